# Optimizing an MI355X kernel written in HIP

```python
import jax, jax.numpy as jnp
from jax import lax
import numpy as np


D_MODEL = 1024
BATCH = 4
SEQ = 8192
DEPTH = 1

N_MEM = 256
EPS = 1e-5
NEG = -1e30
BIG = 1e30

N_HEADS_A = 8
N_KV_A = 2
HG_A = N_HEADS_A // N_KV_A
DH_A = 64
CMP_BLOCK = 32
CMP_STRIDE = 16
SUB_PER_CMP = CMP_BLOCK // CMP_STRIDE
SLC_BLOCK = 64
SUB_PER_SLC = SLC_BLOCK // CMP_STRIDE
N_SEL = 16
WINDOW = 512
PHI_HIDDEN = 128
Q_BLOCK = 64

N_HEADS_B = 4
DH_B = 128
CONV_K = 4
CHUNK = 64

NSA_Q = N_HEADS_A * DH_A
NSA_KV = N_KV_A * DH_A
NSA_GATES = 3 * N_HEADS_A
M_INNER = N_HEADS_B * DH_B
IN_COLS = NSA_Q + 6 * NSA_KV + NSA_GATES + 2 * M_INNER + 2 * N_HEADS_B + 2 * D_MODEL

N_HEADS_X = 4
DH_X = D_MODEL // N_HEADS_X

N_EXPERTS = 32
TOP_K = 4
D_FF = D_MODEL
SWIGLU_LIMIT = 7.0
SWIGLU_ALPHA = 1.702
MOE_BLOCK = 256

kernel_name = 'hybrid_nsa_mlstm_moe_block'


def rmsnorm(x, g):
    xf = x.astype(jnp.float32)
    y = xf * lax.rsqrt(jnp.mean(xf * xf, axis=-1, keepdims=True) + EPS)
    return (y * g.astype(jnp.float32)).astype(x.dtype)


def nsa_mixer(q, k_cmp, v_cmp, k_slc, v_slc, k_win, v_win, gate_logits,
              pe_k, pe_v, w_phi1_k, w_phi2_k, w_phi1_v, w_phi2_v):
    B, T = q.shape[0], q.shape[1]
    f32 = jnp.float32
    scale = DH_A ** -0.5
    n_sub = T // CMP_STRIDE
    n_cmp = n_sub - SUB_PER_CMP + 1
    n_slc = T // SLC_BLOCK
    n_sel = min(N_SEL, n_slc)

    def compress(kv, pe, w1, w2):
        sub = kv.reshape(B, n_sub, CMP_STRIDE, N_KV_A, DH_A)
        blocks = jnp.concatenate([sub[:, r:r + n_cmp] for r in range(SUB_PER_CMP)], axis=2)
        blocks = blocks + pe[None, None, :, None, :]
        flat = blocks.transpose(0, 1, 3, 2, 4).reshape(B, n_cmp, N_KV_A, CMP_BLOCK * DH_A)
        return jax.nn.gelu(flat @ w1) @ w2

    kc = compress(k_cmp, pe_k, w_phi1_k, w_phi2_k)
    vc = compress(v_cmp, pe_v, w_phi1_v, w_phi2_v)
    cmp_end = jnp.arange(n_cmp) * CMP_STRIDE + (CMP_BLOCK - 1)
    kb = k_slc.reshape(B, n_slc, SLC_BLOCK, N_KV_A, DH_A).transpose(0, 3, 1, 2, 4)
    vb = v_slc.reshape(B, n_slc, SLC_BLOCK, N_KV_A, DH_A).transpose(0, 3, 1, 2, 4)
    kw = jnp.pad(k_win, ((0, 0), (WINDOW, 0), (0, 0), (0, 0)))
    vw = jnp.pad(v_win, ((0, 0), (WINDOW, 0), (0, 0), (0, 0)))
    b_idx = jnp.arange(B)[:, None, None, None]
    g_idx = jnp.arange(N_KV_A)[None, :, None, None]
    blk = jnp.arange(n_slc)
    in_slc = jnp.arange(SLC_BLOCK)
    in_win = jnp.arange(Q_BLOCK + WINDOW)

    def block_fn(i):
        q0 = i * Q_BLOCK
        qb = lax.dynamic_slice_in_dim(q, q0, Q_BLOCK, axis=1)
        t = q0 + jnp.arange(Q_BLOCK)
        s = jnp.einsum('bqghd,bjgd->bgqhj', qb, kc).astype(f32) * scale
        mc = (cmp_end[None, :] <= t[:, None])[None, None, :, None, :]
        p_cmp = jax.nn.softmax(jnp.where(mc, s, NEG), axis=-1) * mc
        o_cmp = jnp.einsum('bgqhj,bjgd->bqghd', p_cmp.astype(vc.dtype), vc)
        pg = jnp.pad(p_cmp.sum(axis=3), ((0, 0), (0, 0), (0, 0), (1, SUB_PER_SLC)))
        imp = sum(pg[..., 1 + m - n::SUB_PER_SLC][..., :n_slc]
                  for m in range(SUB_PER_SLC) for n in range(SUB_PER_CMP))
        cur = t // SLC_BLOCK
        valid = blk[None, :] <= cur[:, None]
        forced = (blk[None, :] == 0) | (blk[None, :] == cur[:, None]) | (blk[None, :] == cur[:, None] - 1)
        score = jnp.where(valid, jnp.where(forced, BIG, imp), NEG)
        _, idx = lax.top_k(score, n_sel)
        ks = kb[b_idx, g_idx, idx]
        vs = vb[b_idx, g_idx, idx]
        kpos = idx[..., None] * SLC_BLOCK + in_slc
        ms = (kpos <= t[None, None, :, None, None])[:, :, :, None]
        s = jnp.einsum('bqghd,bgqskd->bgqhsk', qb, ks).astype(f32) * scale
        s = jnp.where(ms, s, NEG).reshape(B, N_KV_A, Q_BLOCK, HG_A, n_sel * SLC_BLOCK)
        p = jax.nn.softmax(s, axis=-1).reshape(B, N_KV_A, Q_BLOCK, HG_A, n_sel, SLC_BLOCK)
        o_slc = jnp.einsum('bgqhsk,bgqskd->bqghd', p.astype(vs.dtype), vs)
        kwb = lax.dynamic_slice_in_dim(kw, q0, Q_BLOCK + WINDOW, axis=1)
        vwb = lax.dynamic_slice_in_dim(vw, q0, Q_BLOCK + WINDOW, axis=1)
        kp = q0 - WINDOW + in_win
        mw = ((kp[None, :] <= t[:, None]) & (kp[None, :] > t[:, None] - WINDOW)
              & (kp[None, :] >= 0))[None, None, :, None, :]
        s = jnp.einsum('bqghd,bkgd->bgqhk', qb, kwb).astype(f32) * scale
        p = jax.nn.softmax(jnp.where(mw, s, NEG), axis=-1)
        o_win = jnp.einsum('bgqhk,bkgd->bqghd', p.astype(vwb.dtype), vwb)
        return o_cmp, o_slc, o_win

    outs = lax.map(block_fn, jnp.arange(T // Q_BLOCK))

    def unblock(o):
        return o.transpose(1, 0, 2, 3, 4, 5).reshape(B, T, N_KV_A, HG_A, DH_A).astype(f32)

    o_cmp, o_slc, o_win = unblock(outs[0]), unblock(outs[1]), unblock(outs[2])
    g = jax.nn.sigmoid(gate_logits.astype(f32)).reshape(B, T, N_KV_A, HG_A, 3)
    o = g[..., 0, None] * o_cmp + g[..., 1, None] * o_slc + g[..., 2, None] * o_win
    return o.reshape(B, T, NSA_Q).astype(q.dtype)


def mlstm_mixer(x_m, o_pre, i_pre, f_pre, w_conv, b_conv, w_q, w_k, w_v, b_i, b_f, mh_gain, skip):
    B, T, _ = x_m.shape
    f32 = jnp.float32
    n_chunk = T // CHUNK
    xp = jnp.pad(x_m, ((0, 0), (CONV_K - 1, 0), (0, 0)))
    conv = sum(xp[:, r:r + T] * w_conv[r] for r in range(CONV_K)) + b_conv
    x_c = jax.nn.silu(conv)
    xc_h = x_c.reshape(B, T, N_HEADS_B, DH_B)
    xm_h = x_m.reshape(B, T, N_HEADS_B, DH_B)
    q = jnp.einsum('bthd,hde->bthe', xc_h, w_q).astype(f32)
    k = jnp.einsum('bthd,hde->bthe', xc_h, w_k).astype(f32) * (DH_B ** -0.5)
    v = jnp.einsum('bthd,hde->bthe', xm_h, w_v).astype(f32)
    log_f = jax.nn.log_sigmoid((f_pre + b_f).astype(f32))
    log_i = (i_pre + b_i).astype(f32)

    def chunks(a):
        return a.reshape(B, n_chunk, CHUNK, N_HEADS_B, -1).transpose(1, 0, 3, 2, 4)

    causal = jnp.tril(jnp.ones((CHUNK, CHUNK), dtype=bool))

    def step(carry, inp):
        C, n, m = carry
        qc, kc, vc, lf, li = inp
        b = jnp.cumsum(lf, axis=-1)
        log_d = jnp.where(causal, b[..., :, None] - b[..., None, :] + li[..., None, :], NEG)
        m_inter = b + m[..., None]
        m_t = jnp.maximum(log_d.max(axis=-1), m_inter)
        d = jnp.exp(log_d - m_t[..., None])
        s = jnp.einsum('bhtd,bhsd->bhts', qc, kc) * d
        inter = jnp.exp(m_inter - m_t)
        num = jnp.einsum('bhts,bhse->bhte', s, vc) + inter[..., None] * jnp.einsum('bhtd,bhde->bhte', qc, C)
        den = s.sum(axis=-1) + inter * jnp.einsum('bhtd,bhd->bht', qc, n)
        h = num / jnp.maximum(jnp.abs(den), jnp.exp(-m_t))[..., None]
        b_last = b[..., -1]
        log_w = b_last[..., None] - b + li
        m_new = jnp.maximum(b_last + m, log_w.max(axis=-1))
        w = jnp.exp(log_w - m_new[..., None])
        decay = jnp.exp(b_last + m - m_new)
        C_new = decay[..., None, None] * C + jnp.einsum('bhs,bhsd,bhse->bhde', w, kc, vc)
        n_new = decay[..., None] * n + jnp.einsum('bhs,bhsd->bhd', w, kc)
        return (C_new, n_new, m_new), h

    init = (jnp.zeros((B, N_HEADS_B, DH_B, DH_B), f32),
            jnp.zeros((B, N_HEADS_B, DH_B), f32),
            jnp.zeros((B, N_HEADS_B), f32))
    _, h = lax.scan(step, init, (chunks(q), chunks(k), chunks(v),
                                 chunks(log_f[..., None])[..., 0], chunks(log_i[..., None])[..., 0]))
    h = h.transpose(1, 0, 3, 2, 4).reshape(B, T, N_HEADS_B, DH_B)
    h = jax.nn.sigmoid(o_pre.astype(f32)).reshape(B, T, N_HEADS_B, DH_B) * h
    mu = h.mean(axis=-1, keepdims=True)
    var = jnp.mean((h - mu) ** 2, axis=-1, keepdims=True)
    hn = (h - mu) * lax.rsqrt(var + EPS) * mh_gain.astype(f32).reshape(N_HEADS_B, DH_B)
    y = hn.reshape(B, T, M_INNER) + skip.astype(f32) * x_c.astype(f32)
    return y.astype(x_m.dtype)


def token_mixer(h, w_in, pe_cmp_k, pe_cmp_v, w_phi1_k, w_phi2_k, w_phi1_v, w_phi2_v,
                w_conv, b_conv, w_q_m, w_k_m, w_v_m, b_i, b_f, mh_gain, skip_m,
                w_up_a, w_up_b, w_o_mix):
    B, T, _ = h.shape
    proj = h @ w_in
    sizes = [NSA_Q] + [NSA_KV] * 6 + [NSA_GATES, M_INNER, M_INNER, N_HEADS_B, N_HEADS_B, D_MODEL, D_MODEL]
    (q, k_cmp, v_cmp, k_slc, v_slc, k_win, v_win, g_nsa,
     x_m, o_pre, i_pre, f_pre, gate_a, gate_b) = jnp.split(proj, np.cumsum(sizes)[:-1].tolist(), axis=-1)

    def kv(a):
        return a.reshape(B, T, N_KV_A, DH_A)

    y_a = nsa_mixer(q.reshape(B, T, N_KV_A, HG_A, DH_A), kv(k_cmp), kv(v_cmp), kv(k_slc), kv(v_slc),
                    kv(k_win), kv(v_win), g_nsa, pe_cmp_k, pe_cmp_v, w_phi1_k, w_phi2_k, w_phi1_v, w_phi2_v)
    y_b = mlstm_mixer(x_m, o_pre, i_pre, f_pre, w_conv, b_conv, w_q_m, w_k_m, w_v_m, b_i, b_f, mh_gain, skip_m)
    merged = jax.nn.sigmoid(gate_a) * (y_a @ w_up_a) + jax.nn.sigmoid(gate_b) * (y_b @ w_up_b)
    return merged @ w_o_mix


def memory_cross_attention(h, m, w_q, w_k, w_v, w_o):
    B, T, D = h.shape
    M = m.shape[1]
    q = (h @ w_q).reshape(B, T, N_HEADS_X, DH_X)
    k = (m @ w_k).reshape(B, M, N_HEADS_X, DH_X)
    v = (m @ w_v).reshape(B, M, N_HEADS_X, DH_X)
    s = jnp.einsum('bthd,bmhd->bhtm', q, k).astype(jnp.float32) * (DH_X ** -0.5)
    p = jax.nn.softmax(s, axis=-1).astype(v.dtype)
    o = jnp.einsum('bhtm,bmhd->bthd', p, v).reshape(B, T, D)
    return o @ w_o


def moe_ffn(h, w_router, b_router, w_gu, b_gu, w_down, b_down):
    B, T, D = h.shape
    f32 = jnp.float32
    n_tok = B * T
    hf = h.reshape(n_tok, D)
    logits = (hf @ w_router + b_router).astype(f32)
    top_val, top_idx = lax.top_k(logits, TOP_K)
    gate = jax.nn.softmax(top_val, axis=-1)
    n_asg = n_tok * TOP_K
    e_flat = top_idx.reshape(n_asg)
    tok_flat = jnp.repeat(jnp.arange(n_tok, dtype=jnp.int32), TOP_K)
    w_flat = gate.reshape(n_asg)
    order = jnp.argsort(e_flat)
    e_s, tok_s, w_s = e_flat[order], tok_flat[order], w_flat[order]
    counts = jnp.bincount(e_flat, length=N_EXPERTS)
    padded = (counts + MOE_BLOCK - 1) // MOE_BLOCK * MOE_BLOCK
    p_end = jnp.cumsum(padded)
    p_start = p_end - padded
    u_start = jnp.cumsum(counts) - counts
    dest = p_start[e_s] + jnp.arange(n_asg) - u_start[e_s]
    n_blk = -(-n_asg // MOE_BLOCK) + N_EXPERTS
    n_pad = n_blk * MOE_BLOCK
    buf_tok = jnp.full((n_pad,), n_tok, jnp.int32).at[dest].set(tok_s)
    buf_w = jnp.zeros((n_pad,), f32).at[dest].set(w_s)
    blk_exp = jnp.minimum(jnp.searchsorted(p_end, jnp.arange(n_blk) * MOE_BLOCK, side='right'), N_EXPERTS - 1)
    x_buf = jnp.concatenate([hf, jnp.zeros((1, D), hf.dtype)], axis=0)[buf_tok].reshape(n_blk, MOE_BLOCK, D)

    def expert_block(args):
        xb, e = args
        gu = xb @ w_gu[e] + b_gu[e]
        g, u = gu[:, :D_FF], gu[:, D_FF:]
        g = jnp.minimum(g, SWIGLU_LIMIT)
        u = jnp.clip(u, -SWIGLU_LIMIT, SWIGLU_LIMIT)
        return ((u + 1.0) * (g * jax.nn.sigmoid(SWIGLU_ALPHA * g))) @ w_down[e] + b_down[e]

    y_buf = lax.map(expert_block, (x_buf, blk_exp)).reshape(n_pad, D)
    y = jnp.zeros((n_tok + 1, D), y_buf.dtype).at[buf_tok].add(y_buf * buf_w[:, None].astype(y_buf.dtype))
    return y[:n_tok].reshape(B, T, D)


def setup_inputs(seed: int = 0) -> dict:
    key = jax.random.key(seed)
    keys = iter(jax.random.split(key, 40))
    L = DEPTH

    def nrm(shape, scale):
        return jax.random.normal(next(keys), shape, jnp.float32) * scale

    def gain(shape):
        return 1.0 + nrm(shape, 0.02)

    return {
        'x': nrm((BATCH, SEQ, D_MODEL), 1.0),
        'mem': nrm((BATCH, N_MEM, D_MODEL), 1.0),
        'g_mix': gain((L, D_MODEL)),
        'w_in': nrm((L, D_MODEL, IN_COLS), D_MODEL ** -0.5),
        'pe_cmp_k': nrm((L, CMP_BLOCK, DH_A), 0.1),
        'pe_cmp_v': nrm((L, CMP_BLOCK, DH_A), 0.1),
        'w_phi1_k': nrm((L, CMP_BLOCK * DH_A, PHI_HIDDEN), (CMP_BLOCK * DH_A) ** -0.5),
        'w_phi2_k': nrm((L, PHI_HIDDEN, DH_A), PHI_HIDDEN ** -0.5),
        'w_phi1_v': nrm((L, CMP_BLOCK * DH_A, PHI_HIDDEN), (CMP_BLOCK * DH_A) ** -0.5),
        'w_phi2_v': nrm((L, PHI_HIDDEN, DH_A), PHI_HIDDEN ** -0.5),
        'w_conv': nrm((L, CONV_K, M_INNER), CONV_K ** -0.5),
        'b_conv': nrm((L, M_INNER), 0.01),
        'w_q_m': nrm((L, N_HEADS_B, DH_B, DH_B), DH_B ** -0.5),
        'w_k_m': nrm((L, N_HEADS_B, DH_B, DH_B), DH_B ** -0.5),
        'w_v_m': nrm((L, N_HEADS_B, DH_B, DH_B), DH_B ** -0.5),
        'b_i': nrm((L, N_HEADS_B), 0.1),
        'b_f': jnp.linspace(3.0, 6.0, N_HEADS_B)[None, :] + nrm((L, N_HEADS_B), 0.1),
        'mh_gain': gain((L, M_INNER)),
        'skip_m': gain((L, M_INNER)),
        'w_up_a': nrm((L, NSA_Q, D_MODEL), NSA_Q ** -0.5),
        'w_up_b': nrm((L, M_INNER, D_MODEL), M_INNER ** -0.5),
        'w_o_mix': nrm((L, D_MODEL, D_MODEL), D_MODEL ** -0.5),
        'g_x': gain((L, D_MODEL)),
        'g_mem': gain((L, D_MODEL)),
        'w_q_x': nrm((L, D_MODEL, D_MODEL), D_MODEL ** -0.5),
        'w_k_x': nrm((L, D_MODEL, D_MODEL), D_MODEL ** -0.5),
        'w_v_x': nrm((L, D_MODEL, D_MODEL), D_MODEL ** -0.5),
        'w_o_x': nrm((L, D_MODEL, D_MODEL), D_MODEL ** -0.5),
        'g_ffn': gain((L, D_MODEL)),
        'w_router': nrm((L, D_MODEL, N_EXPERTS), D_MODEL ** -0.5),
        'b_router': nrm((L, N_EXPERTS), 0.01),
        'w_gu': nrm((L, N_EXPERTS, D_MODEL, 2 * D_FF), D_MODEL ** -0.5),
        'b_gu': nrm((L, N_EXPERTS, 2 * D_FF), 0.01),
        'w_down': nrm((L, N_EXPERTS, D_FF, D_MODEL), D_FF ** -0.5),
        'b_down': nrm((L, N_EXPERTS, D_MODEL), 0.01),
        'g_final': gain((D_MODEL,)),
    }


def reference(x, mem, g_mix, w_in, pe_cmp_k, pe_cmp_v, w_phi1_k, w_phi2_k, w_phi1_v, w_phi2_v,
              w_conv, b_conv, w_q_m, w_k_m, w_v_m, b_i, b_f, mh_gain, skip_m,
              w_up_a, w_up_b, w_o_mix, g_x, g_mem, w_q_x, w_k_x, w_v_x, w_o_x,
              g_ffn, w_router, b_router, w_gu, b_gu, w_down, b_down, g_final):
    for l in range(DEPTH):
        x = x + token_mixer(rmsnorm(x, g_mix[l]), w_in[l], pe_cmp_k[l], pe_cmp_v[l],
                            w_phi1_k[l], w_phi2_k[l], w_phi1_v[l], w_phi2_v[l],
                            w_conv[l], b_conv[l], w_q_m[l], w_k_m[l], w_v_m[l], b_i[l], b_f[l],
                            mh_gain[l], skip_m[l], w_up_a[l], w_up_b[l], w_o_mix[l])
        x = x + memory_cross_attention(rmsnorm(x, g_x[l]), rmsnorm(mem, g_mem[l]),
                                       w_q_x[l], w_k_x[l], w_v_x[l], w_o_x[l])
        x = x + moe_ffn(rmsnorm(x, g_ffn[l]), w_router[l], b_router[l], w_gu[l], b_gu[l],
                        w_down[l], b_down[l])
    return rmsnorm(x, g_final)
```

```cpp
#include <hip/hip_runtime.h>
#include <cstdio>
#include <cstdint>

typedef unsigned short bf16_t;
typedef float f32x4 __attribute__((ext_vector_type(4)));

constexpr int D = 1024, NB = 4, T = 8192, M = NB * T, NMEM = 256;
constexpr int IN_COLS = 4384, LDP = 4608;
constexpr int C_Q = 0, C_KCMP = 512, C_VCMP = 640, C_KSLC = 768, C_VSLC = 896, C_KWIN = 1024, C_VWIN = 1152, C_XM = 1280, C_OPRE = 1792, C_GA = 2304, C_GB = 3328, C_SMALL = 4352;
constexpr int NEXP = 32, TOPK = 4, NASG = M * TOPK, MOE_PAD = 256, MOE_ROWS_MAX = NASG + NEXP * MOE_PAD;
constexpr float EPS = 1e-5f;
constexpr int LDS_MISC = 131072 + 8192, LDS_PTAB = LDS_MISC + 1024;

__host__ __device__ constexpr int my2orig(int c) { return c < 1280 ? c : (c < 2304 ? c + 24 : (c < 4352 ? c + 32 : (c < 4376 ? 1280 + (c - 4352) : 2328 + (c - 4376)))); }

constexpr size_t MiB = 1u << 20;
constexpr size_t WS_CTL = 0;
constexpr size_t WS_SMALL = 1 * MiB;
constexpr size_t WS_W = 48 * MiB;
constexpr size_t WS_GATES = 288 * MiB;
constexpr size_t WS_PROJ = 292 * MiB;
constexpr size_t WS_X1 = 580 * MiB;
constexpr size_t WS_YA = 708 * MiB;
constexpr size_t WS_YB = 740 * MiB;
constexpr size_t WS_T1 = 772 * MiB;
constexpr size_t WS_END = 1024 * MiB;
constexpr size_t SM_RSTD0 = 0, SM_RSTD1 = 128 * 1024, SM_RSTD2 = 256 * 1024, SM_RSTDM = 384 * 1024, SM_BIAS1 = 392 * 1024  ,
    SM_CNT = 400 * 1024  , SM_NT = 401 * 1024  , SM_TEXP = 402 * 1024  ,
    SM_KC = 1 * MiB  , SM_VC = 1 * MiB + 512 * 1024, SM_H1 = 2 * MiB  ,
    SM_KX = 6 * MiB  , SM_VX = 10 * MiB, SM_LOGIT = 14 * MiB  ,
    SM_TE = 18 * MiB  , SM_TW = 18 * MiB + 512 * 1024  , SM_TP = 19 * MiB  ,
    SM_RSLOT = 20 * MiB  ;

struct Args {
    const float* in[36];
    float* out;
    unsigned char* ws;
    int stage, pad;
};

#define GLB __attribute__((address_space(1)))
template <class T> __device__ __forceinline__ T* glb_ptr(unsigned long long v) { return (T*)((GLB T*)v); }
template <class T> __device__ __forceinline__ T* as_global(T* p) { return glb_ptr<T>((unsigned long long)p); }
__device__ __forceinline__ float bf2f(bf16_t v) { return __uint_as_float(((unsigned)v) << 16); }
__device__ __forceinline__ bf16_t f2bf(float f) { unsigned u = __float_as_uint(f); u += 0x7fffu + ((u >> 16) & 1u); return (bf16_t)(u >> 16); }
__device__ __forceinline__ float sigmoidf_(float x) { return 1.f / (1.f + __expf(-x)); }
__device__ __forceinline__ float wave_sum(float v) {
#pragma unroll
    for (int o = 1; o < 64; o <<= 1) v += __shfl_xor(v, o);
    return v;
}
__device__ __forceinline__ float wave_max(float v) {
#pragma unroll
    for (int o = 1; o < 64; o <<= 1) v = fmaxf(v, __shfl_xor(v, o));
    return v;
}

__device__ void nv_rstd(const float* x, float* rstd, int rows, int bid, int nb) {
    const int lane = threadIdx.x & 63, wv = threadIdx.x >> 6, nwv = blockDim.x >> 6;
    for (int m = bid * nwv + wv; m < rows; m += nb * nwv) {
        const f32x4* xr = (const f32x4*)(x + (size_t)m * D) + lane;
        float s = 0.f;
#pragma unroll
        for (int j = 0; j < 4; ++j) { f32x4 v = xr[64 * j]; s += v.x * v.x + v.y * v.y + v.z * v.z + v.w * v.w; }
        s = wave_sum(s);
        if (lane == 0) rstd[m] = rsqrtf(s * (1.f / D) + EPS);
    }
}

template <class FA, class FB, class FE>
__device__ void nv_gemm(int Mr, int N, int K, FA fa, FB fb, FE fe, float* sm, int bid, int nb) {
    const int tid = threadIdx.x, tx = tid & 15, ty = tid >> 4;
    float* As = sm; float* Bs = sm + 16 * 132;
    const int tm = (Mr + 127) / 128, tn = (N + 63) / 64;
    for (int tile = bid; tile < tm * tn; tile += nb) {
        const int m0 = (tile / tn) * 128, n0 = (tile % tn) * 64;
        float acc[4][4];
#pragma unroll
        for (int i = 0; i < 4; ++i)
#pragma unroll
            for (int j = 0; j < 4; ++j) acc[i][j] = 0.f;
        for (int k0 = 0; k0 < K; k0 += 16) {
#pragma unroll
            for (int i = 0; i < 4; ++i) { const int idx = tid + 512 * i, r = idx >> 4, kk = idx & 15; As[kk * 132 + r] = (m0 + r < Mr && k0 + kk < K) ? fa(m0 + r, k0 + kk) : 0.f; }
#pragma unroll
            for (int i = 0; i < 2; ++i) { const int idx = tid + 512 * i, kk = idx >> 6, c = idx & 63; Bs[kk * 64 + c] = (n0 + c < N && k0 + kk < K) ? fb(k0 + kk, n0 + c, m0) : 0.f; }
            __syncthreads();
#pragma unroll
            for (int kk = 0; kk < 16; ++kk) {
                const f32x4 a = *(const f32x4*)&As[kk * 132 + ty * 4], b = *(const f32x4*)&Bs[kk * 64 + tx * 4];
#pragma unroll
                for (int i = 0; i < 4; ++i)
#pragma unroll
                    for (int j = 0; j < 4; ++j) acc[i][j] += a[i] * b[j];
            }
            __syncthreads();
        }
#pragma unroll
        for (int i = 0; i < 4; ++i) if (m0 + ty * 4 + i < Mr && n0 + tx * 4 < N) fe(m0 + ty * 4 + i, n0 + tx * 4, acc[i]);
    }
}

constexpr int NSA_SM_FLOATS = 256 + 4096 + 16 + 512 + 128 + 128 + 16 + 512;
__device__ __forceinline__ void nsa_head_softmax(float* sch, int n, int h, int lt, float* red) {
    float mx = -INFINITY;
    for (int j = lt; j < n; j += 128) mx = fmaxf(mx, sch[j]);
    mx = wave_max(mx);
    if ((lt & 63) == 0) red[h * 2 + (lt >> 6)] = mx;
    __syncthreads();
    mx = fmaxf(red[h * 2], red[h * 2 + 1]);
    float s = 0.f;
    for (int j = lt; j < n; j += 128) { const float e = (mx == -INFINITY) ? 0.f : __expf(sch[j] - mx); sch[j] = e; s += e; }
    s = wave_sum(s);
    __syncthreads();
    if ((lt & 63) == 0) red[8 + h * 2 + (lt >> 6)] = s;
    __syncthreads();
    s = red[8 + h * 2] + red[8 + h * 2 + 1];
    const float inv = s > 0.f ? 1.f / s : 0.f;
    for (int j = lt; j < n; j += 128) sch[j] *= inv;
    __syncthreads();
}
template <class FV>
__device__ __forceinline__ float nsa_head_pv(const float* sch, int n, int h, int lt, float* opart, FV fv) {
    const int d = lt & 63, half = lt >> 6;
    float o = 0.f;
    for (int j = half; j < n; j += 2) { const float p = sch[j]; if (p != 0.f) o += p * fv(j, d); }
    opart[(h * 2 + half) * 64 + d] = o;
    __syncthreads();
    o = opart[(h * 2) * 64 + d] + opart[(h * 2 + 1) * 64 + d];
    __syncthreads();
    return o;
}
__device__ void nv_nsa(const bf16_t* proj, const float* gates, const bf16_t* kc, const bf16_t* vc, bf16_t* ya, float* sm, int bid, int nb) {
    const int tid = threadIdx.x, h = tid >> 7, lt = tid & 127;
    float* q = sm; float* sc = sm + 256; float* red = sc + 4096; float* pg = red + 16; float* impv = pg + 512; float* scorev = impv + 128; int* sel = (int*)(scorev + 128); float* opart = (float*)(sel + 16);
    float* sch = sc + h * 1024;
    for (int unit = bid; unit < NB * 2 * T; unit += nb) {
        const int t = unit % T, g = (unit / T) & 1, b = unit / (2 * T);
        const size_t m = (size_t)b * T + t;
        if (lt < 64) q[h * 64 + lt] = bf2f(proj[m * LDP + C_Q + (g * 4 + h) * 64 + lt]) * 0.125f;
        __syncthreads();
        float yacc = 0.f;
        const int ncv = (t >= 31) ? min((t - 31) / 16 + 1, 511) : 0;
        const bf16_t* kcb = kc + (size_t)(b * 2 + g) * 512 * 64; const bf16_t* vcb = vc + (size_t)(b * 2 + g) * 512 * 64;
        for (int j = lt; j < 512; j += 128) {
            float s = -INFINITY;
            if (j < ncv) { s = 0.f; for (int d = 0; d < 64; ++d) s += q[h * 64 + d] * bf2f(kcb[j * 64 + d]); }
            sch[j] = s;
        }
        __syncthreads();
        nsa_head_softmax(sch, 512, h, lt, red);
        { const float o = nsa_head_pv(sch, 512, h, lt, opart, [&](int j, int d) { return bf2f(vcb[j * 64 + d]); });
          yacc += sigmoidf_(gates[m * 32 + (g * 4 + h) * 3 + 0]) * o; }
        pg[tid] = sc[tid] + sc[1024 + tid] + sc[2048 + tid] + sc[3072 + tid];
        __syncthreads();
        const int cur = t >> 6;
        if (tid < 128) {
            const int bk = tid; float im = 0.f;
            { const int i0 = 4 * bk - 1; if (i0 >= 0 && i0 < 511) im += pg[i0]; }
#pragma unroll
            for (int e = 0; e < 3; ++e) { const int i1 = 4 * bk + e; if (i1 < 511) im += 2.f * pg[i1]; }
            { const int i4 = 4 * bk + 3; if (i4 < 511) im += pg[i4]; }
            const bool valid = bk <= cur, forced = (bk == 0) || (bk == cur) || (bk == cur - 1);
            scorev[bk] = valid ? (forced ? 1e30f : im) : -1e30f;
        }
        __syncthreads();
        if (tid < 128) {
            const float sv = scorev[tid]; int rank = 0;
            for (int k = 0; k < 128; ++k) { const float o = scorev[k]; rank += (o > sv || (o == sv && k < tid)) ? 1 : 0; }
            if (rank < 16) sel[rank] = tid;
        }
        __syncthreads();
        for (int idx = lt; idx < 1024; idx += 128) {
            const int kpos = sel[idx >> 6] * 64 + (idx & 63);
            float s = -INFINITY;
            if (kpos <= t) { const bf16_t* kr = proj + ((size_t)b * T + kpos) * LDP + C_KSLC + g * 64; s = 0.f; for (int d = 0; d < 64; ++d) s += q[h * 64 + d] * bf2f(kr[d]); }
            sch[idx] = s;
        }
        __syncthreads();
        nsa_head_softmax(sch, 1024, h, lt, red);
        { const float o = nsa_head_pv(sch, 1024, h, lt, opart, [&](int j, int d) { const int kpos = sel[j >> 6] * 64 + (j & 63); return bf2f(proj[((size_t)b * T + kpos) * LDP + C_VSLC + g * 64 + d]); });
          yacc += sigmoidf_(gates[m * 32 + (g * 4 + h) * 3 + 1]) * o; }
        for (int idx = lt; idx < 512; idx += 128) {
            const int kp = t - 511 + idx;
            float s = -INFINITY;
            if (kp >= 0) { const bf16_t* kr = proj + ((size_t)b * T + kp) * LDP + C_KWIN + g * 64; s = 0.f; for (int d = 0; d < 64; ++d) s += q[h * 64 + d] * bf2f(kr[d]); }
            sch[idx] = s;
        }
        __syncthreads();
        nsa_head_softmax(sch, 512, h, lt, red);
        { const float o = nsa_head_pv(sch, 512, h, lt, opart, [&](int j, int d) { const int kp = t - 511 + j; return bf2f(proj[((size_t)b * T + kp) * LDP + C_VWIN + g * 64 + d]); });
          yacc += sigmoidf_(gates[m * 32 + (g * 4 + h) * 3 + 2]) * o; }
        if (lt < 64) ya[m * 512 + (g * 4 + h) * 64 + lt] = f2bf(yacc);
        __syncthreads();
    }
}

__device__ void nv_mlstm_seq(const bf16_t* qb, const bf16_t* kb, const bf16_t* vb, const float* gates, const float* b_i, const float* b_f, float* hbuf, float* sm, int bid, int nb) {
    const int tid = threadIdx.x, col = tid >> 1, half = tid & 1;
    for (int unit = bid; unit < NB * 4; unit += nb) {
        const int b = unit >> 2, h = unit & 3;
        float C[64];
#pragma unroll
        for (int i = 0; i < 64; ++i) C[i] = 0.f;
        float mprev = 0.f;
        const float bi = b_i[h], bfv = b_f[h];
        for (int t = 0; t < T; ++t) {
            const size_t m = (size_t)b * T + t;
            const float fp = gates[m * 32 + 28 + h] + bfv, li = gates[m * 32 + 24 + h] + bi;
            const float lf = fminf(fp, 0.f) - log1pf(__expf(-fabsf(fp)));
            const float mnew = fmaxf(lf + mprev, li);
            const float fs = __expf(lf + mprev - mnew), is = __expf(li - mnew);
            float num = 0.f;
            if (col <= 128) {
                const float vt = (col < 128) ? bf2f(vb[m * 512 + h * 128 + col]) : 1.f;
                const float iv = is * vt;
                const bf16_t* kr = kb + m * 512 + h * 128 + half * 64; const bf16_t* qr = qb + m * 512 + h * 128 + half * 64;
#pragma unroll
                for (int i = 0; i < 64; ++i) { C[i] = fs * C[i] + iv * bf2f(kr[i]); num += bf2f(qr[i]) * C[i]; }
            }
            num += __shfl_xor(num, 1);
            if (tid == 256) sm[t & 1] = num;
            __syncthreads();
            if (col < 128 && half == 0) { const float den = sm[t & 1]; hbuf[m * 512 + h * 128 + col] = num / fmaxf(fabsf(den), __expf(-mnew)); }
            mprev = mnew;
        }
        __syncthreads();
    }
}

#define LAS __attribute__((address_space(3)))
namespace pg8 {
typedef short bf16x8 __attribute__((ext_vector_type(8)));
typedef unsigned u32x4 __attribute__((ext_vector_type(4)));
typedef unsigned u32x2 __attribute__((ext_vector_type(2)));
typedef int v4i __attribute__((ext_vector_type(4)));
typedef int v8i __attribute__((ext_vector_type(8)));
constexpr int BM = 256, BK = 64, HALF = 128, HTB = HALF * BK * 2, STAGE_BYTES = 8 * HTB, NXCD = 8, WGM = 8;
__host__ __device__ __forceinline__ int lds_byte(int r, int c) { const int st = (r >> 4) * 2 + (c >> 5), rr = r & 15, cc = c & 31, ob = rr * 64 + cc * 2; return st * 1024 + (ob ^ (((ob >> 9) & 1) << 5)); }
__host__ __device__ __forceinline__ void stage_rc(int b, int& R, int& C) { const int st = b / 1024, sb = b % 1024, swz = sb ^ (((sb >> 9) & 1) << 5); R = (st >> 1) * 16 + swz / 64; C = (st & 1) * 32 + (swz % 64) / 2; }
__host__ __device__ __forceinline__ int perm32(int rho) { const int n = rho >> 4, i = rho & 15; return 8 * (i >> 2) + 4 * n + (i & 3); }
struct Unit { int pm, pn, e, part; };
struct Off4 { unsigned p0, p1; };
__device__ __forceinline__ void tile_of(int L, int nM, int nN, int& pm, int& pn) {
    const int nwg = nM * nN; int wgid = L;
    { const int q = nwg / NXCD, r = nwg % NXCD, xcd = wgid % NXCD, off = wgid / NXCD; wgid = (xcd < r ? xcd * (q + 1) : r * (q + 1) + (xcd - r) * q) + off; }
    const int nig = WGM * nN, gid = wgid / nig, fm = gid * WGM, gsz = (nM - fm) < WGM ? (nM - fm) : WGM;
    pm = fm + ((wgid % nig) % gsz); pn = (wgid % nig) / gsz;
}
__device__ __forceinline__ unsigned cvt_pk_bf16(float lo, float hi) { unsigned r; asm volatile("v_cvt_pk_bf16_f32 %0, %1, %2" : "=v"(r) : "v"(lo), "v"(hi)); return r; }

__device__ __forceinline__ const char* uni(const char* p) {
    const unsigned long long v = (unsigned long long)p;
    return glb_ptr<const char>(((unsigned long long)(unsigned)__builtin_amdgcn_readfirstlane((int)(v >> 32)) << 32) | (unsigned long long)(unsigned)__builtin_amdgcn_readfirstlane((int)(unsigned)v)); }
template <class Epi, class Sched>
__device__ __forceinline__ void gemm_phase(LAS unsigned char* lds, const Sched& S, const Epi& E) {
    int tid_ = threadIdx.x; asm volatile("" : "+v"(tid_));
    const int tid = tid_, wid = __builtin_amdgcn_readfirstlane(tid >> 6), lane = tid & 63, wr = wid >> 2, wc = wid & 3, fr = lane & 15, fq = lane >> 4;
    const int nt = S.ntk;
    int Rr[2], Cc[2]; unsigned voffA[2], voffB[2];
#pragma unroll
    for (int i = 0; i < 2; ++i) { stage_rc(tid * 16 + i * 8192, Rr[i], Cc[i]); const int Rb = Epi::PERM ? ((Rr[i] & ~31) + perm32(Rr[i] & 31)) : Rr[i];
        voffA[i] = (unsigned)Rr[i] * S.lda2 + (unsigned)Cc[i] * 2u; voffB[i] = (unsigned)Rb * S.ldb2 + (unsigned)Cc[i] * 2u; }
    const unsigned kA = (unsigned)S.kstepA, hA = (unsigned)HALF * S.lda2, hB = (unsigned)HALF * S.ldb2; constexpr unsigned kB = BK * 2;
    const char* const baseA = uni(S.abase()); const char* const baseB = uni(S.bbase());
    const unsigned ldsw = (unsigned)wid * 1024u;
    const int aoff = lds_byte(wr * 64 + fr, fq * 8), boff = lds_byte(wc * 32 + fr, fq * 8);
#define PG8_SA(b, h) (((b) * 2 + (h)) * HTB)
#define PG8_SB(b, h) ((4 + (b) * 2 + (h)) * HTB)
#define PG8_STG(bufoff, p0, p1) do { __builtin_amdgcn_global_load_lds((const unsigned*)(p0), (LAS unsigned*)(lds + (bufoff) + ldsw), 16, 0, 0); \
        __builtin_amdgcn_global_load_lds((const unsigned*)(p1), (LAS unsigned*)(lds + (bufoff) + ldsw + 8192), 16, 0, 0); } while (0)
#define PG8_STA(bufoff, ao, h, vv) do { if constexpr (Sched::GATHER) { const unsigned _pp = (h) ? vv.p1 : vv.p0; PG8_STG(bufoff, baseA + ((ao) + (_pp & 0xffffu) * S.lda2 + gcol), baseA + ((ao) + (_pp >> 16) * S.lda2 + gcol)); } \
        else { const unsigned _p = (ao) + (h) * hA; PG8_STG(bufoff, baseA + (_p + voffA[0]), baseA + (_p + voffA[1])); } } while (0)
#define PG8_STB(bufoff, bo, h) do { const unsigned _q = (bo) + (h) * hB; PG8_STG(bufoff, baseB + (_q + voffB[0]), baseB + (_q + voffB[1])); } while (0)
#define PG8_CAT(x0, x1) __builtin_shufflevector(x0, x1, 0, 1, 2, 3, 4, 5, 6, 7)
#define PG8_LDA(dst, b, h) do { _Pragma("unroll") for (int m = 0; m < 4; ++m) { if constexpr (Sched::FP8) dst##8[m] = PG8_CAT(*(const LAS v4i*)(lds + PG8_SA(b, h) + aoff + m * 2048), *(const LAS v4i*)(lds + PG8_SA(b, h) + aoff + m * 2048 + 1024)); \
        else { _Pragma("unroll") for (int k = 0; k < 2; ++k) dst[m][k] = *(const LAS bf16x8*)(lds + PG8_SA(b, h) + aoff + m * 2048 + k * 1024); } } } while (0)
#define PG8_LDB(dst, b, h) do { _Pragma("unroll") for (int n = 0; n < 2; ++n) { if constexpr (Sched::FP8) dst##8[n] = PG8_CAT(*(const LAS v4i*)(lds + PG8_SB(b, h) + boff + n * 2048), *(const LAS v4i*)(lds + PG8_SB(b, h) + boff + n * 2048 + 1024)); \
        else { _Pragma("unroll") for (int k = 0; k < 2; ++k) dst[n][k] = *(const LAS bf16x8*)(lds + PG8_SB(b, h) + boff + n * 2048 + k * 1024); } } } while (0)
#define PG8_MMA(ai, bj, At, Bt) do { __builtin_amdgcn_s_setprio(1); _Pragma("unroll") for (int m = 0; m < 4; ++m) _Pragma("unroll") for (int n = 0; n < 2; ++n) { \
        if constexpr (Sched::FP8) asm volatile("v_mfma_scale_f32_16x16x128_f8f6f4 %0, %1, %2, %0, %3, %4 op_sel_hi:[0,0,0]" : "+v"(acc[ai][bj][m][n]) : "v"(Bt##8[n]), "v"(At##8[m]), "v"(sclB), "v"(sclA)); \
        else { _Pragma("unroll") for (int k = 0; k < 2; ++k) acc[ai][bj][m][n] = __builtin_amdgcn_mfma_f32_16x16x32_bf16(Bt[n][k], At[m][k], acc[ai][bj][m][n], 0, 0, 0); } } \
        __builtin_amdgcn_s_setprio(0); } while (0)
#define PG8_WAIT_V(n) asm volatile("s_waitcnt vmcnt(" #n ")" ::: "memory")
#define PG8_WAIT_L(n) asm volatile("s_waitcnt lgkmcnt(" #n ")" ::: "memory")
#define PG8_BAR __builtin_amdgcn_s_barrier()
#define PG8_SCHED __builtin_amdgcn_sched_barrier(0)
#define PG8_ZERO() do { _Pragma("unroll") for (int a_ = 0; a_ < 2; ++a_) _Pragma("unroll") for (int b_ = 0; b_ < 2; ++b_) _Pragma("unroll") for (int m_ = 0; m_ < 4; ++m_) _Pragma("unroll") for (int n_ = 0; n_ < 2; ++n_) acc[a_][b_][m_][n_] = (f32x4){0.f, 0.f, 0.f, 0.f}; } while (0)
    Unit cur, nxt; int ui = 0;
    if (!S.next(0, cur)) return;
    f32x4 acc[2][2][4][2];
    PG8_ZERO();
    int sclB = Sched::SB, sclA = 127; asm volatile("" : "+v"(sclB), "+v"(sclA));
    bf16x8 At[4][2], B0[2][2], B1[2][2]; v8i At8[4], B08[2], B18[2];
    unsigned cA = (unsigned)__builtin_amdgcn_readfirstlane((int)S.a_off(cur)), cB = (unsigned)__builtin_amdgcn_readfirstlane((int)S.b_off(cur));
    Off4 cvA{0u, 0u}, nvA{0u, 0u};
    const unsigned gcol = (unsigned)Cc[0] * 2u;
    if constexpr (Sched::GATHER) S.a_gather(cur, Rr[0], cvA);
    PG8_STB(PG8_SB(0, 0), cB, 0); PG8_STB(PG8_SB(0, 1), cB, 1); PG8_STA(PG8_SA(0, 0), cA, 0, cvA); PG8_STA(PG8_SA(0, 1), cA, 1, cvA);
    if (wr == 1) PG8_BAR;
    PG8_WAIT_V(2); PG8_BAR;
    PG8_STB(PG8_SB(1, 0), cB + kB, 0); PG8_STA(PG8_SA(1, 0), cA + kA, 0, cvA); PG8_STB(PG8_SB(1, 1), cB + kB, 1);
    PG8_WAIT_V(6); PG8_BAR;
    for (;;) {
        const bool has_next = S.next(ui + 1, nxt);
        const unsigned nA = has_next ? (unsigned)__builtin_amdgcn_readfirstlane((int)S.a_off(nxt)) : cA, nB = has_next ? (unsigned)__builtin_amdgcn_readfirstlane((int)S.b_off(nxt)) : cB;
        if constexpr (Sched::GATHER) { if (has_next) S.a_gather(nxt, Rr[0], nvA); else nvA = cvA; }
        for (int t = 0; t < nt; t += 2) {
            const bool last = (t == nt - 2);
            const unsigned a1 = cA + (unsigned)(t + 1) * kA;
            const unsigned a2 = last ? nA : cA + (unsigned)(t + 2) * kA, b2 = last ? nB : cB + (unsigned)(t + 2) * kB;
            const unsigned a3 = a2 + kA, b3 = b2 + kB;
#define v2 (last ? nvA : cvA)
            PG8_LDB(B0, 0, 0); PG8_LDB(B1, 0, 1); PG8_SCHED; PG8_LDA(At, 0, 0); PG8_STA(PG8_SA(1, 1), a1, 1, cvA);
            PG8_WAIT_V(8); PG8_WAIT_L(0); PG8_BAR; PG8_MMA(0, 0, At, B0); PG8_MMA(0, 1, At, B1); PG8_BAR; PG8_SCHED;
            PG8_LDA(At, 0, 1); PG8_STB(PG8_SB(0, 0), b2, 0); PG8_STB(PG8_SB(0, 1), b2, 1); PG8_STA(PG8_SA(0, 0), a2, 0, v2);
            PG8_WAIT_V(8); PG8_WAIT_L(0); PG8_BAR; PG8_MMA(1, 0, At, B0); PG8_MMA(1, 1, At, B1); PG8_BAR; PG8_SCHED;
            PG8_LDB(B0, 1, 0); PG8_LDB(B1, 1, 1); PG8_SCHED; PG8_LDA(At, 1, 0); PG8_STA(PG8_SA(0, 1), a2, 1, v2);
            PG8_WAIT_V(8); PG8_WAIT_L(0); PG8_BAR; PG8_MMA(0, 0, At, B0); PG8_MMA(0, 1, At, B1); PG8_BAR; PG8_SCHED;
            PG8_LDA(At, 1, 1); PG8_STB(PG8_SB(1, 0), b3, 0); PG8_STB(PG8_SB(1, 1), b3, 1); PG8_STA(PG8_SA(1, 0), a3, 0, v2);
            PG8_WAIT_V(8); PG8_WAIT_L(0); PG8_BAR; PG8_MMA(1, 0, At, B0); PG8_MMA(1, 1, At, B1); PG8_BAR; PG8_SCHED;
#undef v2
        }
        if (wr == 0) PG8_BAR;
        if constexpr (Sched::FP8) asm volatile("s_nop 15\n\ts_nop 15" ::: "memory");
        const bool keep = S.keep(cur);
        if (keep) E.mid(acc, cur, wr, wc, fr, fq); else E(acc, cur, wr, wc, fr, fq);
        if (!has_next) break;
        if (!keep) PG8_ZERO();
        cur = nxt; cA = nA; cB = nB; ++ui; cvA = nvA;
        if (wr == 1) PG8_BAR;
    }
    PG8_WAIT_V(0);
    PG8_BAR;
#undef PG8_SA
#undef PG8_SB
#undef PG8_STG
#undef PG8_STA
#undef PG8_STB
#undef PG8_LDA
#undef PG8_LDB
#undef PG8_MMA
#undef PG8_CAT
#undef PG8_WAIT_V
#undef PG8_WAIT_L
#undef PG8_BAR
#undef PG8_SCHED
#undef PG8_ZERO
}

struct DenseSched {
    static constexpr bool GATHER = false, FP8 = false; static constexpr int SB = 127;
    const char* A0; const char* B0; const char* A1; const char* B1; unsigned lda2, ldb2; size_t kstepA; int ntk, nM, nN, G, c, parts;
    __device__ __forceinline__ bool next(int i, Unit& u) const { const int ti = parts == 2 ? (i >> 1) : i; const long L = (long)ti * G + c; if (L >= (long)nM * nN) return false;
        tile_of((int)L, nM, nN, u.pm, u.pn); u.e = 0; u.part = parts == 2 ? (i & 1) : 0; return true; }
    __device__ __forceinline__ const char* abase() const { return A0; }
    __device__ __forceinline__ const char* bbase() const { return B0; }
    __device__ __forceinline__ unsigned a_off(const Unit& u) const { return (u.part ? (unsigned)(A1 - A0) : 0u) + (unsigned)u.pm * BM * lda2; }
    __device__ __forceinline__ unsigned b_off(const Unit& u) const { return (u.part ? (unsigned)(B1 - B0) : 0u) + (unsigned)u.pn * BM * ldb2; }
    __device__ __forceinline__ bool keep(const Unit& u) const { return parts == 2 && u.part == 0; }
    __device__ __forceinline__ void a_gather(const Unit&, int, Off4&) const {}
};
struct MoeSched {
    const char* A; const char* Bt; unsigned lda2, ldb2; size_t kstepA; int ntk, nM, nN, G, c; size_t bexp;
    const LAS int* tend; const unsigned* rowpair;
    __device__ __forceinline__ bool next(int i, Unit& u) const { const long L = (long)i * G + c; if (L >= (long)nM * nN) return false;
        tile_of((int)L, nM, nN, u.pm, u.pn); int e = 0;
#pragma unroll
        for (int j = 0; j < 31; ++j) e += (u.pm >= tend[j]) ? 1 : 0;
        u.e = __builtin_amdgcn_readfirstlane(e); u.part = 0; return true; }
    __device__ __forceinline__ const char* abase() const { return A; }
    __device__ __forceinline__ const char* bbase() const { return Bt; }
    __device__ __forceinline__ unsigned b_off(const Unit& u) const { return (unsigned)u.e * (unsigned)bexp + (unsigned)u.pn * BM * ldb2; }
    __device__ __forceinline__ bool keep(const Unit&) const { return false; }
};
struct MoeSched1 : MoeSched { static constexpr bool GATHER = true, FP8 = true; static constexpr int SB = 122;
    __device__ __forceinline__ unsigned a_off(const Unit&) const { return 0u; }
    __device__ __forceinline__ void a_gather(const Unit& u, int R0, Off4& off) const {
        off.p0 = rowpair[(u.pm * 2) * 64 + R0]; off.p1 = rowpair[(u.pm * 2 + 1) * 64 + R0]; }
};
struct MoeSched2 : MoeSched { static constexpr bool GATHER = false, FP8 = true; static constexpr int SB = 122;
    __device__ __forceinline__ unsigned a_off(const Unit& u) const { return (unsigned)u.pm * BM * lda2; }
    __device__ __forceinline__ void a_gather(const Unit&, int, Off4&) const {}
};

typedef f32x4 Acc[2][2][4][2];
__device__ __forceinline__ float rstd_from_ssq(const float* ssq, size_t row) {
    const f32x4* p = (const f32x4*)(ssq + row * 16); const f32x4 a = p[0], b = p[1], c = p[2], d = p[3];
    const float s = ((a.x + a.y) + (a.z + a.w)) + ((b.x + b.y) + (b.z + b.w)) + ((c.x + c.y) + (c.z + c.w)) + ((d.x + d.y) + (d.z + d.w));
    return rsqrtf(s * (1.f / 1024.f) + 1e-5f);
}
__device__ __forceinline__ unsigned pack4_fp8(const f32x4& v) { int w = __builtin_amdgcn_cvt_pk_fp8_f32(v[0], v[1], 0, false); w = __builtin_amdgcn_cvt_pk_fp8_f32(v[2], v[3], w, true); return (unsigned)w; }
__device__ __forceinline__ u32x4 pack8(const f32x4& v0, const f32x4& v1) { u32x4 w; w.x = cvt_pk_bf16(v0[0], v0[1]); w.y = cvt_pk_bf16(v0[2], v0[3]); w.z = cvt_pk_bf16(v1[0], v1[1]); w.w = cvt_pk_bf16(v1[2], v1[3]); return w; }
__device__ __forceinline__ void unpack8(const u32x4& w, f32x4& v0, f32x4& v1) {
    v0[0] = __uint_as_float(w.x << 16); v0[1] = __uint_as_float(w.x & 0xffff0000u); v0[2] = __uint_as_float(w.y << 16); v0[3] = __uint_as_float(w.y & 0xffff0000u);
    v1[0] = __uint_as_float(w.z << 16); v1[1] = __uint_as_float(w.z & 0xffff0000u); v1[2] = __uint_as_float(w.w << 16); v1[3] = __uint_as_float(w.w & 0xffff0000u); }

struct EpiProj { static constexpr bool PERM = true;
    bf16_t* proj; float* gates; bf16_t* kvc;
    __device__ __forceinline__ void mid(Acc&, const Unit&, int, int, int, int) const {}
    __device__ __forceinline__ void operator()(const Acc& acc, const Unit& u, int wr, int wc, int fr, int fq) const {
        const int row0 = u.pm * BM + wr * 64 + fr, col0 = u.pn * BM + wc * 32 + 8 * fq;
#pragma unroll
        for (int ai = 0; ai < 2; ++ai)
#pragma unroll
            for (int m = 0; m < 4; ++m) { const size_t row = row0 + ai * HALF + m * 16; bf16_t* rowp = proj + row * LDP + col0;
                if (u.pn >= 2 && u.pn <= 4) { const int cc = wc * 32 + 8 * fq, g = cc >> 6, d = cc & 63; const size_t bt = ((row >> 13) * 2 + g) * (size_t)T + (row & (T - 1));
#pragma unroll
                    for (int bj = 0; bj < 2; ++bj) *(u32x4*)(kvc + ((size_t)((u.pn - 2) * 2 + bj) * M * 128) + bt * 64 + d) = pack8(acc[ai][bj][m][0], acc[ai][bj][m][1]);
                    continue; }
#pragma unroll
                for (int bj = 0; bj < 2; ++bj) *(u32x4*)(rowp + bj * HALF) = pack8(acc[ai][bj][m][0], acc[ai][bj][m][1]);
                if (u.pn == 17 && wc == 0) { *(f32x4*)(gates + row * 32 + 8 * fq) = acc[ai][0][m][0]; *(f32x4*)(gates + row * 32 + 8 * fq + 4) = acc[ai][0][m][1]; } }
    }
};
struct EpiMerged { static constexpr bool PERM = true;
    const bf16_t* proj; bf16_t* mg;
    __device__ __forceinline__ void mid(Acc& acc, const Unit& u, int wr, int wc, int fr, int fq) const {
        const int row0 = u.pm * BM + wr * 64 + fr, col0 = u.pn * BM + wc * 32 + 8 * fq;
#pragma unroll
        for (int ai = 0; ai < 2; ++ai) { u32x4 ga[4][2], gb[4][2];
#pragma unroll
            for (int m = 0; m < 4; ++m)
#pragma unroll
                for (int bj = 0; bj < 2; ++bj) { const bf16_t* pp = proj + (size_t)(row0 + ai * HALF + m * 16) * LDP + col0 + bj * HALF; ga[m][bj] = *(const u32x4*)(pp + C_GA); gb[m][bj] = *(const u32x4*)(pp + C_GB); }
#pragma unroll
            for (int m = 0; m < 4; ++m)
#pragma unroll
                for (int bj = 0; bj < 2; ++bj) { f32x4 a0, a1, b0, b1; unpack8(ga[m][bj], a0, a1); unpack8(gb[m][bj], b0, b1);
#pragma unroll
                    for (int j = 0; j < 4; ++j) { acc[ai][bj][m][0][j] *= (1.f + __expf(-b0[j])) * __builtin_amdgcn_rcpf(1.f + __expf(-a0[j])); acc[ai][bj][m][1][j] *= (1.f + __expf(-b1[j])) * __builtin_amdgcn_rcpf(1.f + __expf(-a1[j])); } } }
    }
    __device__ __forceinline__ void operator()(const Acc& acc, const Unit& u, int wr, int wc, int fr, int fq) const {
        const int row0 = u.pm * BM + wr * 64 + fr, col0 = u.pn * BM + wc * 32 + 8 * fq;
        u32x4 gba[2][4][2];
#pragma unroll
        for (int ai = 0; ai < 2; ++ai)
#pragma unroll
            for (int m = 0; m < 4; ++m)
#pragma unroll
                for (int bj = 0; bj < 2; ++bj) gba[ai][m][bj] = *(const u32x4*)(proj + (size_t)(row0 + ai * HALF + m * 16) * LDP + C_GB + col0 + bj * HALF);
#pragma unroll
        for (int ai = 0; ai < 2; ++ai) {
#pragma unroll
            for (int m = 0; m < 4; ++m)
#pragma unroll
                for (int bj = 0; bj < 2; ++bj) { f32x4 b0, b1; unpack8(gba[ai][m][bj], b0, b1); f32x4 v0 = acc[ai][bj][m][0], v1 = acc[ai][bj][m][1];
#pragma unroll
                    for (int j = 0; j < 4; ++j) { v0[j] *= __builtin_amdgcn_rcpf(1.f + __expf(-b0[j])); v1[j] *= __builtin_amdgcn_rcpf(1.f + __expf(-b1[j])); }
                    *(u32x4*)(mg + (size_t)(row0 + ai * HALF + m * 16) * D + col0 + bj * HALF) = pack8(v0, v1); } }
    }
};
template <bool BASE_BF16>
struct EpiResid { static constexpr bool PERM = false;
    const void* base; bf16_t* xb; float* ssq; unsigned char* xq;
    __device__ __forceinline__ void mid(Acc&, const Unit&, int, int, int, int) const {}
    __device__ __forceinline__ void operator()(const Acc& acc, const Unit& u, int wr, int wc, int fr, int fq) const {
        const int row0 = u.pm * BM + wr * 64 + fr, col0 = u.pn * BM + wc * 32 + 4 * fq;
        if constexpr (BASE_BF16) {
            u32x2 bw[2][4][2][2];
#pragma unroll
            for (int ai = 0; ai < 2; ++ai)
#pragma unroll
                for (int m = 0; m < 4; ++m)
#pragma unroll
                    for (int bj = 0; bj < 2; ++bj)
#pragma unroll
                        for (int n = 0; n < 2; ++n) bw[ai][m][bj][n] = *(const u32x2*)((const bf16_t*)base + (size_t)(row0 + ai * HALF + m * 16) * D + col0 + bj * HALF + n * 16);
#pragma unroll
            for (int ai = 0; ai < 2; ++ai)
#pragma unroll
                for (int m = 0; m < 4; ++m) { const size_t row = row0 + ai * HALF + m * 16; float s = 0.f;
#pragma unroll
                    for (int bj = 0; bj < 2; ++bj)
#pragma unroll
                        for (int n = 0; n < 2; ++n) { const size_t o = row * D + col0 + bj * HALF + n * 16; const u32x2 b2 = bw[ai][m][bj][n];
                            const f32x4 v = (f32x4){__uint_as_float(b2.x << 16), __uint_as_float(b2.x & 0xffff0000u), __uint_as_float(b2.y << 16), __uint_as_float(b2.y & 0xffff0000u)} + acc[ai][bj][m][n];
                            u32x2 w; w.x = cvt_pk_bf16(v[0], v[1]); w.y = cvt_pk_bf16(v[2], v[3]); *(u32x2*)(xb + o) = w;
                            if (xq) *(unsigned*)(xq + o) = pack4_fp8(v);
                            s += (v[0] * v[0] + v[1] * v[1]) + (v[2] * v[2] + v[3] * v[3]); }
                    s += __shfl_xor(s, 16); s += __shfl_xor(s, 32);
                    if (fq == 0) ssq[row * 16 + u.pn * 4 + wc] = s; }
            return; }
#pragma unroll
        for (int ai = 0; ai < 2; ++ai) { f32x4 bv[4][2][2];
#pragma unroll
            for (int m = 0; m < 4; ++m)
#pragma unroll
                for (int bj = 0; bj < 2; ++bj)
#pragma unroll
                    for (int n = 0; n < 2; ++n) { const size_t o = (size_t)(row0 + ai * HALF + m * 16) * D + col0 + bj * HALF + n * 16;
                        if constexpr (BASE_BF16) { const u32x2 bw = *(const u32x2*)((const bf16_t*)base + o); bv[m][bj][n] = (f32x4){__uint_as_float(bw.x << 16), __uint_as_float(bw.x & 0xffff0000u), __uint_as_float(bw.y << 16), __uint_as_float(bw.y & 0xffff0000u)}; }
                        else bv[m][bj][n] = *(const f32x4*)((const float*)base + o); }
#pragma unroll
            for (int m = 0; m < 4; ++m) { const size_t row = row0 + ai * HALF + m * 16; float s = 0.f;
#pragma unroll
                for (int bj = 0; bj < 2; ++bj)
#pragma unroll
                    for (int n = 0; n < 2; ++n) { const size_t o = row * D + col0 + bj * HALF + n * 16; const f32x4 v = bv[m][bj][n] + acc[ai][bj][m][n];
                        u32x2 w; w.x = cvt_pk_bf16(v[0], v[1]); w.y = cvt_pk_bf16(v[2], v[3]); *(u32x2*)(xb + o) = w;
                        if (xq) *(unsigned*)(xq + o) = pack4_fp8(v);
                        s += (v[0] * v[0] + v[1] * v[1]) + (v[2] * v[2] + v[3] * v[3]); }
                s += __shfl_xor(s, 16); s += __shfl_xor(s, 32);
                if (fq == 0) ssq[row * 16 + u.pn * 4 + wc] = s; } }
    }
};
struct EpiScaleBf16 { static constexpr bool PERM = true;
    bf16_t* o; int ldo; const float* ssq;
    __device__ __forceinline__ void mid(Acc&, const Unit&, int, int, int, int) const {}
    __device__ __forceinline__ void operator()(const Acc& acc, const Unit& u, int wr, int wc, int fr, int fq) const {
        const int row0 = u.pm * BM + wr * 64 + fr, col0 = u.pn * BM + wc * 32 + 8 * fq;
        float rsa[2][4];
        if (ssq) { f32x4 qv[2][4];
#pragma unroll
            for (int ai = 0; ai < 2; ++ai)
#pragma unroll
                for (int m = 0; m < 4; ++m) qv[ai][m] = *(const f32x4*)(ssq + (size_t)(row0 + ai * HALF + m * 16) * 16 + 4 * fq);
#pragma unroll
            for (int ai = 0; ai < 2; ++ai)
#pragma unroll
                for (int m = 0; m < 4; ++m) { float sq = (qv[ai][m][0] + qv[ai][m][1]) + (qv[ai][m][2] + qv[ai][m][3]); sq += __shfl_xor(sq, 16); sq += __shfl_xor(sq, 32); rsa[ai][m] = rsqrtf(sq * (1.f / 1024.f) + 1e-5f); } }
        else {
#pragma unroll
            for (int ai = 0; ai < 2; ++ai)
#pragma unroll
                for (int m = 0; m < 4; ++m) rsa[ai][m] = 1.f; }
#pragma unroll
        for (int ai = 0; ai < 2; ++ai)
#pragma unroll
            for (int m = 0; m < 4; ++m) { const size_t row = row0 + ai * HALF + m * 16;
#pragma unroll
                for (int bj = 0; bj < 2; ++bj) *(u32x4*)(o + row * ldo + col0 + bj * HALF) = pack8(acc[ai][bj][m][0] * rsa[ai][m], acc[ai][bj][m][1] * rsa[ai][m]); }
    }
};
struct EpiLogit { static constexpr bool PERM = false;
    float* logit; const float* ssq; const float* bias;
    __device__ __forceinline__ void mid(Acc&, const Unit&, int, int, int, int) const {}
    __device__ __forceinline__ void operator()(const Acc& acc, const Unit& u, int wr, int wc, int fr, int fq) const {
        if (wc != 0) return;
        const int row0 = u.pm * BM + wr * 64 + fr;
#pragma unroll
        for (int ai = 0; ai < 2; ++ai)
#pragma unroll
            for (int m = 0; m < 4; ++m) { const size_t row = row0 + ai * HALF + m * 16; const float rs = rstd_from_ssq(ssq, row);
#pragma unroll
                for (int n = 0; n < 2; ++n) { const int c = n * 16 + 4 * fq; *(f32x4*)(logit + row * 32 + c) = acc[ai][0][m][n] * rs + *(const f32x4*)(bias + c); } }
    }
};
struct EpiMoe1 { static constexpr bool PERM = true;
    unsigned char* act; const float* rowrs; const float* bgu;
    __device__ __forceinline__ void mid(Acc&, const Unit&, int, int, int, int) const {}
    __device__ __forceinline__ void operator()(const Acc& acc, const Unit& u, int wr, int wc, int fr, int fq) const {
        const int row0 = u.pm * BM + wr * 64 + fr, c0 = u.pn * HALF + wc * 32 + 8 * fq;
        const float* bg = bgu + (size_t)u.e * 2048 + c0;
        float rsa[2][4];
#pragma unroll
        for (int ai = 0; ai < 2; ++ai)
#pragma unroll
            for (int m = 0; m < 4; ++m) rsa[ai][m] = rowrs[row0 + ai * HALF + m * 16];
        const f32x4 bg0 = *(const f32x4*)bg, bg1 = *(const f32x4*)(bg + 4), bu0 = *(const f32x4*)(bg + 1024), bu1 = *(const f32x4*)(bg + 1028);
#pragma unroll
        for (int ai = 0; ai < 2; ++ai)
            {
#pragma unroll
              for (int m = 0; m < 4; ++m) { const size_t row = row0 + ai * HALF + m * 16; const float rs = rsa[ai][m];
                f32x4 o0, o1;
#pragma unroll
                for (int j = 0; j < 4; ++j) {
                    float g0 = fminf(acc[ai][0][m][0][j] * rs + bg0[j], 7.f), u0 = fminf(fmaxf(acc[ai][1][m][0][j] * rs + bu0[j], -7.f), 7.f);
                    float g1 = fminf(acc[ai][0][m][1][j] * rs + bg1[j], 7.f), u1 = fminf(fmaxf(acc[ai][1][m][1][j] * rs + bu1[j], -7.f), 7.f);
                    o0[j] = (u0 + 1.f) * g0 * __builtin_amdgcn_rcpf(1.f + __expf(-1.702f * g0)); o1[j] = (u1 + 1.f) * g1 * __builtin_amdgcn_rcpf(1.f + __expf(-1.702f * g1)); }
                u32x2 w8; w8.x = pack4_fp8(o0); w8.y = pack4_fp8(o1); *(u32x2*)(act + row * D + c0) = w8; } }
    }
};
struct EpiMoe2 { static constexpr bool PERM = true;
    bf16_t* ys; const int* rslot; const float* roww; const float* bd;
    __device__ __forceinline__ void mid(Acc&, const Unit&, int, int, int, int) const {}
    __device__ __forceinline__ void operator()(const Acc& acc, const Unit& u, int wr, int wc, int fr, int fq) const {
        const int row0 = u.pm * BM + wr * 64 + fr, col0 = u.pn * BM + wc * 32 + 8 * fq;
        const float* bp = bd + (size_t)u.e * D + col0;
        int slv[2][4]; float wv_[2][4];
#pragma unroll
        for (int ai = 0; ai < 2; ++ai)
#pragma unroll
            for (int m = 0; m < 4; ++m) { slv[ai][m] = rslot[row0 + ai * HALF + m * 16]; wv_[ai][m] = roww[row0 + ai * HALF + m * 16]; }
        f32x4 bb[2][2];
#pragma unroll
        for (int bj = 0; bj < 2; ++bj) { bb[bj][0] = *(const f32x4*)(bp + bj * HALF); bb[bj][1] = *(const f32x4*)(bp + bj * HALF + 4); }
#pragma unroll
        for (int ai = 0; ai < 2; ++ai)
#pragma unroll
            for (int m = 0; m < 4; ++m) { const int sl = slv[ai][m]; const float w = wv_[ai][m]; if (sl < 0) continue;
#pragma unroll
                for (int bj = 0; bj < 2; ++bj) *(u32x4*)(ys + (size_t)sl * D + col0 + bj * HALF) = pack8((acc[ai][bj][m][0] + bb[bj][0]) * w, (acc[ai][bj][m][1] + bb[bj][1]) * w); }
    }
};
struct CmpSched {
    static constexpr bool GATHER = false, FP8 = false; static constexpr int SB = 127;
    const bf16_t* kvc; const char* Bt; unsigned lda2, ldb2; size_t kstepA; int ntk, G, c;
    __device__ __forceinline__ bool next(int i, Unit& u) const { const int L = i * G + c; if (L >= 32) return false; u.pm = L & 15; u.pn = 0; u.e = L >> 4; u.part = 0; return true; }
    __device__ __forceinline__ const char* abase() const { return (const char*)kvc; }
    __device__ __forceinline__ const char* bbase() const { return Bt; }
    __device__ __forceinline__ unsigned a_off(const Unit& u) const { const int bg = u.pm >> 1; return (unsigned)(((size_t)u.e * M * 128 + ((size_t)bg * T + 4096 * (u.pm & 1)) * 64) * 2); }
    __device__ __forceinline__ unsigned b_off(const Unit& u) const { return (unsigned)u.e * 256u * 2048u * 2u; }
    __device__ __forceinline__ bool keep(const Unit&) const { return false; }
    __device__ __forceinline__ void a_gather(const Unit&, int, Off4&) const {}
};
struct EpiCmp { static constexpr bool PERM = false;
    float* h1; const float* bias1;
    __device__ __forceinline__ void mid(Acc&, const Unit&, int, int, int, int) const {}
    __device__ __forceinline__ void operator()(const Acc& acc, const Unit& u, int wr, int wc, int fr, int fq) const {
        const int row0 = u.pm * BM + wr * 64 + fr, col0 = wc * 32 + 4 * fq;
        f32x4 bcv[2];
#pragma unroll
        for (int n = 0; n < 2; ++n) bcv[n] = *(const f32x4*)(bias1 + u.e * 128 + col0 + n * 16);
#pragma unroll
        for (int ai = 0; ai < 2; ++ai)
#pragma unroll
            for (int m = 0; m < 4; ++m) { const size_t row = (size_t)u.e * 4096 + row0 + ai * HALF + m * 16;
#pragma unroll
                for (int n = 0; n < 2; ++n) { const int c = col0 + n * 16; f32x4 v = acc[ai][0][m][n] + bcv[n];
#pragma unroll
                    for (int j = 0; j < 4; ++j) { const float t = v[j]; v[j] = 0.5f * t * (1.f + tanhf(0.7978845608028654f * (t + 0.044715f * t * t * t))); }
                    *(f32x4*)(h1 + row * 128 + c) = v; } }
    }
};
}

namespace nsa {
typedef short bf16x8 __attribute__((ext_vector_type(8)));
typedef short s16x4 __attribute__((ext_vector_type(4)));
typedef float f32x16 __attribute__((ext_vector_type(16)));
typedef unsigned u32x4 __attribute__((ext_vector_type(4)));
constexpr int L_K = 0, L_V = 16384, L_IMP = 32768, IMP_LD = 132, L_SEL = L_IMP + 64 * IMP_LD * 4, L_WSF = L_SEL + 1024, L_OST = L_WSF + 2048, L_END = L_OST + 65536;
constexpr float C2 = 0.125f * 1.4426950408889634f, THR = 6.f;
__device__ __forceinline__ s16x4 vtr(const LAS unsigned char* p) { typedef short v4i16_t __attribute__((ext_vector_type(4))); return __builtin_bit_cast(s16x4, __builtin_amdgcn_ds_read_tr16_b64_v4i16((LAS v4i16_t*)p)); }
template <int OFF> __device__ __forceinline__ s16x4 vtra(const LAS unsigned char* p) { s16x4 r; asm volatile("ds_read_b64_tr_b16 %0, %1 offset:%2" : "=v"(r) : "v"(p), "n"(OFF) : "memory"); return r; }
__device__ __forceinline__ float swap_max(float v) { auto rr = __builtin_amdgcn_permlane32_swap(__float_as_uint(v), __float_as_uint(v), false, false); return fmaxf(__uint_as_float(rr[0]), __uint_as_float(rr[1])); }
__device__ __forceinline__ float swap_sum(float v) { auto rr = __builtin_amdgcn_permlane32_swap(__float_as_uint(v), __float_as_uint(v), false, false); return __uint_as_float(rr[0]) + __uint_as_float(rr[1]); }
__device__ __forceinline__ unsigned pk(float lo, float hi) { return pg8::cvt_pk_bf16(lo, hi); }

struct Ctx { int tid, lane, wid, r32, hi, ksw; LAS unsigned char* lds; LAS float* wsf; };

__device__ __forceinline__ void qkt(f32x16& p0, f32x16& p1, const LAS unsigned char* kp, const bf16x8 (&qr)[4], int sw) {
    bf16x8 kf[8];
#pragma unroll
    for (int d0 = 0; d0 < 4; ++d0) { const int co = ((2 * d0) ^ sw) * 16; kf[2 * d0] = *(const LAS bf16x8*)(kp + co); kf[2 * d0 + 1] = *(const LAS bf16x8*)(kp + 4096 + co); }
    __builtin_amdgcn_sched_barrier(0);
    p0 = __builtin_amdgcn_mfma_f32_32x32x16_bf16(kf[0], qr[0], (f32x16){0.f,0.f,0.f,0.f,0.f,0.f,0.f,0.f,0.f,0.f,0.f,0.f,0.f,0.f,0.f,0.f}, 0, 0, 0);
    p1 = __builtin_amdgcn_mfma_f32_32x32x16_bf16(kf[1], qr[0], (f32x16){0.f,0.f,0.f,0.f,0.f,0.f,0.f,0.f,0.f,0.f,0.f,0.f,0.f,0.f,0.f,0.f}, 0, 0, 0);
#pragma unroll
    for (int d0 = 1; d0 < 4; ++d0) { p0 = __builtin_amdgcn_mfma_f32_32x32x16_bf16(kf[2 * d0], qr[d0], p0, 0, 0, 0); p1 = __builtin_amdgcn_mfma_f32_32x32x16_bf16(kf[2 * d0 + 1], qr[d0], p1, 0, 0, 0); }
}
__device__ __forceinline__ void pv(f32x16 (&o)[2], const LAS unsigned char* vp, const f32x16& p0, const f32x16& p1) {
    u32x4 pw[4];
    pw[0] = (u32x4){pk(p0[0], p0[1]), pk(p0[2], p0[3]), pk(p0[4], p0[5]), pk(p0[6], p0[7])}; pw[1] = (u32x4){pk(p0[8], p0[9]), pk(p0[10], p0[11]), pk(p0[12], p0[13]), pk(p0[14], p0[15])};
    pw[2] = (u32x4){pk(p1[0], p1[1]), pk(p1[2], p1[3]), pk(p1[4], p1[5]), pk(p1[6], p1[7])}; pw[3] = (u32x4){pk(p1[8], p1[9]), pk(p1[10], p1[11]), pk(p1[12], p1[13]), pk(p1[14], p1[15])};
    s16x4 vlo[8], vhi[8];
#pragma unroll
    for (int j = 0; j < 8; ++j) { vlo[j] = vtr(vp + (j >> 2) * 4096 + (j & 3) * 1024); vhi[j] = vtr(vp + (j >> 2) * 4096 + (j & 3) * 1024 + 512); }
    __builtin_amdgcn_sched_barrier(0);
#pragma unroll
    for (int j = 0; j < 8; ++j) { const s16x4 lo = vlo[j], hh = vhi[j];
        o[j >> 2] = __builtin_amdgcn_mfma_f32_32x32x16_bf16(__builtin_bit_cast(bf16x8, pw[j & 3]), (bf16x8){lo[0], lo[1], lo[2], lo[3], hh[0], hh[1], hh[2], hh[3]}, o[j >> 2], 0, 0, 0); }
}
__device__ __forceinline__ void scale_o(f32x16 (&o)[2], const Ctx& c, float f) {
    if (c.hi == 0) c.wsf[c.r32] = f;
#pragma unroll
    for (int g4 = 0; g4 < 4; ++g4) { const f32x4 w = *(const LAS f32x4*)(c.wsf + 8 * g4 + 4 * c.hi);
#pragma unroll
        for (int j = 0; j < 4; ++j) { o[0][4 * g4 + j] *= w[j]; o[1][4 * g4 + j] *= w[j]; } }
}
template <bool FIRST>
__device__ __forceinline__ void acc_y(const f32x16 (&o)[2], const Ctx& c, float f) {
    if (c.hi == 0) c.wsf[c.r32] = f;
    LAS float* stg = (LAS float*)(c.lds + L_OST + c.wid * 8192);
#pragma unroll
    for (int g4 = 0; g4 < 4; ++g4) { const f32x4 w = *(const LAS f32x4*)(c.wsf + 8 * g4 + 4 * c.hi);
#pragma unroll
        for (int j = 0; j < 4; ++j) { const int q = 8 * g4 + 4 * c.hi + j; LAS float* y0 = stg + q * 64 + c.r32;
            if (FIRST) { y0[0] = o[0][4 * g4 + j] * w[j]; y0[32] = o[1][4 * g4 + j] * w[j]; } else { y0[0] += o[0][4 * g4 + j] * w[j]; y0[32] += o[1][4 * g4 + j] * w[j]; } } }
}
template <bool HAS_O>
__device__ __forceinline__ void softmax_tile(f32x16& p0, f32x16& p1, float& mref, float& l, f32x16 (&o)[2], const Ctx& c, const bool alive = true) {
    float rm = fmaxf(p0[0], p1[0]);
#pragma unroll
    for (int r = 1; r < 16; ++r) rm = __builtin_fmaxf(__builtin_fmaxf(rm, p0[r]), p1[r]);
    rm = alive ? swap_max(rm) * C2 : -INFINITY;
    const bool need = rm > mref + THR;
    if (__any(need)) {
        const float mnew = need ? rm : mref, f = __builtin_amdgcn_exp2f(mref - mnew);
        l *= f; mref = mnew;
        if constexpr (HAS_O) scale_o(o, c, f);
    }
    const float nm = alive ? -mref : -INFINITY;
#pragma unroll
    for (int r = 0; r < 16; ++r) { p0[r] = __builtin_amdgcn_exp2f(__builtin_fmaf(p0[r], C2, nm)); p1[r] = __builtin_amdgcn_exp2f(__builtin_fmaf(p1[r], C2, nm)); }
    const f32x16 ps = p0 + p1;
    l += ((ps[0] + ps[1]) + (ps[2] + ps[3])) + ((ps[4] + ps[5]) + (ps[6] + ps[7])) + (((ps[8] + ps[9]) + (ps[10] + ps[11])) + ((ps[12] + ps[13]) + (ps[14] + ps[15])));
}

__device__ __forceinline__ int kslot_off(int s) { return L_K + ((s & 1) << 13) + ((s >> 1) << 15); }
__device__ __forceinline__ int vslot_off(int s) { return L_V + ((s & 1) << 13) + ((s >> 1) << 15); }
static_assert(L_K == 0 && L_V == 16384 && L_IMP == 32768, "slot maps");
__device__ __forceinline__ void dma16(const char* base, unsigned off, const Ctx& c, int ldsoff) {
    __builtin_amdgcn_global_load_lds((const unsigned*)(base + off), (LAS unsigned*)(c.lds + ldsoff + c.wid * 1024), 16, 0, 0); }
template <int NS, class FB>
__device__ __forceinline__ void tile_loop(int nt, const bf16_t* kb, const bf16_t* vb, int pitch, const Ctx& c, const bf16x8 (&qr)[4], FB body) {
    const size_t ts = (size_t)64 * pitch;
    constexpr int KD = NS == 4 ? 3 : 2, VD = NS == 4 ? 2 : 1;
    const LAS unsigned char* kq = c.lds + c.r32 * 128;
    const int vq = ((c.lane >> 4) & 1) * 32 + (c.lane & 3) * 8 + (4 * c.hi + ((c.lane & 15) >> 2)) * 64;
    const char* const kB = pg8::uni((const char*)kb); const char* const vB = pg8::uni((const char*)vb); const unsigned tsb = (unsigned)ts * 2u;
    unsigned kl, vl;
    { const int key = c.tid >> 3, cp = c.tid & 7; kl = (unsigned)(key * pitch + (cp ^ ((key >> 1) & 7)) * 8) * 2u;
      const int w = c.tid >> 6, ln = c.tid & 63; vl = (unsigned)((16 * (w & 3) + (ln >> 2)) * pitch + (w >> 2) * 32 + (ln & 3) * 8) * 2u; }
    dma16(kB, kl, c, kslot_off(0)); dma16(vB, vl, c, vslot_off(0));
    if (nt > 1) dma16(kB, tsb + kl, c, kslot_off(1));
    asm volatile("s_waitcnt vmcnt(0)" ::: "memory"); __builtin_amdgcn_s_barrier(); asm volatile("" ::: "memory");
    if (NS == 4) { if (nt > 2) dma16(kB, 2u * tsb + kl, c, kslot_off(2)); if (nt > 1) dma16(vB, tsb + vl, c, vslot_off(1)); }
    f32x16 pa0, pa1, pb0, pb1;
    qkt(pa0, pa1, kq + kslot_off(0), qr, c.ksw);
    asm volatile("s_waitcnt lgkmcnt(0)" ::: "memory"); __builtin_amdgcn_s_barrier(); asm volatile("" ::: "memory");
#define NSA_STEP(t, C0, C1, N0, N1, NEXT) do { \
        const bool ik = (t) + KD < nt, iv = (t) + VD < nt; \
        if (ik) dma16(kB, (unsigned)((t) + KD) * tsb + kl, c, kslot_off(((t) + KD) & (NS - 1))); \
        if (iv) dma16(vB, (unsigned)((t) + VD) * tsb + vl, c, vslot_off(((t) + VD) & (NS - 1))); \
        if (NEXT) qkt(N0, N1, kq + kslot_off(((t) + 1) & (NS - 1)), qr, c.ksw); \
        body((t), c.lds + vslot_off((t) & (NS - 1)) + vq, C0, C1); \
        if (NS == 4 && ik) asm volatile("s_waitcnt vmcnt(2) lgkmcnt(0)" ::: "memory"); \
        else if (NS == 4 && iv) asm volatile("s_waitcnt vmcnt(1) lgkmcnt(0)" ::: "memory"); \
        else asm volatile("s_waitcnt vmcnt(0) lgkmcnt(0)" ::: "memory"); \
        __builtin_amdgcn_s_barrier(); asm volatile("" ::: "memory"); } while (0)
    int tt = 0;
    for (; tt + 2 < nt; tt += 2) { NSA_STEP(tt, pa0, pa1, pb0, pb1, true); NSA_STEP(tt + 1, pb0, pb1, pa0, pa1, true); }
    if (tt + 2 == nt) { NSA_STEP(tt, pa0, pa1, pb0, pb1, true); NSA_STEP(tt + 1, pb0, pb1, pa0, pa1, false); }
    else { NSA_STEP(tt, pa0, pa1, pb0, pb1, false); }
#undef NSA_STEP
}
__device__ __forceinline__ void tile_loop4_prefetch(int nt, const bf16_t* kb, const bf16_t* vb, const Ctx& c) {
    constexpr int pitch = 64; const unsigned tsb = 64u * pitch * 2u;
    const char* const kB = pg8::uni((const char*)kb); const char* const vB = pg8::uni((const char*)vb);
    const int key = c.tid >> 3, cp = c.tid & 7; const unsigned kl = (unsigned)(key * pitch + (cp ^ ((key >> 1) & 7)) * 8) * 2u;
    const int w = c.tid >> 6, ln = c.tid & 63; const unsigned vl = (unsigned)((16 * (w & 3) + (ln >> 2)) * pitch + (w >> 2) * 32 + (ln & 3) * 8) * 2u;
    dma16(kB, kl, c, kslot_off(0)); dma16(vB, vl, c, vslot_off(0));
    if (nt > 1) dma16(kB, tsb + kl, c, kslot_off(1));
}
template <bool PRE = false, class FM>
__device__ __forceinline__ void tile_loop4(int nt, const bf16_t* kb, const bf16_t* vb, const Ctx& c, const bf16x8 (&qr)[4], float& mref, float& l, f32x16 (&o)[2], FM maskf) {
    constexpr int pitch = 64; const unsigned tsb = 64u * pitch * 2u;
    const LAS unsigned char* kq = c.lds + c.r32 * 128;
    const int vq = ((c.lane >> 4) & 1) * 32 + (c.lane & 3) * 8 + (4 * c.hi + ((c.lane & 15) >> 2)) * 64;
    const char* const kB = pg8::uni((const char*)kb); const char* const vB = pg8::uni((const char*)vb);
    unsigned kl, vl;
    { const int key = c.tid >> 3, cp = c.tid & 7; kl = (unsigned)(key * pitch + (cp ^ ((key >> 1) & 7)) * 8) * 2u;
      const int w = c.tid >> 6, ln = c.tid & 63; vl = (unsigned)((16 * (w & 3) + (ln >> 2)) * pitch + (w >> 2) * 32 + (ln & 3) * 8) * 2u; }
    if (!PRE) { dma16(kB, kl, c, kslot_off(0)); dma16(vB, vl, c, vslot_off(0));
        if (nt > 1) dma16(kB, tsb + kl, c, kslot_off(1)); }
    asm volatile("s_waitcnt vmcnt(0)" ::: "memory"); __builtin_amdgcn_s_barrier(); asm volatile("" ::: "memory");
    if (nt > 2) dma16(kB, 2u * tsb + kl, c, kslot_off(2));
    if (nt > 1) dma16(vB, tsb + vl, c, vslot_off(1));
    f32x16 pa0, pa1, pb0, pb1;
    qkt(pa0, pa1, kq + kslot_off(0), qr, c.ksw);
    asm volatile("s_waitcnt lgkmcnt(0)" ::: "memory"); __builtin_amdgcn_s_barrier(); asm volatile("" ::: "memory");
#define SB() __builtin_amdgcn_sched_barrier(0)
#define NSA_STEP4(t, C0, C1, N0, N1, NEXT) do { \
        const bool ik = (t) + 3 < nt, iv = (t) + 2 < nt; \
        if (ik) dma16(kB, (unsigned)((t) + 3) * tsb + kl, c, kslot_off(((t) + 3) & 3)); \
        if (iv) dma16(vB, (unsigned)((t) + 2) * tsb + vl, c, vslot_off(((t) + 2) & 3)); \
        bf16x8 kf[4]; s16x4 vlo[4], vhi[4], wlo[4], whi[4]; \
        const LAS unsigned char* kp_ = kq + kslot_off(((t) + 1) & 3); \
        if (NEXT) { _Pragma("unroll") for (int d0 = 0; d0 < 2; ++d0) { const int co = ((2 * d0) ^ c.ksw) * 16; kf[2 * d0] = *(const LAS bf16x8*)(kp_ + co); kf[2 * d0 + 1] = *(const LAS bf16x8*)(kp_ + 4096 + co); } } \
        const LAS unsigned char* vp_ = c.lds + vslot_off((t) & 3) + vq; \
        vlo[0] = vtra<0>(vp_); vhi[0] = vtra<512>(vp_); vlo[1] = vtra<1024>(vp_); vhi[1] = vtra<1536>(vp_); vlo[2] = vtra<2048>(vp_); vhi[2] = vtra<2560>(vp_); vlo[3] = vtra<3072>(vp_); vhi[3] = vtra<3584>(vp_); \
        SB(); \
        const bool alive = maskf((t), C0, C1); \
        float rm = fmaxf(C0[0], C1[0]); \
        _Pragma("unroll") for (int r = 1; r < 16; ++r) rm = __builtin_fmaxf(__builtin_fmaxf(rm, C0[r]), C1[r]); \
        rm = alive ? swap_max(rm) * C2 : -INFINITY; \
        const bool need = rm > mref + THR; \
        if (__any(need)) { const float mnew = need ? rm : mref, f = __builtin_amdgcn_exp2f(mref - mnew); l *= f; mref = mnew; scale_o(o, c, f); } \
        const float nm = alive ? -mref : -INFINITY; \
        asm volatile("s_waitcnt lgkmcnt(0)" ::: "memory"); SB(); \
        if (NEXT) { N0 = __builtin_amdgcn_mfma_f32_32x32x16_bf16(kf[0], qr[0], (f32x16){0.f,0.f,0.f,0.f,0.f,0.f,0.f,0.f,0.f,0.f,0.f,0.f,0.f,0.f,0.f,0.f}, 0, 0, 0); } \
        _Pragma("unroll") for (int r = 0; r < 4; ++r) C0[r] = __builtin_amdgcn_exp2f(__builtin_fmaf(C0[r], C2, nm)); SB(); \
        if (NEXT) { N1 = __builtin_amdgcn_mfma_f32_32x32x16_bf16(kf[1], qr[0], (f32x16){0.f,0.f,0.f,0.f,0.f,0.f,0.f,0.f,0.f,0.f,0.f,0.f,0.f,0.f,0.f,0.f}, 0, 0, 0); } \
        _Pragma("unroll") for (int r = 4; r < 8; ++r) C0[r] = __builtin_amdgcn_exp2f(__builtin_fmaf(C0[r], C2, nm)); SB(); \
        if (NEXT) { N0 = __builtin_amdgcn_mfma_f32_32x32x16_bf16(kf[2], qr[1], N0, 0, 0, 0); } \
        _Pragma("unroll") for (int r = 8; r < 12; ++r) C0[r] = __builtin_amdgcn_exp2f(__builtin_fmaf(C0[r], C2, nm)); SB(); \
        if (NEXT) { N1 = __builtin_amdgcn_mfma_f32_32x32x16_bf16(kf[3], qr[1], N1, 0, 0, 0); } \
        SB(); \
        if (NEXT) { _Pragma("unroll") for (int d0 = 2; d0 < 4; ++d0) { const int co = ((2 * d0) ^ c.ksw) * 16; kf[2 * d0 - 4] = *(const LAS bf16x8*)(kp_ + co); kf[2 * d0 - 3] = *(const LAS bf16x8*)(kp_ + 4096 + co); } }        \
        SB(); \
        _Pragma("unroll") for (int r = 12; r < 16; ++r) C0[r] = __builtin_amdgcn_exp2f(__builtin_fmaf(C0[r], C2, nm)); SB(); \
        if (NEXT) { N0 = __builtin_amdgcn_mfma_f32_32x32x16_bf16(kf[0], qr[2], N0, 0, 0, 0); } \
        _Pragma("unroll") for (int r = 0; r < 4; ++r) C1[r] = __builtin_amdgcn_exp2f(__builtin_fmaf(C1[r], C2, nm)); SB(); \
        if (NEXT) { N1 = __builtin_amdgcn_mfma_f32_32x32x16_bf16(kf[1], qr[2], N1, 0, 0, 0); } \
        _Pragma("unroll") for (int r = 4; r < 8; ++r) C1[r] = __builtin_amdgcn_exp2f(__builtin_fmaf(C1[r], C2, nm)); SB(); \
        if (NEXT) { N0 = __builtin_amdgcn_mfma_f32_32x32x16_bf16(kf[2], qr[3], N0, 0, 0, 0); } \
        _Pragma("unroll") for (int r = 8; r < 12; ++r) C1[r] = __builtin_amdgcn_exp2f(__builtin_fmaf(C1[r], C2, nm)); SB(); \
        if (NEXT) { N1 = __builtin_amdgcn_mfma_f32_32x32x16_bf16(kf[3], qr[3], N1, 0, 0, 0); } \
        _Pragma("unroll") for (int r = 12; r < 16; ++r) C1[r] = __builtin_amdgcn_exp2f(__builtin_fmaf(C1[r], C2, nm)); SB(); \
        wlo[0] = vtra<4096>(vp_); whi[0] = vtra<4608>(vp_); wlo[1] = vtra<5120>(vp_); whi[1] = vtra<5632>(vp_); wlo[2] = vtra<6144>(vp_); whi[2] = vtra<6656>(vp_); wlo[3] = vtra<7168>(vp_); whi[3] = vtra<7680>(vp_);        \
        SB(); \
        { const f32x16 ps = C0 + C1; \
          l += ((ps[0] + ps[1]) + (ps[2] + ps[3])) + ((ps[4] + ps[5]) + (ps[6] + ps[7])) + (((ps[8] + ps[9]) + (ps[10] + ps[11])) + ((ps[12] + ps[13]) + (ps[14] + ps[15]))); } \
        { u32x4 pw[4]; \
          pw[0] = (u32x4){pk(C0[0], C0[1]), pk(C0[2], C0[3]), pk(C0[4], C0[5]), pk(C0[6], C0[7])}; pw[1] = (u32x4){pk(C0[8], C0[9]), pk(C0[10], C0[11]), pk(C0[12], C0[13]), pk(C0[14], C0[15])}; \
          pw[2] = (u32x4){pk(C1[0], C1[1]), pk(C1[2], C1[3]), pk(C1[4], C1[5]), pk(C1[6], C1[7])}; pw[3] = (u32x4){pk(C1[8], C1[9]), pk(C1[10], C1[11]), pk(C1[12], C1[13]), pk(C1[14], C1[15])}; \
          SB(); asm volatile("s_waitcnt lgkmcnt(0)" ::: "memory"); SB(); \
          _Pragma("unroll") for (int ks = 0; ks < 4; ++ks) { const s16x4 lo_ = vlo[ks], hh_ = vhi[ks]; \
              o[0] = __builtin_amdgcn_mfma_f32_32x32x16_bf16(__builtin_bit_cast(bf16x8, pw[ks]), (bf16x8){lo_[0], lo_[1], lo_[2], lo_[3], hh_[0], hh_[1], hh_[2], hh_[3]}, o[0], 0, 0, 0); } \
          _Pragma("unroll") for (int ks = 0; ks < 4; ++ks) { const s16x4 lo_ = wlo[ks], hh_ = whi[ks]; \
              o[1] = __builtin_amdgcn_mfma_f32_32x32x16_bf16(__builtin_bit_cast(bf16x8, pw[ks]), (bf16x8){lo_[0], lo_[1], lo_[2], lo_[3], hh_[0], hh_[1], hh_[2], hh_[3]}, o[1], 0, 0, 0); } } \
        if (ik) asm volatile("s_waitcnt vmcnt(2) lgkmcnt(0)" ::: "memory"); \
        else if (iv) asm volatile("s_waitcnt vmcnt(1) lgkmcnt(0)" ::: "memory"); \
        else asm volatile("s_waitcnt vmcnt(0) lgkmcnt(0)" ::: "memory"); \
        __builtin_amdgcn_s_barrier(); asm volatile("" ::: "memory"); } while (0)
    int tt = 0;
    for (; tt + 2 < nt; tt += 2) { NSA_STEP4(tt, pa0, pa1, pb0, pb1, true); NSA_STEP4(tt + 1, pb0, pb1, pa0, pa1, true); }
    if (tt + 2 == nt) { NSA_STEP4(tt, pa0, pa1, pb0, pb1, true); NSA_STEP4(tt + 1, pb0, pb1, pa0, pa1, false); }
    else { NSA_STEP4(tt, pa0, pa1, pb0, pb1, false); }
#undef NSA_STEP4
#undef SB
}
__device__ __forceinline__ void unit(int b, int g, int i, const bf16_t* proj, const bf16_t* kvc, const float* gates, const bf16_t* kc, const bf16_t* vc, bf16_t* ya, LAS unsigned char* lds) {
    Ctx c; { int t_ = threadIdx.x; asm volatile("" : "+v"(t_)); c.tid = t_; }
    c.lane = c.tid & 63; c.wid = __builtin_amdgcn_readfirstlane(c.tid >> 6); c.r32 = c.lane & 31; c.hi = c.lane >> 5; c.lds = lds;
    c.wsf = (LAS float*)(lds + L_WSF + c.wid * 256);
    c.ksw = ((c.r32 >> 1) & 7) ^ c.hi;
    const int tokl = 8 * c.wid + (c.r32 >> 2), h = c.r32 & 3, t = 64 * i + tokl;
    const size_t mrow = (size_t)b * T + t;
    LAS float* imp = (LAS float*)(lds + L_IMP);
    for (int k = c.tid; k < 64 * IMP_LD; k += 512) imp[k] = 0.f;
    bf16x8 qr[4];
#pragma unroll
    for (int d0 = 0; d0 < 4; ++d0) qr[d0] = *(const bf16x8*)(proj + mrow * LDP + C_Q + (g * 4 + h) * 64 + d0 * 16 + c.hi * 8);
    const float* gl = gates + mrow * 32 + (g * 4 + h) * 3;
    const float gt0 = sigmoidf_(gl[0]), gt1 = sigmoidf_(gl[1]), gt2 = sigmoidf_(gl[2]);
    const size_t tsz = (size_t)M * 128, bgo = (size_t)(b * 2 + g) * T * 64;
    const bf16_t* kslc = kvc + 2 * tsz + bgo; const bf16_t* vslc = kvc + 3 * tsz + bgo; const bf16_t* kwin = kvc + 4 * tsz + bgo; const bf16_t* vwin = kvc + 5 * tsz + bgo;
    const bf16_t* kcb = kc + (size_t)(b * 2 + g) * 512 * 64; const bf16_t* vcb = vc + (size_t)(b * 2 + g) * 512 * 64;
    f32x16 o[2];
    __syncthreads();
    const int ncv = (t >= 31) ? min((t - 31) / 16 + 1, 511) : 0;
    const int ntc = (4 * i + 3 + 63) / 64;
    float mref = -1e30f, l = 0.f;
    tile_loop<2>(ntc, kcb, vcb, 64, c, qr, [&](int tt, const LAS unsigned char* vp, f32x16& p0, f32x16& p1) {
        const int kb = 64 * tt + 4 * c.hi;
        if (!__all(64 * tt + 64 <= ncv)) {
#pragma unroll
            for (int r = 0; r < 16; ++r) { const int key = kb + (r & 3) + 8 * (r >> 2); if (key >= ncv) p0[r] = -INFINITY; if (key + 32 >= ncv) p1[r] = -INFINITY; }
        }
        softmax_tile<false>(p0, p1, mref, l, o, c);
    });
    {
        const float lt = swap_sum(l), invl = lt > 0.f ? 1.f / lt : 0.f;
#pragma unroll
        for (int r = 0; r < 16; ++r) { o[0][r] = 0.f; o[1][r] = 0.f; }
        tile_loop<2>(ntc, kcb, vcb, 64, c, qr, [&](int tt, const LAS unsigned char* vp, f32x16& p0, f32x16& p1) {
            const int kb = 64 * tt + 4 * c.hi;
#pragma unroll
            for (int r = 0; r < 16; ++r) { const int key = kb + (r & 3) + 8 * (r >> 2);
                p0[r] = (key >= ncv) ? 0.f : __builtin_amdgcn_exp2f(__builtin_fmaf(p0[r], C2, -mref)) * invl;
                p1[r] = (key + 32 >= ncv) ? 0.f : __builtin_amdgcn_exp2f(__builtin_fmaf(p1[r], C2, -mref)) * invl; }
#pragma unroll
            for (int sub = 0; sub < 2; ++sub)
#pragma unroll
                for (int g4 = 0; g4 < 4; ++g4) {
                    const f32x16& pp = sub ? p1 : p0;
                    float av = 2.f * (pp[4 * g4] + pp[4 * g4 + 1] + pp[4 * g4 + 2]) + pp[4 * g4 + 3], bv = pp[4 * g4 + 3];
                    av += __shfl_xor(av, 1); av += __shfl_xor(av, 2); bv += __shfl_xor(bv, 1); bv += __shfl_xor(bv, 2);
                    if (h == 0) { const int bk = 16 * tt + 8 * sub + 2 * g4 + c.hi; LAS float* ip = imp + tokl * IMP_LD + bk;
                        __hip_atomic_fetch_add(ip, av, __ATOMIC_RELAXED, __HIP_MEMORY_SCOPE_WORKGROUP); __hip_atomic_fetch_add(ip + 1, bv, __ATOMIC_RELAXED, __HIP_MEMORY_SCOPE_WORKGROUP); }
                }
            pv(o, vp, p0, p1);
        });
        acc_y<true>(o, c, gt0);
    }
    tile_loop4_prefetch(i + 1, kslc, vslc, c);
    unsigned mw0, mw1, mw2, mw3;
    if (i < 16) { mw0 = (1u << (i + 1)) - 1u; mw1 = 0u; mw2 = 0u; mw3 = 0u; }
    else {
        LAS unsigned* selm = (LAS unsigned*)(lds + L_SEL);
        for (int tl = 0; tl < 8; tl += 2) {
            const int tkA = 8 * c.wid + tl, tkB = tkA + 1;
            float v0A = imp[tkA * IMP_LD + c.lane], v1A = imp[tkA * IMP_LD + 64 + c.lane], v0B = imp[tkB * IMP_LD + c.lane], v1B = imp[tkB * IMP_LD + 64 + c.lane];
            const bool ok0 = (c.lane >= 1 && c.lane <= i - 2), ok1 = (c.lane + 64 <= i - 2);
            v0A = ok0 ? v0A : -1.f; v1A = ok1 ? v1A : -1.f; v0B = ok0 ? v0B : -1.f; v1B = ok1 ? v1B : -1.f;
            unsigned long long f0 = 1ull, f1 = 0ull;
            if (i - 1 < 64) f0 |= 1ull << (i - 1); else f1 |= 1ull << (i - 1 - 64);
            if (i < 64) f0 |= 1ull << i; else f1 |= 1ull << (i - 64);
            const int k0A = __float_as_int(v0A), k1A = __float_as_int(v1A), k0B = __float_as_int(v0B), k1B = __float_as_int(v1B);
            int KA = 0, KB = 0;
#pragma unroll
            for (int bit = 30; bit >= 0; --bit) { const int trA = KA | (1 << bit), trB = KB | (1 << bit);
                const int cA = __popcll(__ballot(k0A >= trA)) + __popcll(__ballot(k1A >= trA)), cB = __popcll(__ballot(k0B >= trB)) + __popcll(__ballot(k1B >= trB));
                if (cA >= 13) KA = trA; if (cB >= 13) KB = trB; }
#pragma unroll
            for (int q = 0; q < 2; ++q) { const int K = q ? KB : KA, k0 = q ? k0B : k0A, k1 = q ? k1B : k1A, tk = q ? tkB : tkA;
                unsigned long long s0 = f0, s1 = f1;
                const unsigned long long g0 = __ballot(k0 > K), g1 = __ballot(k1 > K);
                unsigned long long e0 = __ballot(k0 == K), e1 = __ballot(k1 == K);
                s0 |= g0; s1 |= g1;
                int needn = 13 - (__popcll(g0) + __popcll(g1));
                while (needn > 0 && (e0 | e1)) { if (e0) { s0 |= e0 & (~e0 + 1ull); e0 &= e0 - 1ull; } else { s1 |= e1 & (~e1 + 1ull); e1 &= e1 - 1ull; } --needn; }
                if (c.lane == 0) { selm[tk * 4 + 0] = (unsigned)s0; selm[tk * 4 + 1] = (unsigned)(s0 >> 32); selm[tk * 4 + 2] = (unsigned)s1; selm[tk * 4 + 3] = (unsigned)(s1 >> 32); } }
        }
        const u32x4 mm = *(const LAS u32x4*)(selm + tokl * 4); mw0 = mm.x; mw1 = mm.y; mw2 = mm.z; mw3 = mm.w;
    }
    {
        mref = -1e30f; l = 0.f;
#pragma unroll
        for (int r = 0; r < 16; ++r) { o[0][r] = 0.f; o[1][r] = 0.f; }
        auto selbit = [&](int tt) { const unsigned wsel = tt < 32 ? mw0 : (tt < 64 ? mw1 : (tt < 96 ? mw2 : mw3)); return (bool)((wsel >> (tt & 31)) & 1u); };
        tile_loop4<true>(i + 1, kslc, vslc, c, qr, mref, l, o, [&](int tt, f32x16& p0, f32x16& p1) {
            if (tt == i) {
                asm volatile("" ::: "memory");
#pragma unroll
                for (int r = 0; r < 16; ++r) { const int kl = 4 * c.hi + (r & 3) + 8 * (r >> 2); p0[r] = kl <= tokl ? p0[r] : -INFINITY; p1[r] = kl + 32 <= tokl ? p1[r] : -INFINITY; }
            }
            return selbit(tt);
        });
        const float lt = swap_sum(l);
        acc_y<false>(o, c, lt > 0.f ? gt1 / lt : 0.f);
    }
    {
        mref = -1e30f; l = 0.f;
#pragma unroll
        for (int r = 0; r < 16; ++r) { o[0][r] = 0.f; o[1][r] = 0.f; }
        const int j0 = i >= 8 ? i - 8 : 0, ntw = i - j0 + 1;
        tile_loop4(ntw, kwin + (size_t)j0 * 64 * 64, vwin + (size_t)j0 * 64 * 64, c, qr, mref, l, o, [&](int tt, f32x16& p0, f32x16& p1) {
            const int jt = j0 + tt;
            if (jt == i) {
#pragma unroll
                for (int r = 0; r < 16; ++r) { const int kl = 4 * c.hi + (r & 3) + 8 * (r >> 2); if (kl > tokl) p0[r] = -INFINITY; if (kl + 32 > tokl) p1[r] = -INFINITY; }
            } else if (jt == i - 8) {
#pragma unroll
                for (int r = 0; r < 16; ++r) { const int kl = 4 * c.hi + (r & 3) + 8 * (r >> 2); if (kl <= tokl) p0[r] = -INFINITY; if (kl + 32 <= tokl) p1[r] = -INFINITY; }
            }
            return true;
        });
        const float lt = swap_sum(l);
        acc_y<false>(o, c, lt > 0.f ? gt2 / lt : 0.f);
    }
    {
        const LAS float* stg = (const LAS float*)(lds + L_OST + c.wid * 8192);
#pragma unroll
        for (int k = 0; k < 4; ++k) { const int ci = c.lane + 64 * k, tl = ci >> 5, wi = ci & 31;
            const f32x4 a0 = *(const LAS f32x4*)(stg + ci * 8), a1 = *(const LAS f32x4*)(stg + ci * 8 + 4);
            *(u32x4*)(ya + ((size_t)b * T + 64 * i + 8 * c.wid + tl) * 512 + g * 256 + wi * 8) = (u32x4){pk(a0[0], a0[1]), pk(a0[2], a0[3]), pk(a1[0], a1[1]), pk(a1[2], a1[3])}; }
    }
}
__device__ __forceinline__ void phase(const bf16_t* proj, const bf16_t* kvc, const float* gates, const bf16_t* kc, const bf16_t* vc, bf16_t* ya, LAS unsigned char* lds, int bid, int nb) {
    const int per = nb == 256 ? 4 : (1024 + nb - 1) / nb;
#pragma unroll 1
    for (int k = 0; k < per; ++k) {
        int bg, i;
        if (nb == 256) { const int v = (bid & 7) * 32 + (bid >> 3), s5 = v & 31; bg = v >> 5; i = k == 0 ? s5 : (k == 1 ? 63 - s5 : (k == 2 ? 64 + s5 : 127 - s5)); }
        else { const int u = bid + k * nb; if (u >= 1024) break; bg = u >> 7; i = 127 - (u & 127); }
        unit(bg >> 1, bg & 1, i, proj, kvc, gates, kc, vc, ya, lds);
    }
}
}

namespace mls {
using nsa::bf16x8; using nsa::s16x4; using nsa::f32x16; using nsa::u32x4; using nsa::vtr; using nsa::pk; using nsa::swap_sum;
constexpr int XLD = 136;
constexpr int L_XC = 0, L_XM = 17408, L_Q = 34816, L_K = 51200, L_KW = 67584, L_V = 83968, L_EA = 100352, L1_END = L_EA + 256;
__device__ __forceinline__ int vblk(int s, int e) { return ((e >> 5) * 4 + (s >> 4)) * 1024 + (s & 15) * 64 + (e & 31) * 2; }
__device__ __forceinline__ f32x16 zero16() { return (f32x16){0.f,0.f,0.f,0.f,0.f,0.f,0.f,0.f,0.f,0.f,0.f,0.f,0.f,0.f,0.f,0.f}; }

struct P1 { const bf16_t* proj; const float* gates; const float* w_conv; const float* b_conv; const float* b_i; const float* b_f; const bf16_t* wT;
            bf16_t* xc; bf16_t* mq; bf16_t* mk; bf16_t* mv; bf16_t* U; float* un; float* gB; float* gG; float* BL; };
__device__ __forceinline__ void ml1_unit(const P1& p, int b, int h, int c, LAS unsigned char* lds) {
    int t_ = threadIdx.x; asm volatile("" : "+v"(t_)); const int tid = t_, lane = tid & 63, wid = __builtin_amdgcn_readfirstlane(tid >> 6), r32 = lane & 31, hi = lane >> 5;
    const size_t m0 = (size_t)b * T + 64 * c; const int bh = b * 4 + h, unit = bh * 128 + c;
    __syncthreads();
    { const int t = tid >> 3, d0 = (tid & 7) * 16; float acc[16];
#pragma unroll
      for (int j = 0; j < 16; ++j) acc[j] = p.b_conv[h * 128 + d0 + j];
      u32x4 xm0 = (u32x4){0u, 0u, 0u, 0u}, xm1 = xm0;
#pragma unroll
      for (int r = 0; r < 4; ++r) { const int tt = 64 * c + t - 3 + r; u32x4 a0 = (u32x4){0u, 0u, 0u, 0u}, a1 = a0;
          if (tt >= 0) { const bf16_t* src = p.proj + ((size_t)b * T + tt) * LDP + C_XM + h * 128 + d0; a0 = *(const u32x4*)src; a1 = *(const u32x4*)(src + 8); }
          if (r == 3) { xm0 = a0; xm1 = a1; }
          f32x4 v0, v1, v2, v3; pg8::unpack8(a0, v0, v1); pg8::unpack8(a1, v2, v3);
          const float* wc = p.w_conv + r * 512 + h * 128 + d0;
#pragma unroll
          for (int j = 0; j < 4; ++j) { acc[j] += v0[j] * wc[j]; acc[4 + j] += v1[j] * wc[4 + j]; acc[8 + j] += v2[j] * wc[8 + j]; acc[12 + j] += v3[j] * wc[12 + j]; } }
#pragma unroll
      for (int j = 0; j < 16; ++j) acc[j] = acc[j] / (1.f + __expf(-acc[j]));
      const u32x4 c0 = (u32x4){pk(acc[0], acc[1]), pk(acc[2], acc[3]), pk(acc[4], acc[5]), pk(acc[6], acc[7])}, c1 = (u32x4){pk(acc[8], acc[9]), pk(acc[10], acc[11]), pk(acc[12], acc[13]), pk(acc[14], acc[15])};
      *(LAS u32x4*)(lds + L_XC + (t * XLD + d0) * 2) = c0; *(LAS u32x4*)(lds + L_XC + (t * XLD + d0 + 8) * 2) = c1;
      *(LAS u32x4*)(lds + L_XM + (t * XLD + d0) * 2) = xm0; *(LAS u32x4*)(lds + L_XM + (t * XLD + d0 + 8) * 2) = xm1;
      bf16_t* xo = p.xc + (m0 + t) * 512 + h * 128 + d0; *(u32x4*)xo = c0; *(u32x4*)(xo + 8) = c1; }
    if (wid == 0) {
        const float fp = p.gates[(m0 + lane) * 32 + 28 + h] + p.b_f[h], li = p.gates[(m0 + lane) * 32 + 24 + h] + p.b_i[h];
        float bs = fminf(fp, 0.f) - log1pf(__expf(-fabsf(fp)));
#pragma unroll
        for (int o = 1; o < 64; o <<= 1) { const float v = __shfl_up(bs, o); if (lane >= o) bs += v; }
        const float bl = __shfl(bs, 63);
        ((LAS float*)(lds + L_EA))[lane] = __expf(bl - bs + li);
        p.gB[(size_t)bh * T + 64 * c + lane] = bs; p.gG[(size_t)bh * T + 64 * c + lane] = li - bs; if (lane == 0) p.BL[unit] = bl;
    }
    __syncthreads();
    { const int tt = wid & 1, et = wid >> 1;
      f32x16 aq = zero16(), ak = zero16(), av = zero16();
      const LAS unsigned char* xcp = lds + L_XC + ((32 * tt + r32) * XLD + 8 * hi) * 2; const LAS unsigned char* xmp = lds + L_XM + ((32 * tt + r32) * XLD + 8 * hi) * 2;
      const bf16_t* wq = p.wT + (size_t)(0 * 4 + h) * 16384 + (size_t)(et * 512 + lane) * 8; const bf16_t* wk = wq + (size_t)4 * 128 * 128; const bf16_t* wv = wk + (size_t)4 * 128 * 128;
#pragma unroll
      for (int ks = 0; ks < 8; ++ks) {
          const bf16x8 xa = *(const LAS bf16x8*)(xcp + ks * 32), xb = *(const LAS bf16x8*)(xmp + ks * 32);
          aq = __builtin_amdgcn_mfma_f32_32x32x16_bf16(xa, *(const bf16x8*)(wq + ks * 512), aq, 0, 0, 0);
          ak = __builtin_amdgcn_mfma_f32_32x32x16_bf16(xa, *(const bf16x8*)(wk + ks * 512), ak, 0, 0, 0);
          av = __builtin_amdgcn_mfma_f32_32x32x16_bf16(xb, *(const bf16x8*)(wv + ks * 512), av, 0, 0, 0); }
      const LAS float* ea = (const LAS float*)(lds + L_EA);
#pragma unroll
      for (int r = 0; r < 16; ++r) { const int s = 32 * tt + (r & 3) + 8 * (r >> 2) + 4 * hi, o = vblk(s, 32 * et + r32); const float kk = ak[r] * 0.08838834764831845f;
          *(LAS bf16_t*)(lds + L_Q + o) = f2bf(aq[r]); *(LAS bf16_t*)(lds + L_K + o) = f2bf(kk); *(LAS bf16_t*)(lds + L_KW + o) = f2bf(kk * ea[s]); *(LAS bf16_t*)(lds + L_V + o) = f2bf(av[r]); } }
    __syncthreads();
#pragma unroll
    for (int i2 = 0; i2 < 2; ++i2) { const int cid = tid + 512 * i2, s = cid >> 4, e8 = cid & 15, o = vblk(s, e8 * 8); const size_t go = (m0 + s) * 512 + h * 128 + e8 * 8;
        *(u32x4*)(p.mq + go) = *(const LAS u32x4*)(lds + L_Q + o); *(u32x4*)(p.mk + go) = *(const LAS u32x4*)(lds + L_K + o); *(u32x4*)(p.mv + go) = *(const LAS u32x4*)(lds + L_V + o); }
    { const int dvt = wid >> 1; const int lo_ = ((lane >> 4) & 1) * 32 + (lane & 3) * 8 + (4 * hi + ((lane & 15) >> 2)) * 64;
      bf16_t* Uo = p.U + (size_t)unit * 16384;
#pragma unroll
      for (int j = 0; j < 2; ++j) { const int dkt = 2 * (wid & 1) + j; f32x16 u = zero16();
#pragma unroll
          for (int ks = 0; ks < 4; ++ks) {
              const s16x4 al = vtr(lds + L_V + lo_ + dvt * 4096 + ks * 1024), ah = vtr(lds + L_V + lo_ + dvt * 4096 + ks * 1024 + 512);
              const s16x4 bl = vtr(lds + L_KW + lo_ + dkt * 4096 + ks * 1024), bh2 = vtr(lds + L_KW + lo_ + dkt * 4096 + ks * 1024 + 512);
              u = __builtin_amdgcn_mfma_f32_32x32x16_bf16((bf16x8){al[0], al[1], al[2], al[3], ah[0], ah[1], ah[2], ah[3]}, (bf16x8){bl[0], bl[1], bl[2], bl[3], bh2[0], bh2[1], bh2[2], bh2[3]}, u, 0, 0, 0); }
#pragma unroll
          for (int r = 0; r < 16; ++r) Uo[(32 * dvt + (r & 3) + 8 * (r >> 2) + 4 * hi) * 128 + 32 * dkt + r32] = f2bf(u[r]); } }
    if (tid < 128) { float su = 0.f; for (int s = 0; s < 64; ++s) su += bf2f(*(const LAS bf16_t*)(lds + L_KW + vblk(s, tid))); p.un[(size_t)unit * 128 + tid] = su; }
}

__device__ __forceinline__ void ml2(const bf16_t* U, const float* un, const float* BL, bf16_t* Cst, float* nst, float* sm, int sb, int nsb) {
    const int tid = threadIdx.x, lane = tid & 63, w = tid >> 6;
    float* segS = sm; float* segF = sm + 8 * 256;
    for (int it = sb; it < 16 * 64; it += nsb) {
        const int bh = it >> 6, e0 = (it & 63) * 256 + 4 * lane; const size_t ub = (size_t)bh * 128 + 16 * w;
        f32x4 S = (f32x4){0.f, 0.f, 0.f, 0.f}; float F = 1.f;
        pg8::u32x2 ur[16]; float fr_[16];
#pragma unroll
        for (int j = 0; j < 16; ++j) { ur[j] = *(const pg8::u32x2*)(U + (ub + j) * 16384 + e0); fr_[j] = __expf(BL[ub + j]); }
#pragma unroll
        for (int j = 0; j < 16; ++j) { const f32x4 x = (f32x4){__uint_as_float(ur[j].x << 16), __uint_as_float(ur[j].x & 0xffff0000u), __uint_as_float(ur[j].y << 16), __uint_as_float(ur[j].y & 0xffff0000u)};
            S = S * fr_[j] + x; F *= fr_[j]; }
        __syncthreads();
        *(f32x4*)(segS + w * 256 + 4 * lane) = S; if (lane == 0) segF[w] = F;
        __syncthreads();
        f32x4 C = (f32x4){0.f, 0.f, 0.f, 0.f};
        for (int sgm = 0; sgm < w; ++sgm) C = C * segF[sgm] + *(const f32x4*)(segS + sgm * 256 + 4 * lane);
#pragma unroll
        for (int j = 0; j < 16; ++j) { const f32x4 x = (f32x4){__uint_as_float(ur[j].x << 16), __uint_as_float(ur[j].x & 0xffff0000u), __uint_as_float(ur[j].y << 16), __uint_as_float(ur[j].y & 0xffff0000u)};
            pg8::u32x2 o; o.x = pg8::cvt_pk_bf16(C[0], C[1]); o.y = pg8::cvt_pk_bf16(C[2], C[3]); *(pg8::u32x2*)(Cst + (ub + j) * 16384 + e0) = o;
            C = C * fr_[j] + x; }
    }
    const int gt = sb * 512 + tid, ngt = nsb * 512;
    for (int g = gt; g < 16 * 128; g += ngt) { const int bh = g >> 7, k = g & 127; float C = 0.f;
#pragma unroll 8
        for (int c = 0; c < 128; ++c) { const size_t u = (size_t)bh * 128 + c; nst[u * 128 + k] = C; C = __expf(BL[u]) * C + un[u * 128 + k]; } }
}

constexpr int L3_V = 0, L3_G = 16384  , L3_WSF = 16384 + 1024, L3_H = 16384 + 1024 + 2048  , L3_Q = L3_H + 64 * 132 * 4  ,
              L3_K = L3_Q + 64 * XLD * 2, L3_C = L3_K + 64 * XLD * 2  , L3_END = L3_C + 128 * XLD * 2;
struct P3 { const bf16_t* proj; const bf16_t* xc; const bf16_t* mq; const bf16_t* mk; const bf16_t* mv; const bf16_t* Cst; const float* nst; const float* gB; const float* gG;
            const float* mh_gain; const float* skip; bf16_t* yb; };
__device__ __forceinline__ void ml3_unit(const P3& p, int b, int h, int c, LAS unsigned char* lds) {
    int t_ = threadIdx.x; asm volatile("" : "+v"(t_)); const int tid = t_, lane = tid & 63, wid = __builtin_amdgcn_readfirstlane(tid >> 6), r32 = lane & 31, hi = lane >> 5;
    const size_t m0 = (size_t)b * T + 64 * c; const int bh = b * 4 + h, unit = bh * 128 + c;
    LAS float* gl = (LAS float*)(lds + L3_G);
    __syncthreads();
#pragma unroll
    for (int i2 = 0; i2 < 2; ++i2) { const int cid = tid + 512 * i2, s = cid >> 4, e8 = cid & 15; const size_t go = (m0 + s) * 512 + h * 128 + e8 * 8;
        const u32x4 vv = *(const u32x4*)(p.mv + go), qq = *(const u32x4*)(p.mq + go), kk = *(const u32x4*)(p.mk + go);
        const u32x4 c0 = *(const u32x4*)(p.Cst + (size_t)unit * 16384 + (size_t)cid * 8), c1 = *(const u32x4*)(p.Cst + (size_t)unit * 16384 + (size_t)(cid + 1024) * 8);
        *(LAS u32x4*)(lds + L3_V + vblk(s, e8 * 8)) = vv; *(LAS u32x4*)(lds + L3_Q + (s * XLD + e8 * 8) * 2) = qq; *(LAS u32x4*)(lds + L3_K + (s * XLD + e8 * 8) * 2) = kk;
        *(LAS u32x4*)(lds + L3_C + (s * XLD + e8 * 8) * 2) = c0; *(LAS u32x4*)(lds + L3_C + ((s + 64) * XLD + e8 * 8) * 2) = c1; }
    if (tid < 64) { gl[tid] = p.gB[(size_t)bh * T + 64 * c + tid]; gl[64 + tid] = p.gG[(size_t)bh * T + 64 * c + tid]; }
    else if (tid < 192) gl[128 + tid - 64] = p.nst[(size_t)unit * 128 + tid - 64];
    __syncthreads();
    const int tt = wid & 1, d0 = wid >> 1, t = 32 * tt + r32;
    bf16x8 qf[8];
#pragma unroll
    for (int ks = 0; ks < 8; ++ks) qf[ks] = *(const LAS bf16x8*)(lds + L3_Q + (t * XLD + 16 * ks + 8 * hi) * 2);
    const float bt = gl[t], ebt = __expf(bt);
    f32x16 o = zero16(); float den = 0.f;
    const int lo_ = ((lane >> 4) & 1) * 32 + (lane & 3) * 8 + (4 * hi + ((lane & 15) >> 2)) * 64;
    for (int st = 0; st <= tt; ++st) {
        f32x16 ps = zero16();
#pragma unroll
        for (int ks = 0; ks < 8; ++ks) ps = __builtin_amdgcn_mfma_f32_32x32x16_bf16(*(const LAS bf16x8*)(lds + L3_K + ((32 * st + r32) * XLD + 16 * ks + 8 * hi) * 2), qf[ks], ps, 0, 0, 0);
#pragma unroll
        for (int g4 = 0; g4 < 4; ++g4) { const f32x4 gs = *(const LAS f32x4*)(gl + 64 + 32 * st + 8 * g4 + 4 * hi);
#pragma unroll
            for (int j = 0; j < 4; ++j) { const int s = 32 * st + 8 * g4 + 4 * hi + j; const float v = (s <= t) ? ps[4 * g4 + j] * __expf(bt + gs[j]) : 0.f; ps[4 * g4 + j] = v; den += v; } }
        const u32x4 pw0 = (u32x4){pk(ps[0], ps[1]), pk(ps[2], ps[3]), pk(ps[4], ps[5]), pk(ps[6], ps[7])}, pw1 = (u32x4){pk(ps[8], ps[9]), pk(ps[10], ps[11]), pk(ps[12], ps[13]), pk(ps[14], ps[15])};
#pragma unroll
        for (int k2 = 0; k2 < 2; ++k2) { const int kg = 2 * st + k2;
            const s16x4 vl = vtr(lds + L3_V + lo_ + d0 * 4096 + kg * 1024), vh = vtr(lds + L3_V + lo_ + d0 * 4096 + kg * 1024 + 512);
            o = __builtin_amdgcn_mfma_f32_32x32x16_bf16(__builtin_bit_cast(bf16x8, k2 ? pw1 : pw0), (bf16x8){vl[0], vl[1], vl[2], vl[3], vh[0], vh[1], vh[2], vh[3]}, o, 0, 0, 0); }
    }
    { float qn = 0.f; const LAS unsigned char* cp = lds + L3_C + ((32 * d0 + r32) * XLD + 8 * hi) * 2;
#pragma unroll
      for (int ks = 0; ks < 8; ++ks) { f32x4 a0, a1; pg8::unpack8(__builtin_bit_cast(u32x4, qf[ks]), a0, a1);
          const f32x4 n0 = *(const LAS f32x4*)(gl + 128 + 16 * ks + 8 * hi), n1 = *(const LAS f32x4*)(gl + 128 + 16 * ks + 8 * hi + 4);
          qn += (a0[0] * n0[0] + a0[1] * n0[1]) + (a0[2] * n0[2] + a0[3] * n0[3]) + (a1[0] * n1[0] + a1[1] * n1[1]) + (a1[2] * n1[2] + a1[3] * n1[3]);
          const u32x4 qs = pg8::pack8(a0 * ebt, a1 * ebt);
          o = __builtin_amdgcn_mfma_f32_32x32x16_bf16(__builtin_bit_cast(bf16x8, qs), *(const LAS bf16x8*)(cp + 32 * ks), o, 0, 0, 0); }
      den = swap_sum(den + ebt * qn); }
    { LAS float* wsf = (LAS float*)(lds + L3_WSF + wid * 256);
      if (hi == 0) wsf[r32] = 1.f / fmaxf(fabsf(den), 1.f);
      LAS float* H = (LAS float*)(lds + L3_H);
#pragma unroll
      for (int g4 = 0; g4 < 4; ++g4) { const f32x4 w = *(const LAS f32x4*)(wsf + 8 * g4 + 4 * hi);
#pragma unroll
          for (int j = 0; j < 4; ++j) { const int tq = 32 * tt + 8 * g4 + 4 * hi + j; H[tq * 132 + 32 * d0 + r32] = o[4 * g4 + j] * w[j]; } } }
    __syncthreads();
    { const LAS float* H = (const LAS float*)(lds + L3_H);
      const int tq = tid >> 3, cs = (tid & 7) * 16; const size_t m = m0 + tq; const int cb = h * 128 + cs;
      const u32x4 op0 = *(const u32x4*)(p.proj + m * LDP + C_OPRE + cb), op1 = *(const u32x4*)(p.proj + m * LDP + C_OPRE + cb + 8);
      const u32x4 xc0 = *(const u32x4*)(p.xc + m * 512 + cb), xc1 = *(const u32x4*)(p.xc + m * 512 + cb + 8);
      f32x4 og[4], xv[4], hv[4]; pg8::unpack8(op0, og[0], og[1]); pg8::unpack8(op1, og[2], og[3]); pg8::unpack8(xc0, xv[0], xv[1]); pg8::unpack8(xc1, xv[2], xv[3]);
      float s1 = 0.f, s2 = 0.f;
#pragma unroll
      for (int q4 = 0; q4 < 4; ++q4) { hv[q4] = *(const LAS f32x4*)(H + tq * 132 + cs + 4 * q4);
#pragma unroll
          for (int j = 0; j < 4; ++j) { const float v = hv[q4][j] * __builtin_amdgcn_rcpf(1.f + __expf(-og[q4][j])); hv[q4][j] = v; s1 += v; s2 += v * v; } }
      s1 += __shfl_xor(s1, 1); s2 += __shfl_xor(s2, 1); s1 += __shfl_xor(s1, 2); s2 += __shfl_xor(s2, 2); s1 += __shfl_xor(s1, 4); s2 += __shfl_xor(s2, 4);
      const float mu = s1 * (1.f / 128.f), rs = rsqrtf(fmaxf(s2 * (1.f / 128.f) - mu * mu, 0.f) + EPS);
      f32x4 yo[4];
#pragma unroll
      for (int q4 = 0; q4 < 4; ++q4) { const f32x4 gn = *(const f32x4*)(p.mh_gain + cb + 4 * q4), sk = *(const f32x4*)(p.skip + cb + 4 * q4);
#pragma unroll
          for (int j = 0; j < 4; ++j) yo[q4][j] = (hv[q4][j] - mu) * rs * gn[j] + sk[j] * xv[q4][j]; }
      *(u32x4*)(p.yb + m * 512 + cb) = pg8::pack8(yo[0], yo[1]); *(u32x4*)(p.yb + m * 512 + cb + 8) = pg8::pack8(yo[2], yo[3]); }
}
}

namespace xat {
using nsa::bf16x8; using nsa::s16x4; using nsa::f32x16; using nsa::u32x4; using nsa::vtr; using nsa::pk; using nsa::swap_sum; using nsa::swap_max;
constexpr int L_K = 0, L_V = 65536, L_WSF = 98304, L_END = L_WSF + 2048;
constexpr float C2X = 0.0625f * 1.4426950408889634f, THR = 6.f;
__device__ __forceinline__ void unit(int b, int h, int qb, const bf16_t* qx, const bf16_t* kx, const bf16_t* vx, int kvp, bf16_t* ox, LAS unsigned char* lds) {
    int t_ = threadIdx.x; asm volatile("" : "+v"(t_)); const int tid = t_, lane = tid & 63, wid = __builtin_amdgcn_readfirstlane(tid >> 6), r32 = lane & 31, hi = lane >> 5;
    LAS float* wsf = (LAS float*)(lds + L_WSF + wid * 256);
    const size_t mrow = (size_t)b * T + 256 * qb + 32 * wid + r32;
    bf16x8 qr[16];
#pragma unroll
    for (int d0 = 0; d0 < 16; ++d0) qr[d0] = *(const bf16x8*)(qx + mrow * D + h * 256 + d0 * 16 + hi * 8);
    const bf16_t* kb = kx + (size_t)b * NMEM * kvp + h * 256; const bf16_t* vb = vx + (size_t)b * NMEM * kvp + h * 256;
    const LAS unsigned char* kp0 = lds + L_K + hi * 1024 + r32 * 16;
    const LAS unsigned char* vp0 = lds + L_V + ((lane >> 4) & 1) * 32 + (lane & 3) * 8 + (4 * hi + ((lane & 15) >> 2)) * 64;
    for (int dh2 = 0; dh2 < 2; ++dh2) {
        f32x16 o[4];
#pragma unroll
        for (int d0 = 0; d0 < 4; ++d0) o[d0] = mls::zero16();
        float mref = -1e30f, l = 0.f;
#define XA_LOAD(jt, slot) do { _Pragma("unroll") for (int i2 = 0; i2 < 4; ++i2) { const int pid = tid + 512 * i2; \
                __builtin_amdgcn_global_load_lds((const unsigned*)(kb + (size_t)(64 * (jt) + (pid & 63)) * kvp + (pid >> 6) * 8), (LAS unsigned*)(lds + L_K + (slot) * 32768 + (wid * 64 + 512 * i2) * 16), 16, 0, 0); } \
            _Pragma("unroll") for (int i2 = 0; i2 < 2; ++i2) { const int pid = tid + 512 * i2, blk = pid >> 6, ln = pid & 63; \
                __builtin_amdgcn_global_load_lds((const unsigned*)(vb + (size_t)(64 * (jt) + 16 * (blk & 3) + (ln >> 2)) * kvp + 128 * dh2 + (blk >> 2) * 32 + (ln & 3) * 8), (LAS unsigned*)(lds + L_V + (slot) * 16384 + (wid * 64 + 512 * i2) * 16), 16, 0, 0); } } while (0)
        __syncthreads();
        XA_LOAD(0, 0); asm volatile("s_waitcnt vmcnt(0)" ::: "memory"); __syncthreads();
        for (int jt = 0; jt < 4; ++jt) { const int slot = jt & 1;
            if (jt + 1 < 4) XA_LOAD(jt + 1, slot ^ 1);
            f32x16 p0 = mls::zero16(), p1 = p0;
            { const LAS unsigned char* kp = kp0 + slot * 32768;
              bf16x8 ka0 = *(const LAS bf16x8*)(kp), ka1 = *(const LAS bf16x8*)(kp + 512), kb0, kb1;
#pragma unroll
              for (int d0 = 0; d0 < 16; d0 += 2) {
                  kb0 = *(const LAS bf16x8*)(kp + (d0 + 1) * 2048); kb1 = *(const LAS bf16x8*)(kp + (d0 + 1) * 2048 + 512);
                  __builtin_amdgcn_sched_barrier(0);
                  p0 = __builtin_amdgcn_mfma_f32_32x32x16_bf16(ka0, qr[d0], p0, 0, 0, 0); p1 = __builtin_amdgcn_mfma_f32_32x32x16_bf16(ka1, qr[d0], p1, 0, 0, 0);
                  __builtin_amdgcn_sched_barrier(0);
                  if (d0 + 2 < 16) { ka0 = *(const LAS bf16x8*)(kp + (d0 + 2) * 2048); ka1 = *(const LAS bf16x8*)(kp + (d0 + 2) * 2048 + 512); }
                  __builtin_amdgcn_sched_barrier(0);
                  p0 = __builtin_amdgcn_mfma_f32_32x32x16_bf16(kb0, qr[d0 + 1], p0, 0, 0, 0); p1 = __builtin_amdgcn_mfma_f32_32x32x16_bf16(kb1, qr[d0 + 1], p1, 0, 0, 0);
                  __builtin_amdgcn_sched_barrier(0); } }
            float rm = fmaxf(p0[0], p1[0]);
#pragma unroll
            for (int r = 1; r < 16; ++r) rm = fmaxf(rm, fmaxf(p0[r], p1[r]));
            rm = swap_max(rm) * C2X;
            const bool need = rm > mref + THR;
            if (__any(need)) {
                const float mnew = need ? rm : mref, f = __builtin_amdgcn_exp2f(mref - mnew);
                l *= f; mref = mnew;
#pragma unroll
                for (int r = 0; r < 16; ++r) { o[0][r] *= f; o[1][r] *= f; o[2][r] *= f; o[3][r] *= f; }
            }
            float sum = 0.f;
#pragma unroll
            for (int r = 0; r < 16; ++r) { p0[r] = __builtin_amdgcn_exp2f(__builtin_fmaf(p0[r], C2X, -mref)); p1[r] = __builtin_amdgcn_exp2f(__builtin_fmaf(p1[r], C2X, -mref)); sum += p0[r] + p1[r]; }
            l += sum;
            u32x4 pw[4];
            pw[0] = (u32x4){pk(p0[0], p0[1]), pk(p0[2], p0[3]), pk(p0[4], p0[5]), pk(p0[6], p0[7])}; pw[1] = (u32x4){pk(p0[8], p0[9]), pk(p0[10], p0[11]), pk(p0[12], p0[13]), pk(p0[14], p0[15])};
            pw[2] = (u32x4){pk(p1[0], p1[1]), pk(p1[2], p1[3]), pk(p1[4], p1[5]), pk(p1[6], p1[7])}; pw[3] = (u32x4){pk(p1[8], p1[9]), pk(p1[10], p1[11]), pk(p1[12], p1[13]), pk(p1[14], p1[15])};
            { const LAS unsigned char* vp = vp0 + slot * 16384;
#define XA_VLD(i, L0, H0, L1, H1) do { L0 = vtr(vp + ((i) >> 1) * 4096 + ((i) & 1) * 2048); H0 = vtr(vp + ((i) >> 1) * 4096 + ((i) & 1) * 2048 + 512); L1 = vtr(vp + ((i) >> 1) * 4096 + ((i) & 1) * 2048 + 1024); H1 = vtr(vp + ((i) >> 1) * 4096 + ((i) & 1) * 2048 + 1536); } while (0)
#define XA_VMM(i, L0, H0, L1, H1) do { o[(i) >> 1] = __builtin_amdgcn_mfma_f32_32x32x16_bf16((bf16x8){L0[0], L0[1], L0[2], L0[3], H0[0], H0[1], H0[2], H0[3]}, __builtin_bit_cast(bf16x8, pw[((i) & 1) * 2]), o[(i) >> 1], 0, 0, 0); \
                  o[(i) >> 1] = __builtin_amdgcn_mfma_f32_32x32x16_bf16((bf16x8){L1[0], L1[1], L1[2], L1[3], H1[0], H1[1], H1[2], H1[3]}, __builtin_bit_cast(bf16x8, pw[((i) & 1) * 2 + 1]), o[(i) >> 1], 0, 0, 0); } while (0)
              s16x4 al0, ah0, al1, ah1, bl0, bh0, bl1, bh1;
              XA_VLD(0, al0, ah0, al1, ah1);
#pragma unroll
              for (int i = 0; i < 8; i += 2) {
                  XA_VLD(i + 1, bl0, bh0, bl1, bh1);
                  __builtin_amdgcn_sched_barrier(0);
                  XA_VMM(i, al0, ah0, al1, ah1);
                  __builtin_amdgcn_sched_barrier(0);
                  if (i + 2 < 8) XA_VLD(i + 2, al0, ah0, al1, ah1);
                  __builtin_amdgcn_sched_barrier(0);
                  XA_VMM(i + 1, bl0, bh0, bl1, bh1);
                  __builtin_amdgcn_sched_barrier(0); }
#undef XA_VLD
#undef XA_VMM
            }
            asm volatile("s_waitcnt vmcnt(0)" ::: "memory"); __syncthreads();
        }
#undef XA_LOAD
        const float inv = 1.f / swap_sum(l);
        LAS unsigned char* ot = lds + wid * 8704;
#pragma unroll
        for (int d0 = 0; d0 < 4; ++d0)
#pragma unroll
            for (int g4 = 0; g4 < 4; ++g4) { pg8::u32x2 w; w.x = pk(o[d0][4 * g4] * inv, o[d0][4 * g4 + 1] * inv); w.y = pk(o[d0][4 * g4 + 2] * inv, o[d0][4 * g4 + 3] * inv);
                *(LAS pg8::u32x2*)(ot + r32 * 272 + (32 * d0 + 8 * g4 + 4 * hi) * 2) = w; }
#pragma unroll
        for (int i2 = 0; i2 < 8; ++i2) { const int row = 4 * i2 + (lane >> 4), c16 = lane & 15;
            *(u32x4*)(ox + ((size_t)b * T + 256 * qb + 32 * wid + row) * D + h * 256 + 128 * dh2 + c16 * 8) = *(const LAS u32x4*)(ot + row * 272 + c16 * 16); }
    }
}
}

__device__ __forceinline__ int conv_srccol(int kind, int r) {
    if (kind == 1) return r < IN_COLS ? my2orig(r) : -1;
    if (kind == 2) { const int pn = r >> 8, rr = r & 255; return (rr >> 7) * 1024 + pn * 128 + (rr & 127); }
    if (kind == 3) return r < NEXP ? r : -1;
    if (kind == 4) return r < 128 ? r : -1;
    return r;
}
template <bool F8>
__device__ __forceinline__ void conv_item(const float* W, int ldw, const float* gk, int kind, bf16_t* WT, int K, int k0, int r0, LAS float* scr, int lane) {
    const int c4 = (lane & 15) * 4; const int sc = conv_srccol(kind, r0 + c4);
    f32x4 vv[16];
#pragma unroll
    for (int i = 0; i < 16; ++i) { const int kk = 4 * i + (lane >> 4); vv[i] = (f32x4){0.f, 0.f, 0.f, 0.f}; if (sc >= 0) vv[i] = *(const f32x4*)(W + (size_t)(k0 + kk) * ldw + sc); }
    float gv[16];
#pragma unroll
    for (int i = 0; i < 16; ++i) gv[i] = gk ? gk[k0 + 4 * i + (lane >> 4)] : 1.f;
#pragma unroll
    for (int i = 0; i < 16; ++i) { const int kk = 4 * i + (lane >> 4); const f32x4 v = vv[i] * gv[i];
        LAS float* d = scr + kk * 65 + c4; d[0] = v[0]; d[1] = v[1]; d[2] = v[2]; d[3] = v[3]; }
    asm volatile("s_waitcnt lgkmcnt(0)" ::: "memory");
    const int ch = lane & 7;
#pragma unroll 2
    for (int i = 0; i < 8; ++i) { const int n = (lane >> 3) + 8 * i; const LAS float* s = scr + (8 * ch) * 65 + n;
        if constexpr (F8) {
            pg8::u32x2 o; o.x = pg8::pack4_fp8((f32x4){s[0 * 65], s[1 * 65], s[2 * 65], s[3 * 65]} * 32.f); o.y = pg8::pack4_fp8((f32x4){s[4 * 65], s[5 * 65], s[6 * 65], s[7 * 65]} * 32.f);
            *(pg8::u32x2*)((unsigned char*)WT + (size_t)(r0 + n) * K + k0 + 8 * ch) = o;
        } else {
        pg8::u32x4 o; o.x = pg8::cvt_pk_bf16(s[0 * 65], s[1 * 65]); o.y = pg8::cvt_pk_bf16(s[2 * 65], s[3 * 65]); o.z = pg8::cvt_pk_bf16(s[4 * 65], s[5 * 65]); o.w = pg8::cvt_pk_bf16(s[6 * 65], s[7 * 65]);
        bf16_t* dst = WT + (size_t)(r0 + n) * K + k0 + 8 * ch;
        if (kind == 5) dst = WT + (size_t)((((r0 + n) >> 5) * 8 + ((k0 + 8 * ch) >> 4)) * 64 + (((k0 + 8 * ch) >> 3) & 1) * 32 + ((r0 + n) & 31)) * 8;
        *(pg8::u32x4*)dst = o; } }
    asm volatile("s_waitcnt lgkmcnt(0)" ::: "memory");
}
template <bool F8 = false>
__device__ __forceinline__ bool conv_matrix(int& it, const float* W, int ldw, const float* gk, int kind, bf16_t* WT, int K, int rows, LAS float* scr, int lane) {
    const int nkb = K / 64, nrb = rows / 64, nit = nkb * nrb;
    if (it >= nit) { it -= nit; return false; }
    const int kbp = it / (2 * nrb), r2 = it % (2 * nrb), rb = r2 >> 1, kb = 2 * kbp + (r2 & 1);
    conv_item<F8>(W, ldw, gk, kind, WT, K, kb * 64, rb * 64, scr, lane);
    return true;
}

enum Stage { ST_PREP = 0, ST_PROJ, ST_A, ST_B, ST_C, ST_MRG, ST_OMIX, ST_QX, ST_XATT, ST_OX, ST_ROUTER, ST_RSCAT, ST_MOE1, ST_MOE2, ST_FINAL, ST_COUNT };
constexpr size_t W_1_T = 22 * MiB;

constexpr size_t W_IN_T = 0, W_UA_T = 9 * MiB, W_UB_T = 10 * MiB, W_OM_T = 11 * MiB, W_QX_T = 13 * MiB, W_OX_T = 15 * MiB, W_R_T = 17 * MiB, W_GU_T = 32 * MiB, W_D_T = 160 * MiB;
constexpr size_t SM_SSQ1 = 22 * MiB, SM_SSQ2 = 24 * MiB;
constexpr size_t W_KX_T = 18 * MiB, W_VX_T = 20 * MiB, W_MEMN = 26 * MiB, W_KVX = 28 * MiB;
constexpr size_t W_M_T = 24 * MiB;
constexpr size_t SM_ROWRS = 32 * MiB, SM_ROWW = 33 * MiB, SM_RPAIR = 34 * MiB, SM_TEND = 35 * MiB;
constexpr size_t SM_UN = 26 * MiB, SM_NST = 27 * MiB, SM_GB = 28 * MiB, SM_GG = 28 * MiB + 512 * 1024, SM_BL = 29 * MiB;

template <int stage> __device__ __forceinline__ void run_stage(const Args& a, float* sm) {
    int tid_ = threadIdx.x; asm volatile("" : "+v"(tid_));
    int bid_ = blockIdx.x; asm volatile("" : "+s"(bid_));
    const int bid = bid_, nb = gridDim.x, tid = tid_;
    LAS unsigned char* ldsb = (LAS unsigned char*)sm;
    unsigned long long ws_ = (unsigned long long)a.ws; asm volatile("" : "+s"(ws_)); unsigned char* ws = glb_ptr<unsigned char>(ws_);
    const LAS unsigned long long* ptab = (const LAS unsigned long long*)((LAS unsigned char*)sm + LDS_PTAB);
#define INP(k) glb_ptr<const float>(((unsigned long long)(unsigned)__builtin_amdgcn_readfirstlane((int)(ptab[k] >> 32)) << 32) | (unsigned long long)(unsigned)__builtin_amdgcn_readfirstlane((int)(unsigned)ptab[k]))
    const float* x = INP(0); const float* mem = INP(1); const float* g_mix = INP(2); const float* w_in = INP(3);
    const float* pe_k = INP(4); const float* pe_v = INP(5); const float* w1k = INP(6); const float* w2k = INP(7); const float* w1v = INP(8); const float* w2v = INP(9);
    const float* w_conv = INP(10); const float* b_conv = INP(11); const float* w_q_m = INP(12); const float* w_k_m = INP(13); const float* w_v_m = INP(14);
    const float* b_i = INP(15); const float* b_f = INP(16); const float* mh_gain = INP(17); const float* skip_m = INP(18);
    const float* w_up_a = INP(19); const float* w_up_b = INP(20); const float* w_o_mix = INP(21); const float* g_x = INP(22); const float* g_mem = INP(23);
    const float* w_q_x = INP(24); const float* w_k_x = INP(25); const float* w_v_x = INP(26); const float* w_o_x = INP(27);
    const float* g_ffn = INP(28); const float* w_router = INP(29); const float* b_router = INP(30); const float* w_gu = INP(31); const float* b_gu = INP(32);
    const float* w_down = INP(33); const float* b_down = INP(34); const float* g_final = INP(35);
    unsigned char* sml = ws + WS_SMALL;
    float* rstdm = (float*)(sml + SM_RSTDM);
    float* bias1 = (float*)(sml + SM_BIAS1); int* cnt = (int*)(sml + 30 * MiB);     int* ntl = (int*)(sml + SM_NT); int* texp = (int*)(sml + SM_TEXP);
    bf16_t* kc = (bf16_t*)(sml + SM_KC); bf16_t* vc = (bf16_t*)(sml + SM_VC); float* h1 = (float*)(sml + SM_H1);
    float* kx = (float*)(sml + SM_KX); float* vx = (float*)(sml + SM_VX); float* logit = (float*)(sml + SM_LOGIT);
    int* te = (int*)(sml + SM_TE); float* tw = (float*)(sml + SM_TW); int* tp = (int*)(sml + SM_TP); int* rslot = (int*)(sml + SM_RSLOT);
    float* ssq1 = (float*)(sml + SM_SSQ1); float* ssq2 = (float*)(sml + SM_SSQ2);
    float* gates = (float*)(ws + WS_GATES); bf16_t* proj = (bf16_t*)(ws + WS_PROJ); float* x1 = (float*)(ws + WS_X1);
    bf16_t* ya = (bf16_t*)(ws + WS_YA); bf16_t* yb = (bf16_t*)(ws + WS_YB);
    bf16_t* xb0 = (bf16_t*)(ws + WS_T1);
    bf16_t* xc = (bf16_t*)(ws + WS_T1); bf16_t* mq = (bf16_t*)(ws + WS_T1 + 32 * MiB); bf16_t* mk = (bf16_t*)(ws + WS_T1 + 64 * MiB); bf16_t* mv = (bf16_t*)(ws + WS_T1 + 96 * MiB);
    float* hbuf = (float*)(ws + WS_T1 + 128 * MiB);
    bf16_t* mg = (bf16_t*)(ws + WS_T1);
    bf16_t* xb1 = (bf16_t*)(ws + WS_T1 + 64 * MiB);
    bf16_t* xb2 = (bf16_t*)(ws + WS_X1);
    bf16_t* qx = (bf16_t*)(ws + WS_PROJ);
    bf16_t* ox = (bf16_t*)(ws + WS_PROJ + 64 * MiB);
    unsigned char* act8 = ws + WS_PROJ;
    unsigned char* xq8 = ws + WS_X1 + 64 * MiB;
    bf16_t* ys = (bf16_t*)(ws + WS_YA);
    bf16_t* wt = (bf16_t*)(ws + WS_W);
    bf16_t* memn = wt + W_MEMN / 2; bf16_t* kvx = wt + W_KVX / 2;
    bf16_t* kvc6 = (bf16_t*)(ws + 964 * MiB);
    const int G = nb;

    switch (stage) {
    case ST_PREP: {
        const int lane = tid & 63, wv = tid >> 6;
        LAS float* scr = (LAS float*)(ldsb + wv * 16640);
        const int gw = bid * 8 + wv, NGW = nb * 8;
        constexpr int I_IN = 16 * 72, I_U = 8 * 16, I_SQ = 16 * 16, I_R = 16 * 4, I_GU = 16 * 32, I_D = 16 * 16;
        constexpr int NITEMS = I_IN + 2 * I_U + 5 * I_SQ + I_R + 48 + 256;
        for (int item = gw; item < NITEMS; item += NGW) {
            int it = item;
            if (conv_matrix(it, w_in, IN_COLS, g_mix, 1, wt + W_IN_T / 2, D, LDP, scr, lane)) continue;
            if (conv_matrix(it, w_up_a, D, nullptr, 0, wt + W_UA_T / 2, 512, D, scr, lane)) continue;
            if (conv_matrix(it, w_up_b, D, nullptr, 0, wt + W_UB_T / 2, 512, D, scr, lane)) continue;
            if (conv_matrix(it, w_o_mix, D, nullptr, 0, wt + W_OM_T / 2, D, D, scr, lane)) continue;
            if (conv_matrix(it, w_q_x, D, g_x, 0, wt + W_QX_T / 2, D, D, scr, lane)) continue;
            if (conv_matrix(it, w_o_x, D, nullptr, 0, wt + W_OX_T / 2, D, D, scr, lane)) continue;
            if (conv_matrix(it, w_k_x, D, g_mem, 0, wt + W_KX_T / 2, D, D, scr, lane)) continue;
            if (conv_matrix(it, w_v_x, D, g_mem, 0, wt + W_VX_T / 2, D, D, scr, lane)) continue;
            if (conv_matrix(it, w_router, NEXP, g_ffn, 3, wt + W_R_T / 2, D, 256, scr, lane)) continue;
            if (it < 48) { const int mi = it >> 2; it &= 3; const float* wsrc = (mi < 4 ? w_q_m : mi < 8 ? w_k_m : w_v_m) + (size_t)(mi & 3) * 16384;
                conv_matrix(it, wsrc, 128, nullptr, 5, wt + W_M_T / 2 + (size_t)mi * 16384, 128, 128, scr, lane); continue; }
            it -= 48;
            if (conv_matrix(it, w1k, 128, nullptr, 4, wt + W_1_T / 2, 2048, 256, scr, lane)) continue;
            if (conv_matrix(it, w1v, 128, nullptr, 4, wt + W_1_T / 2 + 256 * 2048, 2048, 256, scr, lane)) continue;
        }
        for (int m = gw; m < M; m += NGW) {
            const f32x4* xr = (const f32x4*)(x + (size_t)m * D) + lane; f32x4 v[4]; float s = 0.f;
#pragma unroll
            for (int j = 0; j < 4; ++j) { v[j] = xr[64 * j]; s += v[j].x * v[j].x + v[j].y * v[j].y + v[j].z * v[j].z + v[j].w * v[j].w; }
            const float rs = rsqrtf(wave_sum(s) * (1.f / D) + EPS);
            pg8::u32x2* o = (pg8::u32x2*)(xb0 + (size_t)m * D) + lane;
#pragma unroll
            for (int j = 0; j < 4; ++j) { pg8::u32x2 w; w.x = pg8::cvt_pk_bf16(v[j].x * rs, v[j].y * rs); w.y = pg8::cvt_pk_bf16(v[j].z * rs, v[j].w * rs); o[64 * j] = w; }
        }
        for (int m = gw; m < NB * NMEM; m += NGW) {
            const f32x4* xr = (const f32x4*)(mem + (size_t)m * D) + lane; f32x4 v[4]; float s = 0.f;
#pragma unroll
            for (int j = 0; j < 4; ++j) { v[j] = xr[64 * j]; s += v[j].x * v[j].x + v[j].y * v[j].y + v[j].z * v[j].z + v[j].w * v[j].w; }
            const float rs = rsqrtf(wave_sum(s) * (1.f / D) + EPS);
            pg8::u32x2* o = (pg8::u32x2*)(memn + (size_t)m * D) + lane;
#pragma unroll
            for (int j = 0; j < 4; ++j) { pg8::u32x2 w; w.x = pg8::cvt_pk_bf16(v[j].x * rs, v[j].y * rs); w.y = pg8::cvt_pk_bf16(v[j].z * rs, v[j].w * rs); o[64 * j] = w; }
        }
        for (int i = bid; i < 256; i += nb) {
            const float* pe = i < 128 ? pe_k : pe_v; const float* w1 = i < 128 ? w1k : w1v; const int j = i & 127; float sacc = 0.f;
#pragma unroll
            for (int q4 = 0; q4 < 4; ++q4) { const int kk = tid + 512 * q4; sacc += pe[kk] * w1[(size_t)kk * 128 + j]; }
            sacc = wave_sum(sacc);
            __syncthreads();
            if (lane == 0) sm[wv] = sacc;
            __syncthreads();
            if (tid == 0) bias1[i] = ((sm[0] + sm[1]) + (sm[2] + sm[3])) + ((sm[4] + sm[5]) + (sm[6] + sm[7]));
        }
        if (bid == 0 && tid < 32) cnt[tid * 64] = 0;
    } break;
    case ST_PROJ: {
        pg8::DenseSched S{(const char*)xb0, (const char*)(wt + W_IN_T / 2), nullptr, nullptr, 2048u, 2048u, 128, 16, M / 256, LDP / 256, G, bid, 1};
        pg8::EpiProj E{proj, gates, kvc6};
        pg8::gemm_phase(ldsb, S, E);
    } break;
    case ST_A: {
        { pg8::CmpSched S{kvc6, (const char*)(wt + W_1_T / 2), 2048u, 4096u, (size_t)128, 32, G, bid};
          pg8::EpiCmp E{h1, bias1};
          pg8::gemm_phase(ldsb, S, E); }
        mls::P1 P{proj, gates, w_conv, b_conv, b_i, b_f, wt + W_M_T / 2, xc, mq, mk, mv, (bf16_t*)(ws + WS_X1), (float*)(sml + SM_UN), (float*)(sml + SM_GB), (float*)(sml + SM_GG), (float*)(sml + SM_BL)};
        if (nb == 256) {
            const int u0 = bid < 32 ? 2016 + bid : (bid - 32) * 9, nu = bid < 32 ? 1 : 9;
#pragma unroll 1
            for (int k = 0; k < nu; ++k) { const int u = u0 + k; mls::ml1_unit(P, u >> 9, (u >> 7) & 3, u & 127, ldsb); }
        } else {
#pragma unroll 1
            for (int u = bid; u < 2048; u += nb) mls::ml1_unit(P, u >> 9, (u >> 7) & 3, u & 127, ldsb);
        }
    } break;
    case ST_B: {
        { pg8::DenseSched S{(const char*)memn, (const char*)(wt + W_KX_T / 2), nullptr, nullptr, 2048u, 2048u, 128, 16, NB * NMEM / 256, 2 * D / 256, G, bid, 1};
          pg8::EpiScaleBf16 E{kvx, 2 * D, nullptr};
          pg8::gemm_phase(ldsb, S, E); }
        const int ncg = nb >= 128 ? 64 : 0;
        if (ncg == 0 || bid < ncg) {
            const int cb = ncg ? bid : bid, cn = ncg ? ncg : nb;
            for (int kv = 0; kv < 2; ++kv) {
                const float* w2 = kv ? w2v : w2k; bf16_t* o = kv ? vc : kc;
                nv_gemm(4096, 64, 128,
                    [&](int row, int kk) { return h1[((size_t)kv * 4096 + row) * 128 + kk]; },
                    [&](int kk, int n, int) { return w2[(size_t)kk * 64 + n]; },
                    [&](int row, int n, const float* acc) { const bool pad = (row & 511) == 511;
#pragma unroll
                        for (int j = 0; j < 4; ++j) o[(size_t)row * 64 + n + j] = pad ? (bf16_t)0 : f2bf(acc[j]); },
                    sm, kv ? cb : (cb + cn / 2) % cn, cn);
            }
        }
        if (ncg == 0 || bid >= ncg)
            mls::ml2((const bf16_t*)(ws + WS_X1), (const float*)(sml + SM_UN), (const float*)(sml + SM_BL), (bf16_t*)(ws + WS_T1 + 128 * MiB), (float*)(sml + SM_NST), sm, ncg ? bid - ncg : bid, ncg ? nb - ncg : nb);
    } break;
    case ST_C: {
#define MOE_CONVERT() do { constexpr int I_GU = 16 * 32, I_D = 16 * 16, NMOE = NEXP * (I_GU + I_D); \
            int tid2 = threadIdx.x, bid2 = blockIdx.x; asm volatile("" : "+v"(tid2), "+s"(bid2)); \
            const int lane = tid2 & 63, wv = __builtin_amdgcn_readfirstlane(tid2 >> 6), gw = bid2 * 8 + wv, NGW = gridDim.x * 8; \
            LAS float* scr = (LAS float*)((LAS unsigned char*)sm + wv * 16640); \
            __syncthreads(); \
            _Pragma("unroll 1") for (int it0 = gw; it0 < NMOE; it0 += NGW) { int it = it0; unsigned char* wdst = ws + WS_W; \
                if (it < NEXP * I_GU) { const int e = it / I_GU; it -= e * I_GU; conv_matrix<true>(it, INP(31) + (size_t)e * D * 2048, 2048, INP(28), 2, (bf16_t*)(wdst + W_GU_T + (size_t)e * 2048 * D), D, 2048, scr, lane); } \
                else { it -= NEXP * I_GU; const int e = it / I_D; it -= e * I_D; conv_matrix<true>(it, INP(33) + (size_t)e * D * D, D, nullptr, 0, (bf16_t*)(wdst + W_D_T + (size_t)e * D * D), D, D, scr, lane); } } \
            __syncthreads(); } while (0)
        if (bid & 1) MOE_CONVERT();
        nsa::phase(proj, kvc6, gates, kc, vc, ya, ldsb, bid, nb);
        { mls::P3 P{proj, xc, mq, mk, mv, (const bf16_t*)(ws + WS_T1 + 128 * MiB), (const float*)(sml + SM_NST), (const float*)(sml + SM_GB), (const float*)(sml + SM_GG), mh_gain, skip_m, yb};
#pragma unroll 1
          for (int u = bid; u < 2048; u += nb) mls::ml3_unit(P, u >> 9, (u >> 7) & 3, u & 127, ldsb); }
        if (!(bid & 1)) MOE_CONVERT();
#undef MOE_CONVERT
    } break;
    case ST_MRG: {
        pg8::DenseSched S{(const char*)ya, (const char*)(wt + W_UA_T / 2), (const char*)yb, (const char*)(wt + W_UB_T / 2), 1024u, 1024u, 128, 8, M / 256, D / 256, G, bid, 2};
        pg8::EpiMerged E{proj, mg};
        pg8::gemm_phase(ldsb, S, E);
    } break;
    case ST_OMIX: {
        pg8::DenseSched S{(const char*)mg, (const char*)(wt + W_OM_T / 2), nullptr, nullptr, 2048u, 2048u, 128, 16, M / 256, D / 256, G, bid, 1};
        pg8::EpiResid<false> E{x, xb1, ssq1, nullptr};
        pg8::gemm_phase(ldsb, S, E);
    } break;
    case ST_QX: {
        pg8::DenseSched S{(const char*)xb1, (const char*)(wt + W_QX_T / 2), nullptr, nullptr, 2048u, 2048u, 128, 16, M / 256, D / 256, G, bid, 1};
        pg8::EpiScaleBf16 E{qx, D, ssq1};
        pg8::gemm_phase(ldsb, S, E);
    } break;
    case ST_XATT: {
#pragma unroll 1
        for (int u = bid; u < 512; u += nb) xat::unit(u >> 7, (u >> 5) & 3, u & 31, qx, kvx, kvx + D, 2 * D, ox, ldsb);
    } break;
    case ST_OX: {
        pg8::DenseSched S{(const char*)ox, (const char*)(wt + W_OX_T / 2), nullptr, nullptr, 2048u, 2048u, 128, 16, M / 256, D / 256, G, bid, 1};
        pg8::EpiResid<true> E{xb1, xb2, ssq2, xq8};
        pg8::gemm_phase(ldsb, S, E);
    } break;
    case ST_ROUTER: {
        typedef short bf16x8_t __attribute__((ext_vector_type(8)));
        const int lane = tid & 63, wv = tid >> 6;
        constexpr int WLD = 2064;
        LAS unsigned char* wl = ldsb;
        LAS float* lgs = (LAS float*)(ldsb + 66560) + wv * (16 * 33);
        int* hist = (int*)(sm + (66560 + 8 * 16 * 33 * 4) / 4); int* gbase = hist + 32;
        for (int i = bid * 512 + tid; i < MOE_ROWS_MAX; i += nb * 512) { rslot[i] = -1; ((float*)(sml + SM_ROWRS))[i] = 0.f; ((float*)(sml + SM_ROWW))[i] = 0.f; if (i < MOE_ROWS_MAX / 2) ((unsigned*)(sml + SM_RPAIR))[i] = 0u; }
        for (int i = tid; i < 32 * 128; i += 512) { const int r = i >> 7, c16 = i & 127; *(LAS pg8::u32x4*)(wl + r * WLD + c16 * 16) = *(const pg8::u32x4*)(wt + W_R_T / 2 + (size_t)r * D + c16 * 8); }
        for (int ch = bid; ch < M / 128; ch += nb) {
            __syncthreads();
            if (tid < 32) hist[tid] = 0;
            const size_t row0 = (size_t)ch * 128 + wv * 16;
            f32x4 a0 = (f32x4){0.f, 0.f, 0.f, 0.f}, a1 = a0;
            const bf16_t* ap = xb2 + (row0 + (lane & 15)) * D + (lane >> 4) * 8;
            const LAS unsigned char* bp = wl + (lane & 15) * WLD + (lane >> 4) * 16;
#pragma unroll 8
            for (int ks = 0; ks < 32; ++ks) {
                const bf16x8_t af = *(const bf16x8_t*)(ap + ks * 32);
                const bf16x8_t b0 = *(const LAS bf16x8_t*)(bp + ks * 64), b1 = *(const LAS bf16x8_t*)(bp + 16 * WLD + ks * 64);
                a0 = __builtin_amdgcn_mfma_f32_16x16x32_bf16(af, b0, a0, 0, 0, 0); a1 = __builtin_amdgcn_mfma_f32_16x16x32_bf16(af, b1, a1, 0, 0, 0);
            }
#pragma unroll
            for (int j = 0; j < 4; ++j) { lgs[((lane >> 4) * 4 + j) * 33 + (lane & 15)] = a0[j]; lgs[((lane >> 4) * 4 + j) * 33 + 16 + (lane & 15)] = a1[j]; }
            __syncthreads();
            int ei[4]; float ex[4]; int lp[4]; float ssum = 0.f; const size_t m = row0 + lane;
            if (lane < 16) {
                const float rs = pg8::rstd_from_ssq(ssq2, m);
                float lv[NEXP];
#pragma unroll
                for (int e = 0; e < NEXP; ++e) lv[e] = lgs[lane * 33 + e] * rs + b_router[e];
                float ev[4];
#pragma unroll
                for (int k = 0; k < 4; ++k) { float best = -INFINITY; int bi_ = 0;
#pragma unroll
                    for (int e = 0; e < NEXP; ++e) { if (lv[e] > best) { best = lv[e]; bi_ = e; } }
                    ei[k] = bi_; ev[k] = best;
#pragma unroll
                    for (int e = 0; e < NEXP; ++e) if (e == bi_) lv[e] = -INFINITY; }
#pragma unroll
                for (int k = 0; k < 4; ++k) { ex[k] = __expf(ev[k] - ev[0]); ssum += ex[k]; lp[k] = atomicAdd(&hist[ei[k]], 1); }
            }
            __syncthreads();
            if (tid < 32) gbase[tid] = atomicAdd(&cnt[tid * 64], hist[tid]);
            __syncthreads();
            if (lane < 16) {
#pragma unroll
                for (int k = 0; k < 4; ++k) { te[m * 4 + k] = ei[k]; tw[m * 4 + k] = ex[k] / ssum; tp[m * 4 + k] = gbase[ei[k]] + lp[k]; }
            }
        }
    } break;
    case ST_RSCAT: {
        int* eb = (int*)sm;
        if (tid < 32) { int acc = 0; for (int e = 0; e < tid; ++e) acc += (cnt[e * 64] + MOE_PAD - 1) / MOE_PAD * MOE_PAD; eb[tid] = acc; }
        __syncthreads();
        if (bid == 0 && tid < 32) { const int te_ = (eb[tid] + (cnt[tid * 64] + MOE_PAD - 1) / MOE_PAD * MOE_PAD) / MOE_PAD; ((int*)(sml + SM_TEND))[tid] = te_; if (tid == 31) ntl[0] = te_; }
        for (int i = bid * 512 + tid; i < NASG; i += nb * 512) { const int row = eb[te[i]] + tp[i]; rslot[row] = i;
            ((float*)(sml + SM_ROWRS))[row] = pg8::rstd_from_ssq(ssq2, i >> 2); ((float*)(sml + SM_ROWW))[row] = tw[i];
            ((unsigned short*)(sml + SM_RPAIR))[(((row >> 8) * 2 + ((row >> 7) & 1)) * 64 + (row & 63)) * 2 + ((row >> 6) & 1)] = (unsigned short)(i >> 2); }
    } break;
    case ST_MOE1: {
        pg8::MoeSched1 S; S.A = (const char*)xq8; S.Bt = (const char*)wt + W_GU_T; S.lda2 = 1024u; S.ldb2 = 1024u; S.kstepA = 128; S.ntk = 8; S.nM = ntl[0]; S.nN = 8; S.G = G; S.c = bid;
        S.bexp = (size_t)2048 * D; S.tend = (const LAS int*)(ldsb + 131072); S.rowpair = (const unsigned*)(sml + SM_RPAIR);
        if (tid < 32) ((LAS int*)(ldsb + 131072))[tid] = ((const int*)(sml + SM_TEND))[tid];
        __syncthreads();
        pg8::EpiMoe1 E{act8, (const float*)(sml + SM_ROWRS), b_gu};
        pg8::gemm_phase(ldsb, S, E);
    } break;
    case ST_MOE2: {
        pg8::MoeSched2 S; S.A = (const char*)act8; S.Bt = (const char*)wt + W_D_T; S.lda2 = 1024u; S.ldb2 = 1024u; S.kstepA = 128; S.ntk = 8; S.nM = ntl[0]; S.nN = 4; S.G = G; S.c = bid;
        S.bexp = (size_t)D * D; S.tend = (const LAS int*)(ldsb + 131072); S.rowpair = nullptr;
        if (tid < 32) ((LAS int*)(ldsb + 131072))[tid] = ((const int*)(sml + SM_TEND))[tid];
        __syncthreads();
        pg8::EpiMoe2 E{ys, rslot, (const float*)(sml + SM_ROWW), b_down};
        pg8::gemm_phase(ldsb, S, E);
    } break;
    case ST_FINAL: {
        const int lane = tid & 63, wv = tid >> 6;
        for (int m = bid * 8 + wv; m < M; m += nb * 8) {
            const pg8::u32x2* xr = (const pg8::u32x2*)(xb2 + (size_t)m * D) + lane; f32x4 v[4]; float s = 0.f;
#pragma unroll
            for (int j = 0; j < 4; ++j) { const pg8::u32x2 w = xr[64 * j]; v[j] = (f32x4){__uint_as_float(w.x << 16), __uint_as_float(w.x & 0xffff0000u), __uint_as_float(w.y << 16), __uint_as_float(w.y & 0xffff0000u)}; }
#pragma unroll
            for (int k = 0; k < 4; ++k) { const pg8::u32x2* yr = (const pg8::u32x2*)(ys + ((size_t)m * 4 + k) * D) + lane;
#pragma unroll
                for (int j = 0; j < 4; ++j) { const pg8::u32x2 w = yr[64 * j]; v[j].x += __uint_as_float(w.x << 16); v[j].y += __uint_as_float(w.x & 0xffff0000u); v[j].z += __uint_as_float(w.y << 16); v[j].w += __uint_as_float(w.y & 0xffff0000u); } }
#pragma unroll
            for (int j = 0; j < 4; ++j) s += v[j].x * v[j].x + v[j].y * v[j].y + v[j].z * v[j].z + v[j].w * v[j].w;
            const float rs = rsqrtf(wave_sum(s) * (1.f / D) + EPS);
            f32x4* o = (f32x4*)(as_global(a.out) + (size_t)m * D) + lane; const f32x4* gf = (const f32x4*)g_final + lane;
#pragma unroll
            for (int j = 0; j < 4; ++j) o[64 * j] = v[j] * rs * gf[64 * j];
        }
    } break;
    default: break;
    }
#undef INP
}

#define XB_TMO      128
#define XB_XCNT(j)  (256  + 64 * (j))
#define XB_XSUB(j)  (1280 + 64 * (j))
#define XB_XGEN(j)  (2304 + 64 * (j))
#define XB_TOP      3328
#define XB_TOPGEN   3392
#define XCD_BAR_WORDS 3456
#define XB_SPIN_CAP (1u << 20)
#define LAS __attribute__((address_space(3)))
__device__ __forceinline__ unsigned xb_ld(unsigned* p)              { return __hip_atomic_load(p, __ATOMIC_RELAXED, __HIP_MEMORY_SCOPE_AGENT); }
__device__ __forceinline__ unsigned xb_add(unsigned* p, unsigned v) { return __hip_atomic_fetch_add(p, v, __ATOMIC_RELAXED, __HIP_MEMORY_SCOPE_AGENT); }
__device__ __forceinline__ unsigned xb_xcc_id() { return (unsigned)__builtin_amdgcn_s_getreg((3 << 11) | 20) & 0xFu; }
#define XB_SPIN(cond, bar) do { unsigned _sp = 0; while (cond) { __builtin_amdgcn_s_sleep(1); \
    if ((++_sp & 255u) == 0u) { if (xb_ld(&(bar)[XB_TMO])) break; if (_sp > XB_SPIN_CAP) { atomicAdd(&(bar)[XB_TMO], 1u); break; } } } } while (0)
struct XcdBarrier { unsigned* bar; unsigned x; volatile LAS unsigned* st; };
__device__ __forceinline__ XcdBarrier xcd_barrier_post(unsigned* bar, volatile LAS unsigned* st) {
    XcdBarrier b; b.bar = bar; b.x = xb_xcc_id(); b.st = st;
    if (threadIdx.x == 0) (void)xb_add(&bar[XB_XCNT(b.x)], 1u);
    return b;
}
__device__ __forceinline__ void xcd_barrier_complete(unsigned* bar, unsigned x, unsigned& nloc, unsigned& nx) {
    const unsigned G = gridDim.x * gridDim.y * gridDim.z;
    unsigned sum, cnt, mine, sp = 0u;
    for (;;) {
        sum = 0u; cnt = 0u; mine = 0u;
#pragma unroll
        for (unsigned j = 0; j < 16; ++j) { const unsigned c = xb_ld(&bar[XB_XCNT(j)]); sum += c; cnt += (c > 0u) ? 1u : 0u; mine = (j == x) ? c : mine; }
        if (sum == G) break;
        __builtin_amdgcn_s_sleep(1);
        if ((++sp & 255u) == 0u) { if (xb_ld(&bar[XB_TMO])) break; if (sp > XB_SPIN_CAP) { atomicAdd(&bar[XB_TMO], 1u); break; } }
    }
    nloc = mine > 0u ? mine : 1u; nx = cnt > 0u ? cnt : 1u;
}
__device__ __forceinline__ void xcd_barrier(const XcdBarrier& b) {
    asm volatile("s_waitcnt vmcnt(0)" ::: "memory");
    __syncthreads();
    if (threadIdx.x == 0) {
        unsigned* bar = b.bar;
        __builtin_amdgcn_s_waitcnt(0);
        unsigned nloc = b.st[0], nx = b.st[1];
        if (nloc == 0u) { xcd_barrier_complete(bar, b.x, nloc, nx); b.st[0] = nloc; b.st[1] = nx; }
        const unsigned old = xb_add(&bar[XB_XSUB(b.x)], 1u);
        const unsigned gen = old / nloc;
        if (old + 1u == (gen + 1u) * nloc) {
            __builtin_amdgcn_fence(__ATOMIC_RELEASE, "agent");
            asm volatile("s_waitcnt vmcnt(0)" ::: "memory");
            const unsigned og = xb_add(&bar[XB_TOP], 1u);
            const unsigned tg = og / nx;
            if (og + 1u == (tg + 1u) * nx) xb_add(&bar[XB_TOPGEN], 1u);
            else XB_SPIN(xb_ld(&bar[XB_TOPGEN]) == tg, bar);
            __builtin_amdgcn_fence(__ATOMIC_ACQUIRE, "agent");
            xb_add(&bar[XB_XGEN(b.x)], 1u);
            asm volatile("s_waitcnt vmcnt(0)" ::: "memory");
        } else {
            XB_SPIN(xb_ld(&bar[XB_XGEN(b.x)]) == gen, bar);
            __builtin_amdgcn_fence(__ATOMIC_ACQUIRE, "agent");
            asm volatile("s_waitcnt vmcnt(0)" ::: "memory");
        }
    }
    __syncthreads();
}

constexpr int LDS_BYTES = 147456;
constexpr int CW_BAR = 4096;

template <int S> __device__ __forceinline__ void run_stages(const Args& a, float* sm, const XcdBarrier& bar) {
    if constexpr (S < ST_COUNT) {
        run_stage<S>(a, sm);
#ifdef DUP_MASK
        if constexpr ((DUP_MASK >> S) & 1) { __syncthreads(); run_stage<S>(a, sm); }
#endif
        if (S + 1 < ST_COUNT) xcd_barrier(bar);
        run_stages<S + 1>(a, sm, bar);
    }
}
__global__ void __launch_bounds__(512, 2) mega(Args a) {
    extern __shared__ __attribute__((aligned(16))) unsigned char lds[];
    float* sm = (float*)lds;
    volatile LAS unsigned* misc = (volatile LAS unsigned*)((LAS unsigned char*)lds + LDS_MISC);
    if (threadIdx.x < 32) misc[threadIdx.x] = 0u;
    if (threadIdx.x < 36) ((LAS unsigned long long*)((LAS unsigned char*)lds + LDS_PTAB))[threadIdx.x] = (unsigned long long)a.in[threadIdx.x];
    __syncthreads();
    XcdBarrier bar = xcd_barrier_post((unsigned*)(as_global(a.ws) + WS_CTL) + CW_BAR, misc + 8);
    run_stages<0>(a, sm, bar);
}

extern "C" void kernel_launch(void* const* d_in, const int* in_sizes, int n_in, void* d_out, int out_size, void* d_ws, size_t ws_size, hipStream_t stream) {
    static int grid = 0;
    if (grid == 0) {
        if (n_in != 36 || out_size != M * D || ws_size < WS_END) { fprintf(stderr, "kernel_launch: unexpected n_in %d / out %d / ws %zu\n", n_in, out_size, ws_size); grid = -1; return; }
        int dev = 0, cus = 0;
        if (hipGetDevice(&dev) != hipSuccess || hipDeviceGetAttribute(&cus, hipDeviceAttributeMultiprocessorCount, dev) != hipSuccess) { grid = -1; return; }
        if (hipFuncSetAttribute((const void*)mega, hipFuncAttributeMaxDynamicSharedMemorySize, LDS_BYTES) != hipSuccess) { fprintf(stderr, "kernel_launch: hipFuncSetAttribute failed\n"); grid = -1; return; }
        int per_cu = 0;
        if (hipOccupancyMaxActiveBlocksPerMultiprocessor(&per_cu, (const void*)mega, 512, LDS_BYTES) != hipSuccess || per_cu < 1) { fprintf(stderr, "kernel_launch: occupancy query says %d\n", per_cu); }
        (void)hipGetLastError();
        grid = cus;
    }
    if (grid < 0) return;
    (void)hipMemsetAsync((char*)d_ws + WS_CTL, 0, 1 * MiB, stream);
    Args a{};
    for (int i = 0; i < 36; ++i) a.in[i] = (const float*)d_in[i];
    a.out = (float*)d_out; a.ws = (unsigned char*)d_ws;
    a.stage = 0; a.pad = ST_COUNT;
    hipLaunchKernelGGL(mega, dim3(grid), dim3(512), LDS_BYTES, stream, a);
}
```

```cpp
#include <hip/hip_runtime.h>
#include <cstdio>
#include <cstdint>

typedef unsigned short bf16_t;
typedef float f32x4 __attribute__((ext_vector_type(4)));

constexpr int D = 1024, NB = 4, T = 8192, M = NB * T, NMEM = 256;
constexpr int IN_COLS = 4384, LDP = 4608;
constexpr int C_Q = 0, C_KCMP = 512, C_VCMP = 640, C_KSLC = 768, C_VSLC = 896, C_KWIN = 1024, C_VWIN = 1152, C_XM = 1280, C_OPRE = 1792, C_GA = 2304, C_GB = 3328, C_SMALL = 4352;
constexpr int NEXP = 32, TOPK = 4, NASG = M * TOPK, MOE_PAD = 256, MOE_ROWS_MAX = NASG + NEXP * MOE_PAD;
constexpr float EPS = 1e-5f;
constexpr int LDS_MISC = 131072 + 8192, LDS_PTAB = LDS_MISC + 1024;

__host__ __device__ constexpr int my2orig(int c) { return c < 1280 ? c : (c < 2304 ? c + 24 : (c < 4352 ? c + 32 : (c < 4376 ? 1280 + (c - 4352) : 2328 + (c - 4376)))); }

constexpr size_t MiB = 1u << 20;
constexpr size_t WS_CTL = 0;
constexpr size_t WS_SMALL = 1 * MiB;
constexpr size_t WS_W = 48 * MiB;
constexpr size_t WS_GATES = 288 * MiB;
constexpr size_t WS_PROJ = 292 * MiB;
constexpr size_t WS_X1 = 580 * MiB;
constexpr size_t WS_YA = 708 * MiB;
constexpr size_t WS_YB = 740 * MiB;
constexpr size_t WS_T1 = 772 * MiB;
constexpr size_t WS_END = 1024 * MiB;
constexpr size_t SM_RSTD0 = 0, SM_RSTD1 = 128 * 1024, SM_RSTD2 = 256 * 1024, SM_RSTDM = 384 * 1024, SM_BIAS1 = 392 * 1024  ,
    SM_CNT = 400 * 1024  , SM_NT = 401 * 1024  , SM_TEXP = 402 * 1024  ,
    SM_KC = 1 * MiB  , SM_VC = 1 * MiB + 512 * 1024, SM_H1 = 2 * MiB  ,
    SM_KX = 6 * MiB  , SM_VX = 10 * MiB, SM_LOGIT = 14 * MiB  ,
    SM_TE = 18 * MiB  , SM_TW = 18 * MiB + 512 * 1024  , SM_TP = 19 * MiB  ,
    SM_RSLOT = 20 * MiB  ;

struct Args {
    const float* in[36];
    float* out;
    unsigned char* ws;
    int stage, pad;
};

#define GLB __attribute__((address_space(1)))
template <class T> __device__ __forceinline__ T* glb_ptr(unsigned long long v) { return (T*)((GLB T*)v); }
template <class T> __device__ __forceinline__ T* as_global(T* p) { return glb_ptr<T>((unsigned long long)p); }
__device__ __forceinline__ float bf2f(bf16_t v) { return __uint_as_float(((unsigned)v) << 16); }
__device__ __forceinline__ bf16_t f2bf(float f) { unsigned u = __float_as_uint(f); u += 0x7fffu + ((u >> 16) & 1u); return (bf16_t)(u >> 16); }
__device__ __forceinline__ float sigmoidf_(float x) { return 1.f / (1.f + __expf(-x)); }
__device__ __forceinline__ float wave_sum(float v) {
#pragma unroll
    for (int o = 1; o < 64; o <<= 1) v += __shfl_xor(v, o);
    return v;
}
__device__ __forceinline__ float wave_max(float v) {
#pragma unroll
    for (int o = 1; o < 64; o <<= 1) v = fmaxf(v, __shfl_xor(v, o));
    return v;
}

__device__ void nv_rstd(const float* x, float* rstd, int rows, int bid, int nb) {
    const int lane = threadIdx.x & 63, wv = threadIdx.x >> 6, nwv = blockDim.x >> 6;
    for (int m = bid * nwv + wv; m < rows; m += nb * nwv) {
        const f32x4* xr = (const f32x4*)(x + (size_t)m * D) + lane;
        float s = 0.f;
#pragma unroll
        for (int j = 0; j < 4; ++j) { f32x4 v = xr[64 * j]; s += v.x * v.x + v.y * v.y + v.z * v.z + v.w * v.w; }
        s = wave_sum(s);
        if (lane == 0) rstd[m] = rsqrtf(s * (1.f / D) + EPS);
    }
}

template <class FA, class FB, class FE>
__device__ void nv_gemm(int Mr, int N, int K, FA fa, FB fb, FE fe, float* sm, int bid, int nb) {
    const int tid = threadIdx.x, tx = tid & 15, ty = tid >> 4;
    float* As = sm; float* Bs = sm + 16 * 132;
    const int tm = (Mr + 127) / 128, tn = (N + 63) / 64;
    for (int tile = bid; tile < tm * tn; tile += nb) {
        const int m0 = (tile / tn) * 128, n0 = (tile % tn) * 64;
        float acc[4][4];
#pragma unroll
        for (int i = 0; i < 4; ++i)
#pragma unroll
            for (int j = 0; j < 4; ++j) acc[i][j] = 0.f;
        for (int k0 = 0; k0 < K; k0 += 16) {
#pragma unroll
            for (int i = 0; i < 4; ++i) { const int idx = tid + 512 * i, r = idx >> 4, kk = idx & 15; As[kk * 132 + r] = (m0 + r < Mr && k0 + kk < K) ? fa(m0 + r, k0 + kk) : 0.f; }
#pragma unroll
            for (int i = 0; i < 2; ++i) { const int idx = tid + 512 * i, kk = idx >> 6, c = idx & 63; Bs[kk * 64 + c] = (n0 + c < N && k0 + kk < K) ? fb(k0 + kk, n0 + c, m0) : 0.f; }
            __syncthreads();
#pragma unroll
            for (int kk = 0; kk < 16; ++kk) {
                const f32x4 a = *(const f32x4*)&As[kk * 132 + ty * 4], b = *(const f32x4*)&Bs[kk * 64 + tx * 4];
#pragma unroll
                for (int i = 0; i < 4; ++i)
#pragma unroll
                    for (int j = 0; j < 4; ++j) acc[i][j] += a[i] * b[j];
            }
            __syncthreads();
        }
#pragma unroll
        for (int i = 0; i < 4; ++i) if (m0 + ty * 4 + i < Mr && n0 + tx * 4 < N) fe(m0 + ty * 4 + i, n0 + tx * 4, acc[i]);
    }
}

constexpr int NSA_SM_FLOATS = 256 + 4096 + 16 + 512 + 128 + 128 + 16 + 512;
__device__ __forceinline__ void nsa_head_softmax(float* sch, int n, int h, int lt, float* red) {
    float mx = -INFINITY;
    for (int j = lt; j < n; j += 128) mx = fmaxf(mx, sch[j]);
    mx = wave_max(mx);
    if ((lt & 63) == 0) red[h * 2 + (lt >> 6)] = mx;
    __syncthreads();
    mx = fmaxf(red[h * 2], red[h * 2 + 1]);
    float s = 0.f;
    for (int j = lt; j < n; j += 128) { const float e = (mx == -INFINITY) ? 0.f : __expf(sch[j] - mx); sch[j] = e; s += e; }
    s = wave_sum(s);
    __syncthreads();
    if ((lt & 63) == 0) red[8 + h * 2 + (lt >> 6)] = s;
    __syncthreads();
    s = red[8 + h * 2] + red[8 + h * 2 + 1];
    const float inv = s > 0.f ? 1.f / s : 0.f;
    for (int j = lt; j < n; j += 128) sch[j] *= inv;
    __syncthreads();
}
template <class FV>
__device__ __forceinline__ float nsa_head_pv(const float* sch, int n, int h, int lt, float* opart, FV fv) {
    const int d = lt & 63, half = lt >> 6;
    float o = 0.f;
    for (int j = half; j < n; j += 2) { const float p = sch[j]; if (p != 0.f) o += p * fv(j, d); }
    opart[(h * 2 + half) * 64 + d] = o;
    __syncthreads();
    o = opart[(h * 2) * 64 + d] + opart[(h * 2 + 1) * 64 + d];
    __syncthreads();
    return o;
}
__device__ void nv_nsa(const bf16_t* proj, const float* gates, const bf16_t* kc, const bf16_t* vc, bf16_t* ya, float* sm, int bid, int nb) {
    const int tid = threadIdx.x, h = tid >> 7, lt = tid & 127;
    float* q = sm; float* sc = sm + 256; float* red = sc + 4096; float* pg = red + 16; float* impv = pg + 512; float* scorev = impv + 128; int* sel = (int*)(scorev + 128); float* opart = (float*)(sel + 16);
    float* sch = sc + h * 1024;
    for (int unit = bid; unit < NB * 2 * T; unit += nb) {
        const int t = unit % T, g = (unit / T) & 1, b = unit / (2 * T);
        const size_t m = (size_t)b * T + t;
        if (lt < 64) q[h * 64 + lt] = bf2f(proj[m * LDP + C_Q + (g * 4 + h) * 64 + lt]) * 0.125f;
        __syncthreads();
        float yacc = 0.f;
        const int ncv = (t >= 31) ? min((t - 31) / 16 + 1, 511) : 0;
        const bf16_t* kcb = kc + (size_t)(b * 2 + g) * 512 * 64; const bf16_t* vcb = vc + (size_t)(b * 2 + g) * 512 * 64;
        for (int j = lt; j < 512; j += 128) {
            float s = -INFINITY;
            if (j < ncv) { s = 0.f; for (int d = 0; d < 64; ++d) s += q[h * 64 + d] * bf2f(kcb[j * 64 + d]); }
            sch[j] = s;
        }
        __syncthreads();
        nsa_head_softmax(sch, 512, h, lt, red);
        { const float o = nsa_head_pv(sch, 512, h, lt, opart, [&](int j, int d) { return bf2f(vcb[j * 64 + d]); });
          yacc += sigmoidf_(gates[m * 32 + (g * 4 + h) * 3 + 0]) * o; }
        pg[tid] = sc[tid] + sc[1024 + tid] + sc[2048 + tid] + sc[3072 + tid];
        __syncthreads();
        const int cur = t >> 6;
        if (tid < 128) {
            const int bk = tid; float im = 0.f;
            { const int i0 = 4 * bk - 1; if (i0 >= 0 && i0 < 511) im += pg[i0]; }
#pragma unroll
            for (int e = 0; e < 3; ++e) { const int i1 = 4 * bk + e; if (i1 < 511) im += 2.f * pg[i1]; }
            { const int i4 = 4 * bk + 3; if (i4 < 511) im += pg[i4]; }
            const bool valid = bk <= cur, forced = (bk == 0) || (bk == cur) || (bk == cur - 1);
            scorev[bk] = valid ? (forced ? 1e30f : im) : -1e30f;
        }
        __syncthreads();
        if (tid < 128) {
            const float sv = scorev[tid]; int rank = 0;
            for (int k = 0; k < 128; ++k) { const float o = scorev[k]; rank += (o > sv || (o == sv && k < tid)) ? 1 : 0; }
            if (rank < 16) sel[rank] = tid;
        }
        __syncthreads();
        for (int idx = lt; idx < 1024; idx += 128) {
            const int kpos = sel[idx >> 6] * 64 + (idx & 63);
            float s = -INFINITY;
            if (kpos <= t) { const bf16_t* kr = proj + ((size_t)b * T + kpos) * LDP + C_KSLC + g * 64; s = 0.f; for (int d = 0; d < 64; ++d) s += q[h * 64 + d] * bf2f(kr[d]); }
            sch[idx] = s;
        }
        __syncthreads();
        nsa_head_softmax(sch, 1024, h, lt, red);
        { const float o = nsa_head_pv(sch, 1024, h, lt, opart, [&](int j, int d) { const int kpos = sel[j >> 6] * 64 + (j & 63); return bf2f(proj[((size_t)b * T + kpos) * LDP + C_VSLC + g * 64 + d]); });
          yacc += sigmoidf_(gates[m * 32 + (g * 4 + h) * 3 + 1]) * o; }
        for (int idx = lt; idx < 512; idx += 128) {
            const int kp = t - 511 + idx;
            float s = -INFINITY;
            if (kp >= 0) { const bf16_t* kr = proj + ((size_t)b * T + kp) * LDP + C_KWIN + g * 64; s = 0.f; for (int d = 0; d < 64; ++d) s += q[h * 64 + d] * bf2f(kr[d]); }
            sch[idx] = s;
        }
        __syncthreads();
        nsa_head_softmax(sch, 512, h, lt, red);
        { const float o = nsa_head_pv(sch, 512, h, lt, opart, [&](int j, int d) { const int kp = t - 511 + j; return bf2f(proj[((size_t)b * T + kp) * LDP + C_VWIN + g * 64 + d]); });
          yacc += sigmoidf_(gates[m * 32 + (g * 4 + h) * 3 + 2]) * o; }
        if (lt < 64) ya[m * 512 + (g * 4 + h) * 64 + lt] = f2bf(yacc);
        __syncthreads();
    }
}

__device__ void nv_mlstm_seq(const bf16_t* qb, const bf16_t* kb, const bf16_t* vb, const float* gates, const float* b_i, const float* b_f, float* hbuf, float* sm, int bid, int nb) {
    const int tid = threadIdx.x, col = tid >> 1, half = tid & 1;
    for (int unit = bid; unit < NB * 4; unit += nb) {
        const int b = unit >> 2, h = unit & 3;
        float C[64];
#pragma unroll
        for (int i = 0; i < 64; ++i) C[i] = 0.f;
        float mprev = 0.f;
        const float bi = b_i[h], bfv = b_f[h];
        for (int t = 0; t < T; ++t) {
            const size_t m = (size_t)b * T + t;
            const float fp = gates[m * 32 + 28 + h] + bfv, li = gates[m * 32 + 24 + h] + bi;
            const float lf = fminf(fp, 0.f) - log1pf(__expf(-fabsf(fp)));
            const float mnew = fmaxf(lf + mprev, li);
            const float fs = __expf(lf + mprev - mnew), is = __expf(li - mnew);
            float num = 0.f;
            if (col <= 128) {
                const float vt = (col < 128) ? bf2f(vb[m * 512 + h * 128 + col]) : 1.f;
                const float iv = is * vt;
                const bf16_t* kr = kb + m * 512 + h * 128 + half * 64; const bf16_t* qr = qb + m * 512 + h * 128 + half * 64;
#pragma unroll
                for (int i = 0; i < 64; ++i) { C[i] = fs * C[i] + iv * bf2f(kr[i]); num += bf2f(qr[i]) * C[i]; }
            }
            num += __shfl_xor(num, 1);
            if (tid == 256) sm[t & 1] = num;
            __syncthreads();
            if (col < 128 && half == 0) { const float den = sm[t & 1]; hbuf[m * 512 + h * 128 + col] = num / fmaxf(fabsf(den), __expf(-mnew)); }
            mprev = mnew;
        }
        __syncthreads();
    }
}

#define LAS __attribute__((address_space(3)))
namespace pg8 {
typedef short bf16x8 __attribute__((ext_vector_type(8)));
typedef unsigned u32x4 __attribute__((ext_vector_type(4)));
typedef unsigned u32x2 __attribute__((ext_vector_type(2)));
typedef int v4i __attribute__((ext_vector_type(4)));
typedef int v8i __attribute__((ext_vector_type(8)));
constexpr int BM = 256, BK = 64, HALF = 128, HTB = HALF * BK * 2, STAGE_BYTES = 8 * HTB, NXCD = 8, WGM = 8;
__host__ __device__ __forceinline__ int lds_byte(int r, int c) { const int st = (r >> 4) * 2 + (c >> 5), rr = r & 15, cc = c & 31, ob = rr * 64 + cc * 2; return st * 1024 + (ob ^ (((ob >> 9) & 1) << 5)); }
__host__ __device__ __forceinline__ void stage_rc(int b, int& R, int& C) { const int st = b / 1024, sb = b % 1024, swz = sb ^ (((sb >> 9) & 1) << 5); R = (st >> 1) * 16 + swz / 64; C = (st & 1) * 32 + (swz % 64) / 2; }
__host__ __device__ __forceinline__ int perm32(int rho) { const int n = rho >> 4, i = rho & 15; return 8 * (i >> 2) + 4 * n + (i & 3); }
struct Unit { int pm, pn, e, part; };
struct Off4 { unsigned p0, p1; };
__device__ __forceinline__ void tile_of(int L, int nM, int nN, int& pm, int& pn) {
    const int nwg = nM * nN; int wgid = L;
    { const int q = nwg / NXCD, r = nwg % NXCD, xcd = wgid % NXCD, off = wgid / NXCD; wgid = (xcd < r ? xcd * (q + 1) : r * (q + 1) + (xcd - r) * q) + off; }
    const int nig = WGM * nN, gid = wgid / nig, fm = gid * WGM, gsz = (nM - fm) < WGM ? (nM - fm) : WGM;
    pm = fm + ((wgid % nig) % gsz); pn = (wgid % nig) / gsz;
}
__device__ __forceinline__ unsigned cvt_pk_bf16(float lo, float hi) { unsigned r; asm volatile("v_cvt_pk_bf16_f32 %0, %1, %2" : "=v"(r) : "v"(lo), "v"(hi)); return r; }

__device__ __forceinline__ const char* uni(const char* p) {
    const unsigned long long v = (unsigned long long)p;
    return glb_ptr<const char>(((unsigned long long)(unsigned)__builtin_amdgcn_readfirstlane((int)(v >> 32)) << 32) | (unsigned long long)(unsigned)__builtin_amdgcn_readfirstlane((int)(unsigned)v)); }
template <class Epi, class Sched>
__device__ __forceinline__ void gemm_phase(LAS unsigned char* lds, const Sched& S, const Epi& E) {
    int tid_ = threadIdx.x; asm volatile("" : "+v"(tid_));
    const int tid = tid_, wid = __builtin_amdgcn_readfirstlane(tid >> 6), lane = tid & 63, wr = wid >> 2, wc = wid & 3, fr = lane & 15, fq = lane >> 4;
    const int nt = S.ntk;
    int Rr[2], Cc[2]; unsigned voffA[2], voffB[2];
#pragma unroll
    for (int i = 0; i < 2; ++i) { stage_rc(tid * 16 + i * 8192, Rr[i], Cc[i]); const int Rb = Epi::PERM ? ((Rr[i] & ~31) + perm32(Rr[i] & 31)) : Rr[i];
        voffA[i] = (unsigned)Rr[i] * S.lda2 + (unsigned)Cc[i] * 2u; voffB[i] = (unsigned)Rb * S.ldb2 + (unsigned)Cc[i] * 2u; }
    const unsigned kA = (unsigned)S.kstepA, hA = (unsigned)HALF * S.lda2, hB = (unsigned)HALF * S.ldb2; constexpr unsigned kB = BK * 2;
    const char* const baseA = uni(S.abase()); const char* const baseB = uni(S.bbase());
    const unsigned ldsw = (unsigned)wid * 1024u;
    const int aoff = lds_byte(wr * 64 + fr, fq * 8), boff = lds_byte(wc * 32 + fr, fq * 8);
#define PG8_SA(b, h) (((b) * 2 + (h)) * HTB)
#define PG8_SB(b, h) ((4 + (b) * 2 + (h)) * HTB)
#define PG8_STG(bufoff, p0, p1) do { __builtin_amdgcn_global_load_lds((const unsigned*)(p0), (LAS unsigned*)(lds + (bufoff) + ldsw), 16, 0, 0); \
        __builtin_amdgcn_global_load_lds((const unsigned*)(p1), (LAS unsigned*)(lds + (bufoff) + ldsw + 8192), 16, 0, 0); } while (0)
#define PG8_STA(bufoff, ao, h, vv) do { if constexpr (Sched::GATHER) { const unsigned _pp = (h) ? vv.p1 : vv.p0; PG8_STG(bufoff, baseA + ((ao) + (_pp & 0xffffu) * S.lda2 + gcol), baseA + ((ao) + (_pp >> 16) * S.lda2 + gcol)); } \
        else { const unsigned _p = (ao) + (h) * hA; PG8_STG(bufoff, baseA + (_p + voffA[0]), baseA + (_p + voffA[1])); } } while (0)
#define PG8_STB(bufoff, bo, h) do { const unsigned _q = (bo) + (h) * hB; PG8_STG(bufoff, baseB + (_q + voffB[0]), baseB + (_q + voffB[1])); } while (0)
#define PG8_CAT(x0, x1) __builtin_shufflevector(x0, x1, 0, 1, 2, 3, 4, 5, 6, 7)
#define PG8_LDA(dst, b, h) do { _Pragma("unroll") for (int m = 0; m < 4; ++m) { if constexpr (Sched::FP8) dst##8[m] = PG8_CAT(*(const LAS v4i*)(lds + PG8_SA(b, h) + aoff + m * 2048), *(const LAS v4i*)(lds + PG8_SA(b, h) + aoff + m * 2048 + 1024)); \
        else { _Pragma("unroll") for (int k = 0; k < 2; ++k) dst[m][k] = *(const LAS bf16x8*)(lds + PG8_SA(b, h) + aoff + m * 2048 + k * 1024); } } } while (0)
#define PG8_LDB(dst, b, h) do { _Pragma("unroll") for (int n = 0; n < 2; ++n) { if constexpr (Sched::FP8) dst##8[n] = PG8_CAT(*(const LAS v4i*)(lds + PG8_SB(b, h) + boff + n * 2048), *(const LAS v4i*)(lds + PG8_SB(b, h) + boff + n * 2048 + 1024)); \
        else { _Pragma("unroll") for (int k = 0; k < 2; ++k) dst[n][k] = *(const LAS bf16x8*)(lds + PG8_SB(b, h) + boff + n * 2048 + k * 1024); } } } while (0)
#define PG8_MMA(ai, bj, At, Bt) do { __builtin_amdgcn_s_setprio(1); _Pragma("unroll") for (int m = 0; m < 4; ++m) _Pragma("unroll") for (int n = 0; n < 2; ++n) { \
        if constexpr (Sched::FP8) asm volatile("v_mfma_scale_f32_16x16x128_f8f6f4 %0, %1, %2, %0, %3, %4 op_sel_hi:[0,0,0]" : "+v"(acc[ai][bj][m][n]) : "v"(Bt##8[n]), "v"(At##8[m]), "v"(sclB), "v"(sclA)); \
        else { _Pragma("unroll") for (int k = 0; k < 2; ++k) acc[ai][bj][m][n] = __builtin_amdgcn_mfma_f32_16x16x32_bf16(Bt[n][k], At[m][k], acc[ai][bj][m][n], 0, 0, 0); } } \
        __builtin_amdgcn_s_setprio(0); } while (0)
#define PG8_WAIT_V(n) asm volatile("s_waitcnt vmcnt(" #n ")" ::: "memory")
#define PG8_WAIT_L(n) asm volatile("s_waitcnt lgkmcnt(" #n ")" ::: "memory")
#define PG8_BAR __builtin_amdgcn_s_barrier()
#define PG8_SCHED __builtin_amdgcn_sched_barrier(0)
#define PG8_ZERO() do { _Pragma("unroll") for (int a_ = 0; a_ < 2; ++a_) _Pragma("unroll") for (int b_ = 0; b_ < 2; ++b_) _Pragma("unroll") for (int m_ = 0; m_ < 4; ++m_) _Pragma("unroll") for (int n_ = 0; n_ < 2; ++n_) acc[a_][b_][m_][n_] = (f32x4){0.f, 0.f, 0.f, 0.f}; } while (0)
    Unit cur, nxt; int ui = 0;
    if (!S.next(0, cur)) return;
    f32x4 acc[2][2][4][2];
    PG8_ZERO();
    int sclB = Sched::SB, sclA = 127; asm volatile("" : "+v"(sclB), "+v"(sclA));
    bf16x8 At[4][2], B0[2][2], B1[2][2]; v8i At8[4], B08[2], B18[2];
    unsigned cA = (unsigned)__builtin_amdgcn_readfirstlane((int)S.a_off(cur)), cB = (unsigned)__builtin_amdgcn_readfirstlane((int)S.b_off(cur));
    Off4 cvA{0u, 0u}, nvA{0u, 0u};
    const unsigned gcol = (unsigned)Cc[0] * 2u;
    if constexpr (Sched::GATHER) S.a_gather(cur, Rr[0], cvA);
    PG8_STB(PG8_SB(0, 0), cB, 0); PG8_STB(PG8_SB(0, 1), cB, 1); PG8_STA(PG8_SA(0, 0), cA, 0, cvA); PG8_STA(PG8_SA(0, 1), cA, 1, cvA);
    if (wr == 1) PG8_BAR;
    PG8_WAIT_V(2); PG8_BAR;
    PG8_STB(PG8_SB(1, 0), cB + kB, 0); PG8_STA(PG8_SA(1, 0), cA + kA, 0, cvA); PG8_STB(PG8_SB(1, 1), cB + kB, 1);
    PG8_WAIT_V(6); PG8_BAR;
    for (;;) {
        const bool has_next = S.next(ui + 1, nxt);
        const unsigned nA = has_next ? (unsigned)__builtin_amdgcn_readfirstlane((int)S.a_off(nxt)) : cA, nB = has_next ? (unsigned)__builtin_amdgcn_readfirstlane((int)S.b_off(nxt)) : cB;
        if constexpr (Sched::GATHER) { if (has_next) S.a_gather(nxt, Rr[0], nvA); else nvA = cvA; }
        for (int t = 0; t < nt; t += 2) {
            const bool last = (t == nt - 2);
            const unsigned a1 = cA + (unsigned)(t + 1) * kA;
            const unsigned a2 = last ? nA : cA + (unsigned)(t + 2) * kA, b2 = last ? nB : cB + (unsigned)(t + 2) * kB;
            const unsigned a3 = a2 + kA, b3 = b2 + kB;
#define v2 (last ? nvA : cvA)
            PG8_LDB(B0, 0, 0); PG8_LDB(B1, 0, 1); PG8_SCHED; PG8_LDA(At, 0, 0); PG8_STA(PG8_SA(1, 1), a1, 1, cvA);
            PG8_WAIT_V(8); PG8_WAIT_L(0); PG8_BAR; PG8_MMA(0, 0, At, B0); PG8_MMA(0, 1, At, B1); PG8_BAR; PG8_SCHED;
            PG8_LDA(At, 0, 1); PG8_STB(PG8_SB(0, 0), b2, 0); PG8_STB(PG8_SB(0, 1), b2, 1); PG8_STA(PG8_SA(0, 0), a2, 0, v2);
            PG8_WAIT_V(8); PG8_WAIT_L(0); PG8_BAR; PG8_MMA(1, 0, At, B0); PG8_MMA(1, 1, At, B1); PG8_BAR; PG8_SCHED;
            PG8_LDB(B0, 1, 0); PG8_LDB(B1, 1, 1); PG8_SCHED; PG8_LDA(At, 1, 0); PG8_STA(PG8_SA(0, 1), a2, 1, v2);
            PG8_WAIT_V(8); PG8_WAIT_L(0); PG8_BAR; PG8_MMA(0, 0, At, B0); PG8_MMA(0, 1, At, B1); PG8_BAR; PG8_SCHED;
            PG8_LDA(At, 1, 1); PG8_STB(PG8_SB(1, 0), b3, 0); PG8_STB(PG8_SB(1, 1), b3, 1); PG8_STA(PG8_SA(1, 0), a3, 0, v2);
            PG8_WAIT_V(8); PG8_WAIT_L(0); PG8_BAR; PG8_MMA(1, 0, At, B0); PG8_MMA(1, 1, At, B1); PG8_BAR; PG8_SCHED;
#undef v2
        }
        if (wr == 0) PG8_BAR;
        if constexpr (Sched::FP8) asm volatile("s_nop 15\n\ts_nop 15" ::: "memory");
        const bool keep = S.keep(cur);
        if (keep) E.mid(acc, cur, wr, wc, fr, fq); else E(acc, cur, wr, wc, fr, fq);
        if (!has_next) break;
        if (!keep) PG8_ZERO();
        cur = nxt; cA = nA; cB = nB; ++ui; cvA = nvA;
        if (wr == 1) PG8_BAR;
    }
    PG8_WAIT_V(0);
    PG8_BAR;
#undef PG8_SA
#undef PG8_SB
#undef PG8_STG
#undef PG8_STA
#undef PG8_STB
#undef PG8_LDA
#undef PG8_LDB
#undef PG8_MMA
#undef PG8_CAT
#undef PG8_WAIT_V
#undef PG8_WAIT_L
#undef PG8_BAR
#undef PG8_SCHED
#undef PG8_ZERO
}

struct DenseSched {
    static constexpr bool GATHER = false, FP8 = false; static constexpr int SB = 127;
    const char* A0; const char* B0; const char* A1; const char* B1; unsigned lda2, ldb2; size_t kstepA; int ntk, nM, nN, G, c, parts;
    __device__ __forceinline__ bool next(int i, Unit& u) const { const int ti = parts == 2 ? (i >> 1) : i; const long L = (long)ti * G + c; if (L >= (long)nM * nN) return false;
        tile_of((int)L, nM, nN, u.pm, u.pn); u.e = 0; u.part = parts == 2 ? (i & 1) : 0; return true; }
    __device__ __forceinline__ const char* abase() const { return A0; }
    __device__ __forceinline__ const char* bbase() const { return B0; }
    __device__ __forceinline__ unsigned a_off(const Unit& u) const { return (u.part ? (unsigned)(A1 - A0) : 0u) + (unsigned)u.pm * BM * lda2; }
    __device__ __forceinline__ unsigned b_off(const Unit& u) const { return (u.part ? (unsigned)(B1 - B0) : 0u) + (unsigned)u.pn * BM * ldb2; }
    __device__ __forceinline__ bool keep(const Unit& u) const { return parts == 2 && u.part == 0; }
    __device__ __forceinline__ void a_gather(const Unit&, int, Off4&) const {}
};
struct MoeSched {
    const char* A; const char* Bt; unsigned lda2, ldb2; size_t kstepA; int ntk, nM, nN, G, c; size_t bexp;
    const LAS int* tend; const unsigned* rowpair;
    __device__ __forceinline__ bool next(int i, Unit& u) const { const long L = (long)i * G + c; if (L >= (long)nM * nN) return false;
        tile_of((int)L, nM, nN, u.pm, u.pn); int e = 0;
#pragma unroll
        for (int j = 0; j < 31; ++j) e += (u.pm >= tend[j]) ? 1 : 0;
        u.e = __builtin_amdgcn_readfirstlane(e); u.part = 0; return true; }
    __device__ __forceinline__ const char* abase() const { return A; }
    __device__ __forceinline__ const char* bbase() const { return Bt; }
    __device__ __forceinline__ unsigned b_off(const Unit& u) const { return (unsigned)u.e * (unsigned)bexp + (unsigned)u.pn * BM * ldb2; }
    __device__ __forceinline__ bool keep(const Unit&) const { return false; }
};
struct MoeSched1 : MoeSched { static constexpr bool GATHER = true, FP8 = true; static constexpr int SB = 122;
    __device__ __forceinline__ unsigned a_off(const Unit&) const { return 0u; }
    __device__ __forceinline__ void a_gather(const Unit& u, int R0, Off4& off) const {
        off.p0 = rowpair[(u.pm * 2) * 64 + R0]; off.p1 = rowpair[(u.pm * 2 + 1) * 64 + R0]; }
};
struct MoeSched2 : MoeSched { static constexpr bool GATHER = false, FP8 = true; static constexpr int SB = 122;
    __device__ __forceinline__ unsigned a_off(const Unit& u) const { return (unsigned)u.pm * BM * lda2; }
    __device__ __forceinline__ void a_gather(const Unit&, int, Off4&) const {}
};

typedef f32x4 Acc[2][2][4][2];
__device__ __forceinline__ float rstd_from_ssq(const float* ssq, size_t row) {
    const f32x4* p = (const f32x4*)(ssq + row * 16); const f32x4 a = p[0], b = p[1], c = p[2], d = p[3];
    const float s = ((a.x + a.y) + (a.z + a.w)) + ((b.x + b.y) + (b.z + b.w)) + ((c.x + c.y) + (c.z + c.w)) + ((d.x + d.y) + (d.z + d.w));
    return rsqrtf(s * (1.f / 1024.f) + 1e-5f);
}
__device__ __forceinline__ unsigned pack4_fp8(const f32x4& v) { int w = __builtin_amdgcn_cvt_pk_fp8_f32(v[0], v[1], 0, false); w = __builtin_amdgcn_cvt_pk_fp8_f32(v[2], v[3], w, true); return (unsigned)w; }
__device__ __forceinline__ u32x4 pack8(const f32x4& v0, const f32x4& v1) { u32x4 w; w.x = cvt_pk_bf16(v0[0], v0[1]); w.y = cvt_pk_bf16(v0[2], v0[3]); w.z = cvt_pk_bf16(v1[0], v1[1]); w.w = cvt_pk_bf16(v1[2], v1[3]); return w; }
__device__ __forceinline__ void unpack8(const u32x4& w, f32x4& v0, f32x4& v1) {
    v0[0] = __uint_as_float(w.x << 16); v0[1] = __uint_as_float(w.x & 0xffff0000u); v0[2] = __uint_as_float(w.y << 16); v0[3] = __uint_as_float(w.y & 0xffff0000u);
    v1[0] = __uint_as_float(w.z << 16); v1[1] = __uint_as_float(w.z & 0xffff0000u); v1[2] = __uint_as_float(w.w << 16); v1[3] = __uint_as_float(w.w & 0xffff0000u); }

struct EpiProj { static constexpr bool PERM = true;
    bf16_t* proj; float* gates; bf16_t* kvc;
    __device__ __forceinline__ void mid(Acc&, const Unit&, int, int, int, int) const {}
    __device__ __forceinline__ void operator()(const Acc& acc, const Unit& u, int wr, int wc, int fr, int fq) const {
        const int row0 = u.pm * BM + wr * 64 + fr, col0 = u.pn * BM + wc * 32 + 8 * fq;
#pragma unroll
        for (int ai = 0; ai < 2; ++ai)
#pragma unroll
            for (int m = 0; m < 4; ++m) { const size_t row = row0 + ai * HALF + m * 16; bf16_t* rowp = proj + row * LDP + col0;
                if (u.pn >= 2 && u.pn <= 4) { const int cc = wc * 32 + 8 * fq, g = cc >> 6, d = cc & 63; const size_t bt = ((row >> 13) * 2 + g) * (size_t)T + (row & (T - 1));
#pragma unroll
                    for (int bj = 0; bj < 2; ++bj) *(u32x4*)(kvc + ((size_t)((u.pn - 2) * 2 + bj) * M * 128) + bt * 64 + d) = pack8(acc[ai][bj][m][0], acc[ai][bj][m][1]);
                    continue; }
#pragma unroll
                for (int bj = 0; bj < 2; ++bj) *(u32x4*)(rowp + bj * HALF) = pack8(acc[ai][bj][m][0], acc[ai][bj][m][1]);
                if (u.pn == 17 && wc == 0) { *(f32x4*)(gates + row * 32 + 8 * fq) = acc[ai][0][m][0]; *(f32x4*)(gates + row * 32 + 8 * fq + 4) = acc[ai][0][m][1]; } }
    }
};
struct EpiMerged { static constexpr bool PERM = true;
    const bf16_t* proj; bf16_t* mg;
    __device__ __forceinline__ void mid(Acc& acc, const Unit& u, int wr, int wc, int fr, int fq) const {
        const int row0 = u.pm * BM + wr * 64 + fr, col0 = u.pn * BM + wc * 32 + 8 * fq;
#pragma unroll
        for (int ai = 0; ai < 2; ++ai) { u32x4 ga[4][2], gb[4][2];
#pragma unroll
            for (int m = 0; m < 4; ++m)
#pragma unroll
                for (int bj = 0; bj < 2; ++bj) { const bf16_t* pp = proj + (size_t)(row0 + ai * HALF + m * 16) * LDP + col0 + bj * HALF; ga[m][bj] = *(const u32x4*)(pp + C_GA); gb[m][bj] = *(const u32x4*)(pp + C_GB); }
#pragma unroll
            for (int m = 0; m < 4; ++m)
#pragma unroll
                for (int bj = 0; bj < 2; ++bj) { f32x4 a0, a1, b0, b1; unpack8(ga[m][bj], a0, a1); unpack8(gb[m][bj], b0, b1);
#pragma unroll
                    for (int j = 0; j < 4; ++j) { acc[ai][bj][m][0][j] *= (1.f + __expf(-b0[j])) * __builtin_amdgcn_rcpf(1.f + __expf(-a0[j])); acc[ai][bj][m][1][j] *= (1.f + __expf(-b1[j])) * __builtin_amdgcn_rcpf(1.f + __expf(-a1[j])); } } }
    }
    __device__ __forceinline__ void operator()(const Acc& acc, const Unit& u, int wr, int wc, int fr, int fq) const {
        const int row0 = u.pm * BM + wr * 64 + fr, col0 = u.pn * BM + wc * 32 + 8 * fq;
        u32x4 gba[2][4][2];
#pragma unroll
        for (int ai = 0; ai < 2; ++ai)
#pragma unroll
            for (int m = 0; m < 4; ++m)
#pragma unroll
                for (int bj = 0; bj < 2; ++bj) gba[ai][m][bj] = *(const u32x4*)(proj + (size_t)(row0 + ai * HALF + m * 16) * LDP + C_GB + col0 + bj * HALF);
#pragma unroll
        for (int ai = 0; ai < 2; ++ai) {
#pragma unroll
            for (int m = 0; m < 4; ++m)
#pragma unroll
                for (int bj = 0; bj < 2; ++bj) { f32x4 b0, b1; unpack8(gba[ai][m][bj], b0, b1); f32x4 v0 = acc[ai][bj][m][0], v1 = acc[ai][bj][m][1];
#pragma unroll
                    for (int j = 0; j < 4; ++j) { v0[j] *= __builtin_amdgcn_rcpf(1.f + __expf(-b0[j])); v1[j] *= __builtin_amdgcn_rcpf(1.f + __expf(-b1[j])); }
                    *(u32x4*)(mg + (size_t)(row0 + ai * HALF + m * 16) * D + col0 + bj * HALF) = pack8(v0, v1); } }
    }
};
template <bool BASE_BF16>
struct EpiResid { static constexpr bool PERM = false;
    const void* base; bf16_t* xb; float* ssq; unsigned char* xq;
    __device__ __forceinline__ void mid(Acc&, const Unit&, int, int, int, int) const {}
    __device__ __forceinline__ void operator()(const Acc& acc, const Unit& u, int wr, int wc, int fr, int fq) const {
        const int row0 = u.pm * BM + wr * 64 + fr, col0 = u.pn * BM + wc * 32 + 4 * fq;
        if constexpr (BASE_BF16) {
            u32x2 bw[2][4][2][2];
#pragma unroll
            for (int ai = 0; ai < 2; ++ai)
#pragma unroll
                for (int m = 0; m < 4; ++m)
#pragma unroll
                    for (int bj = 0; bj < 2; ++bj)
#pragma unroll
                        for (int n = 0; n < 2; ++n) bw[ai][m][bj][n] = *(const u32x2*)((const bf16_t*)base + (size_t)(row0 + ai * HALF + m * 16) * D + col0 + bj * HALF + n * 16);
#pragma unroll
            for (int ai = 0; ai < 2; ++ai)
#pragma unroll
                for (int m = 0; m < 4; ++m) { const size_t row = row0 + ai * HALF + m * 16; float s = 0.f;
#pragma unroll
                    for (int bj = 0; bj < 2; ++bj)
#pragma unroll
                        for (int n = 0; n < 2; ++n) { const size_t o = row * D + col0 + bj * HALF + n * 16; const u32x2 b2 = bw[ai][m][bj][n];
                            const f32x4 v = (f32x4){__uint_as_float(b2.x << 16), __uint_as_float(b2.x & 0xffff0000u), __uint_as_float(b2.y << 16), __uint_as_float(b2.y & 0xffff0000u)} + acc[ai][bj][m][n];
                            u32x2 w; w.x = cvt_pk_bf16(v[0], v[1]); w.y = cvt_pk_bf16(v[2], v[3]); *(u32x2*)(xb + o) = w;
                            if (xq) *(unsigned*)(xq + o) = pack4_fp8(v);
                            s += (v[0] * v[0] + v[1] * v[1]) + (v[2] * v[2] + v[3] * v[3]); }
                    s += __shfl_xor(s, 16); s += __shfl_xor(s, 32);
                    if (fq == 0) ssq[row * 16 + u.pn * 4 + wc] = s; }
            return; }
#pragma unroll
        for (int ai = 0; ai < 2; ++ai) { f32x4 bv[4][2][2];
#pragma unroll
            for (int m = 0; m < 4; ++m)
#pragma unroll
                for (int bj = 0; bj < 2; ++bj)
#pragma unroll
                    for (int n = 0; n < 2; ++n) { const size_t o = (size_t)(row0 + ai * HALF + m * 16) * D + col0 + bj * HALF + n * 16;
                        if constexpr (BASE_BF16) { const u32x2 bw = *(const u32x2*)((const bf16_t*)base + o); bv[m][bj][n] = (f32x4){__uint_as_float(bw.x << 16), __uint_as_float(bw.x & 0xffff0000u), __uint_as_float(bw.y << 16), __uint_as_float(bw.y & 0xffff0000u)}; }
                        else bv[m][bj][n] = *(const f32x4*)((const float*)base + o); }
#pragma unroll
            for (int m = 0; m < 4; ++m) { const size_t row = row0 + ai * HALF + m * 16; float s = 0.f;
#pragma unroll
                for (int bj = 0; bj < 2; ++bj)
#pragma unroll
                    for (int n = 0; n < 2; ++n) { const size_t o = row * D + col0 + bj * HALF + n * 16; const f32x4 v = bv[m][bj][n] + acc[ai][bj][m][n];
                        u32x2 w; w.x = cvt_pk_bf16(v[0], v[1]); w.y = cvt_pk_bf16(v[2], v[3]); *(u32x2*)(xb + o) = w;
                        if (xq) *(unsigned*)(xq + o) = pack4_fp8(v);
                        s += (v[0] * v[0] + v[1] * v[1]) + (v[2] * v[2] + v[3] * v[3]); }
                s += __shfl_xor(s, 16); s += __shfl_xor(s, 32);
                if (fq == 0) ssq[row * 16 + u.pn * 4 + wc] = s; } }
    }
};
struct EpiScaleBf16 { static constexpr bool PERM = true;
    bf16_t* o; int ldo; const float* ssq;
    __device__ __forceinline__ void mid(Acc&, const Unit&, int, int, int, int) const {}
    __device__ __forceinline__ void operator()(const Acc& acc, const Unit& u, int wr, int wc, int fr, int fq) const {
        const int row0 = u.pm * BM + wr * 64 + fr, col0 = u.pn * BM + wc * 32 + 8 * fq;
        float rsa[2][4];
        if (ssq) { f32x4 qv[2][4];
#pragma unroll
            for (int ai = 0; ai < 2; ++ai)
#pragma unroll
                for (int m = 0; m < 4; ++m) qv[ai][m] = *(const f32x4*)(ssq + (size_t)(row0 + ai * HALF + m * 16) * 16 + 4 * fq);
#pragma unroll
            for (int ai = 0; ai < 2; ++ai)
#pragma unroll
                for (int m = 0; m < 4; ++m) { float sq = (qv[ai][m][0] + qv[ai][m][1]) + (qv[ai][m][2] + qv[ai][m][3]); sq += __shfl_xor(sq, 16); sq += __shfl_xor(sq, 32); rsa[ai][m] = rsqrtf(sq * (1.f / 1024.f) + 1e-5f); } }
        else {
#pragma unroll
            for (int ai = 0; ai < 2; ++ai)
#pragma unroll
                for (int m = 0; m < 4; ++m) rsa[ai][m] = 1.f; }
#pragma unroll
        for (int ai = 0; ai < 2; ++ai)
#pragma unroll
            for (int m = 0; m < 4; ++m) { const size_t row = row0 + ai * HALF + m * 16;
#pragma unroll
                for (int bj = 0; bj < 2; ++bj) *(u32x4*)(o + row * ldo + col0 + bj * HALF) = pack8(acc[ai][bj][m][0] * rsa[ai][m], acc[ai][bj][m][1] * rsa[ai][m]); }
    }
};
struct EpiLogit { static constexpr bool PERM = false;
    float* logit; const float* ssq; const float* bias;
    __device__ __forceinline__ void mid(Acc&, const Unit&, int, int, int, int) const {}
    __device__ __forceinline__ void operator()(const Acc& acc, const Unit& u, int wr, int wc, int fr, int fq) const {
        if (wc != 0) return;
        const int row0 = u.pm * BM + wr * 64 + fr;
#pragma unroll
        for (int ai = 0; ai < 2; ++ai)
#pragma unroll
            for (int m = 0; m < 4; ++m) { const size_t row = row0 + ai * HALF + m * 16; const float rs = rstd_from_ssq(ssq, row);
#pragma unroll
                for (int n = 0; n < 2; ++n) { const int c = n * 16 + 4 * fq; *(f32x4*)(logit + row * 32 + c) = acc[ai][0][m][n] * rs + *(const f32x4*)(bias + c); } }
    }
};
struct EpiMoe1 { static constexpr bool PERM = true;
    unsigned char* act; const float* rowrs; const float* bgu;
    __device__ __forceinline__ void mid(Acc&, const Unit&, int, int, int, int) const {}
    __device__ __forceinline__ void operator()(const Acc& acc, const Unit& u, int wr, int wc, int fr, int fq) const {
        const int row0 = u.pm * BM + wr * 64 + fr, c0 = u.pn * HALF + wc * 32 + 8 * fq;
        const float* bg = bgu + (size_t)u.e * 2048 + c0;
        float rsa[2][4];
#pragma unroll
        for (int ai = 0; ai < 2; ++ai)
#pragma unroll
            for (int m = 0; m < 4; ++m) rsa[ai][m] = rowrs[row0 + ai * HALF + m * 16];
        const f32x4 bg0 = *(const f32x4*)bg, bg1 = *(const f32x4*)(bg + 4), bu0 = *(const f32x4*)(bg + 1024), bu1 = *(const f32x4*)(bg + 1028);
#pragma unroll
        for (int ai = 0; ai < 2; ++ai)
            {
#pragma unroll
              for (int m = 0; m < 4; ++m) { const size_t row = row0 + ai * HALF + m * 16; const float rs = rsa[ai][m];
                f32x4 o0, o1;
#pragma unroll
                for (int j = 0; j < 4; ++j) {
                    float g0 = fminf(acc[ai][0][m][0][j] * rs + bg0[j], 7.f), u0 = fminf(fmaxf(acc[ai][1][m][0][j] * rs + bu0[j], -7.f), 7.f);
                    float g1 = fminf(acc[ai][0][m][1][j] * rs + bg1[j], 7.f), u1 = fminf(fmaxf(acc[ai][1][m][1][j] * rs + bu1[j], -7.f), 7.f);
                    o0[j] = (u0 + 1.f) * g0 * __builtin_amdgcn_rcpf(1.f + __expf(-1.702f * g0)); o1[j] = (u1 + 1.f) * g1 * __builtin_amdgcn_rcpf(1.f + __expf(-1.702f * g1)); }
                u32x2 w8; w8.x = pack4_fp8(o0); w8.y = pack4_fp8(o1); *(u32x2*)(act + row * D + c0) = w8; } }
    }
};
struct EpiMoe2 { static constexpr bool PERM = true;
    bf16_t* ys; const int* rslot; const float* roww; const float* bd;
    __device__ __forceinline__ void mid(Acc&, const Unit&, int, int, int, int) const {}
    __device__ __forceinline__ void operator()(const Acc& acc, const Unit& u, int wr, int wc, int fr, int fq) const {
        const int row0 = u.pm * BM + wr * 64 + fr, col0 = u.pn * BM + wc * 32 + 8 * fq;
        const float* bp = bd + (size_t)u.e * D + col0;
        int slv[2][4]; float wv_[2][4];
#pragma unroll
        for (int ai = 0; ai < 2; ++ai)
#pragma unroll
            for (int m = 0; m < 4; ++m) { slv[ai][m] = rslot[row0 + ai * HALF + m * 16]; wv_[ai][m] = roww[row0 + ai * HALF + m * 16]; }
        f32x4 bb[2][2];
#pragma unroll
        for (int bj = 0; bj < 2; ++bj) { bb[bj][0] = *(const f32x4*)(bp + bj * HALF); bb[bj][1] = *(const f32x4*)(bp + bj * HALF + 4); }
#pragma unroll
        for (int ai = 0; ai < 2; ++ai)
#pragma unroll
            for (int m = 0; m < 4; ++m) { const int sl = slv[ai][m]; const float w = wv_[ai][m]; if (sl < 0) continue;
#pragma unroll
                for (int bj = 0; bj < 2; ++bj) *(u32x4*)(ys + (size_t)sl * D + col0 + bj * HALF) = pack8((acc[ai][bj][m][0] + bb[bj][0]) * w, (acc[ai][bj][m][1] + bb[bj][1]) * w); }
    }
};
struct CmpSched {
    static constexpr bool GATHER = false, FP8 = false; static constexpr int SB = 127;
    const bf16_t* kvc; const char* Bt; unsigned lda2, ldb2; size_t kstepA; int ntk, G, c;
    __device__ __forceinline__ bool next(int i, Unit& u) const { const int L = i * G + c; if (L >= 32) return false; u.pm = L & 15; u.pn = 0; u.e = L >> 4; u.part = 0; return true; }
    __device__ __forceinline__ const char* abase() const { return (const char*)kvc; }
    __device__ __forceinline__ const char* bbase() const { return Bt; }
    __device__ __forceinline__ unsigned a_off(const Unit& u) const { const int bg = u.pm >> 1; return (unsigned)(((size_t)u.e * M * 128 + ((size_t)bg * T + 4096 * (u.pm & 1)) * 64) * 2); }
    __device__ __forceinline__ unsigned b_off(const Unit& u) const { return (unsigned)u.e * 256u * 2048u * 2u; }
    __device__ __forceinline__ bool keep(const Unit&) const { return false; }
    __device__ __forceinline__ void a_gather(const Unit&, int, Off4&) const {}
};
struct EpiCmp { static constexpr bool PERM = false;
    float* h1; const float* bias1;
    __device__ __forceinline__ void mid(Acc&, const Unit&, int, int, int, int) const {}
    __device__ __forceinline__ void operator()(const Acc& acc, const Unit& u, int wr, int wc, int fr, int fq) const {
        const int row0 = u.pm * BM + wr * 64 + fr, col0 = wc * 32 + 4 * fq;
        f32x4 bcv[2];
#pragma unroll
        for (int n = 0; n < 2; ++n) bcv[n] = *(const f32x4*)(bias1 + u.e * 128 + col0 + n * 16);
#pragma unroll
        for (int ai = 0; ai < 2; ++ai)
#pragma unroll
            for (int m = 0; m < 4; ++m) { const size_t row = (size_t)u.e * 4096 + row0 + ai * HALF + m * 16;
#pragma unroll
                for (int n = 0; n < 2; ++n) { const int c = col0 + n * 16; f32x4 v = acc[ai][0][m][n] + bcv[n];
#pragma unroll
                    for (int j = 0; j < 4; ++j) { const float t = v[j]; v[j] = 0.5f * t * (1.f + tanhf(0.7978845608028654f * (t + 0.044715f * t * t * t))); }
                    *(f32x4*)(h1 + row * 128 + c) = v; } }
    }
};
}

namespace nsa {
typedef short bf16x8 __attribute__((ext_vector_type(8)));
typedef short s16x4 __attribute__((ext_vector_type(4)));
typedef float f32x16 __attribute__((ext_vector_type(16)));
typedef unsigned u32x4 __attribute__((ext_vector_type(4)));
constexpr int L_K = 0, L_V = 16384, L_IMP = 32768, IMP_LD = 132, L_SEL = L_IMP + 64 * IMP_LD * 4, L_WSF = L_SEL + 1024, L_OST = L_WSF + 2048, L_END = L_OST + 65536;
constexpr float C2 = 0.125f * 1.4426950408889634f, THR = 6.f;
__device__ __forceinline__ s16x4 vtr(const LAS unsigned char* p) { typedef short v4i16_t __attribute__((ext_vector_type(4))); return __builtin_bit_cast(s16x4, __builtin_amdgcn_ds_read_tr16_b64_v4i16((LAS v4i16_t*)p)); }
template <int OFF> __device__ __forceinline__ s16x4 vtra(const LAS unsigned char* p) { s16x4 r; asm volatile("ds_read_b64_tr_b16 %0, %1 offset:%2" : "=v"(r) : "v"(p), "n"(OFF) : "memory"); return r; }
__device__ __forceinline__ float swap_max(float v) { auto rr = __builtin_amdgcn_permlane32_swap(__float_as_uint(v), __float_as_uint(v), false, false); return fmaxf(__uint_as_float(rr[0]), __uint_as_float(rr[1])); }
__device__ __forceinline__ float swap_sum(float v) { auto rr = __builtin_amdgcn_permlane32_swap(__float_as_uint(v), __float_as_uint(v), false, false); return __uint_as_float(rr[0]) + __uint_as_float(rr[1]); }
__device__ __forceinline__ unsigned pk(float lo, float hi) { return pg8::cvt_pk_bf16(lo, hi); }

struct Ctx { int tid, lane, wid, r32, hi, ksw; LAS unsigned char* lds; LAS float* wsf; };

__device__ __forceinline__ void qkt(f32x16& p0, f32x16& p1, const LAS unsigned char* kp, const bf16x8 (&qr)[4], int sw) {
    bf16x8 kf[8];
#pragma unroll
    for (int d0 = 0; d0 < 4; ++d0) { const int co = ((2 * d0) ^ sw) * 16; kf[2 * d0] = *(const LAS bf16x8*)(kp + co); kf[2 * d0 + 1] = *(const LAS bf16x8*)(kp + 4096 + co); }
    __builtin_amdgcn_sched_barrier(0);
    p0 = __builtin_amdgcn_mfma_f32_32x32x16_bf16(kf[0], qr[0], (f32x16){0.f,0.f,0.f,0.f,0.f,0.f,0.f,0.f,0.f,0.f,0.f,0.f,0.f,0.f,0.f,0.f}, 0, 0, 0);
    p1 = __builtin_amdgcn_mfma_f32_32x32x16_bf16(kf[1], qr[0], (f32x16){0.f,0.f,0.f,0.f,0.f,0.f,0.f,0.f,0.f,0.f,0.f,0.f,0.f,0.f,0.f,0.f}, 0, 0, 0);
#pragma unroll
    for (int d0 = 1; d0 < 4; ++d0) { p0 = __builtin_amdgcn_mfma_f32_32x32x16_bf16(kf[2 * d0], qr[d0], p0, 0, 0, 0); p1 = __builtin_amdgcn_mfma_f32_32x32x16_bf16(kf[2 * d0 + 1], qr[d0], p1, 0, 0, 0); }
}
__device__ __forceinline__ void pv(f32x16 (&o)[2], const LAS unsigned char* vp, const f32x16& p0, const f32x16& p1) {
    u32x4 pw[4];
    pw[0] = (u32x4){pk(p0[0], p0[1]), pk(p0[2], p0[3]), pk(p0[4], p0[5]), pk(p0[6], p0[7])}; pw[1] = (u32x4){pk(p0[8], p0[9]), pk(p0[10], p0[11]), pk(p0[12], p0[13]), pk(p0[14], p0[15])};
    pw[2] = (u32x4){pk(p1[0], p1[1]), pk(p1[2], p1[3]), pk(p1[4], p1[5]), pk(p1[6], p1[7])}; pw[3] = (u32x4){pk(p1[8], p1[9]), pk(p1[10], p1[11]), pk(p1[12], p1[13]), pk(p1[14], p1[15])};
    s16x4 vlo[8], vhi[8];
#pragma unroll
    for (int j = 0; j < 8; ++j) { vlo[j] = vtr(vp + (j >> 2) * 4096 + (j & 3) * 1024); vhi[j] = vtr(vp + (j >> 2) * 4096 + (j & 3) * 1024 + 512); }
    __builtin_amdgcn_sched_barrier(0);
#pragma unroll
    for (int j = 0; j < 8; ++j) { const s16x4 lo = vlo[j], hh = vhi[j];
        o[j >> 2] = __builtin_amdgcn_mfma_f32_32x32x16_bf16(__builtin_bit_cast(bf16x8, pw[j & 3]), (bf16x8){lo[0], lo[1], lo[2], lo[3], hh[0], hh[1], hh[2], hh[3]}, o[j >> 2], 0, 0, 0); }
}
__device__ __forceinline__ void scale_o(f32x16 (&o)[2], const Ctx& c, float f) {
    if (c.hi == 0) c.wsf[c.r32] = f;
#pragma unroll
    for (int g4 = 0; g4 < 4; ++g4) { const f32x4 w = *(const LAS f32x4*)(c.wsf + 8 * g4 + 4 * c.hi);
#pragma unroll
        for (int j = 0; j < 4; ++j) { o[0][4 * g4 + j] *= w[j]; o[1][4 * g4 + j] *= w[j]; } }
}
template <bool FIRST>
__device__ __forceinline__ void acc_y(const f32x16 (&o)[2], const Ctx& c, float f) {
    if (c.hi == 0) c.wsf[c.r32] = f;
    LAS float* stg = (LAS float*)(c.lds + L_OST + c.wid * 8192);
#pragma unroll
    for (int g4 = 0; g4 < 4; ++g4) { const f32x4 w = *(const LAS f32x4*)(c.wsf + 8 * g4 + 4 * c.hi);
#pragma unroll
        for (int j = 0; j < 4; ++j) { const int q = 8 * g4 + 4 * c.hi + j; LAS float* y0 = stg + q * 64 + c.r32;
            if (FIRST) { y0[0] = o[0][4 * g4 + j] * w[j]; y0[32] = o[1][4 * g4 + j] * w[j]; } else { y0[0] += o[0][4 * g4 + j] * w[j]; y0[32] += o[1][4 * g4 + j] * w[j]; } } }
}
template <bool HAS_O>
__device__ __forceinline__ void softmax_tile(f32x16& p0, f32x16& p1, float& mref, float& l, f32x16 (&o)[2], const Ctx& c, const bool alive = true) {
    float rm = fmaxf(p0[0], p1[0]);
#pragma unroll
    for (int r = 1; r < 16; ++r) rm = __builtin_fmaxf(__builtin_fmaxf(rm, p0[r]), p1[r]);
    rm = alive ? swap_max(rm) * C2 : -INFINITY;
    const bool need = rm > mref + THR;
    if (__any(need)) {
        const float mnew = need ? rm : mref, f = __builtin_amdgcn_exp2f(mref - mnew);
        l *= f; mref = mnew;
        if constexpr (HAS_O) scale_o(o, c, f);
    }
    const float nm = alive ? -mref : -INFINITY;
#pragma unroll
    for (int r = 0; r < 16; ++r) { p0[r] = __builtin_amdgcn_exp2f(__builtin_fmaf(p0[r], C2, nm)); p1[r] = __builtin_amdgcn_exp2f(__builtin_fmaf(p1[r], C2, nm)); }
    const f32x16 ps = p0 + p1;
    l += ((ps[0] + ps[1]) + (ps[2] + ps[3])) + ((ps[4] + ps[5]) + (ps[6] + ps[7])) + (((ps[8] + ps[9]) + (ps[10] + ps[11])) + ((ps[12] + ps[13]) + (ps[14] + ps[15])));
}

__device__ __forceinline__ int kslot_off(int s) { return L_K + ((s & 1) << 13) + ((s >> 1) << 15); }
__device__ __forceinline__ int vslot_off(int s) { return L_V + ((s & 1) << 13) + ((s >> 1) << 15); }
static_assert(L_K == 0 && L_V == 16384 && L_IMP == 32768, "slot maps");
__device__ __forceinline__ void dma16(const char* base, unsigned off, const Ctx& c, int ldsoff) {
    __builtin_amdgcn_global_load_lds((const unsigned*)(base + off), (LAS unsigned*)(c.lds + ldsoff + c.wid * 1024), 16, 0, 0); }
template <int NS, class FB>
__device__ __forceinline__ void tile_loop(int nt, const bf16_t* kb, const bf16_t* vb, int pitch, const Ctx& c, const bf16x8 (&qr)[4], FB body) {
    const size_t ts = (size_t)64 * pitch;
    constexpr int KD = NS == 4 ? 3 : 2, VD = NS == 4 ? 2 : 1;
    const LAS unsigned char* kq = c.lds + c.r32 * 128;
    const int vq = ((c.lane >> 4) & 1) * 32 + (c.lane & 3) * 8 + (4 * c.hi + ((c.lane & 15) >> 2)) * 64;
    const char* const kB = pg8::uni((const char*)kb); const char* const vB = pg8::uni((const char*)vb); const unsigned tsb = (unsigned)ts * 2u;
    unsigned kl, vl;
    { const int key = c.tid >> 3, cp = c.tid & 7; kl = (unsigned)(key * pitch + (cp ^ ((key >> 1) & 7)) * 8) * 2u;
      const int w = c.tid >> 6, ln = c.tid & 63; vl = (unsigned)((16 * (w & 3) + (ln >> 2)) * pitch + (w >> 2) * 32 + (ln & 3) * 8) * 2u; }
    dma16(kB, kl, c, kslot_off(0)); dma16(vB, vl, c, vslot_off(0));
    if (nt > 1) dma16(kB, tsb + kl, c, kslot_off(1));
    asm volatile("s_waitcnt vmcnt(0)" ::: "memory"); __builtin_amdgcn_s_barrier(); asm volatile("" ::: "memory");
    if (NS == 4) { if (nt > 2) dma16(kB, 2u * tsb + kl, c, kslot_off(2)); if (nt > 1) dma16(vB, tsb + vl, c, vslot_off(1)); }
    f32x16 pa0, pa1, pb0, pb1;
    qkt(pa0, pa1, kq + kslot_off(0), qr, c.ksw);
    asm volatile("s_waitcnt lgkmcnt(0)" ::: "memory"); __builtin_amdgcn_s_barrier(); asm volatile("" ::: "memory");
#define NSA_STEP(t, C0, C1, N0, N1, NEXT) do { \
        const bool ik = (t) + KD < nt, iv = (t) + VD < nt; \
        if (ik) dma16(kB, (unsigned)((t) + KD) * tsb + kl, c, kslot_off(((t) + KD) & (NS - 1))); \
        if (iv) dma16(vB, (unsigned)((t) + VD) * tsb + vl, c, vslot_off(((t) + VD) & (NS - 1))); \
        if (NEXT) qkt(N0, N1, kq + kslot_off(((t) + 1) & (NS - 1)), qr, c.ksw); \
        body((t), c.lds + vslot_off((t) & (NS - 1)) + vq, C0, C1); \
        if (NS == 4 && ik) asm volatile("s_waitcnt vmcnt(2) lgkmcnt(0)" ::: "memory"); \
        else if (NS == 4 && iv) asm volatile("s_waitcnt vmcnt(1) lgkmcnt(0)" ::: "memory"); \
        else asm volatile("s_waitcnt vmcnt(0) lgkmcnt(0)" ::: "memory"); \
        __builtin_amdgcn_s_barrier(); asm volatile("" ::: "memory"); } while (0)
    int tt = 0;
    for (; tt + 2 < nt; tt += 2) { NSA_STEP(tt, pa0, pa1, pb0, pb1, true); NSA_STEP(tt + 1, pb0, pb1, pa0, pa1, true); }
    if (tt + 2 == nt) { NSA_STEP(tt, pa0, pa1, pb0, pb1, true); NSA_STEP(tt + 1, pb0, pb1, pa0, pa1, false); }
    else { NSA_STEP(tt, pa0, pa1, pb0, pb1, false); }
#undef NSA_STEP
}
__device__ __forceinline__ void tile_loop4_prefetch(int nt, const bf16_t* kb, const bf16_t* vb, const Ctx& c) {
    constexpr int pitch = 64; const unsigned tsb = 64u * pitch * 2u;
    const char* const kB = pg8::uni((const char*)kb); const char* const vB = pg8::uni((const char*)vb);
    const int key = c.tid >> 3, cp = c.tid & 7; const unsigned kl = (unsigned)(key * pitch + (cp ^ ((key >> 1) & 7)) * 8) * 2u;
    const int w = c.tid >> 6, ln = c.tid & 63; const unsigned vl = (unsigned)((16 * (w & 3) + (ln >> 2)) * pitch + (w >> 2) * 32 + (ln & 3) * 8) * 2u;
    dma16(kB, kl, c, kslot_off(0)); dma16(vB, vl, c, vslot_off(0));
    if (nt > 1) dma16(kB, tsb + kl, c, kslot_off(1));
}
template <bool PRE = false, class FM>
__device__ __forceinline__ void tile_loop4(int nt, const bf16_t* kb, const bf16_t* vb, const Ctx& c, const bf16x8 (&qr)[4], float& mref, float& l, f32x16 (&o)[2], FM maskf) {
    constexpr int pitch = 64; const unsigned tsb = 64u * pitch * 2u;
    const LAS unsigned char* kq = c.lds + c.r32 * 128;
    const int vq = ((c.lane >> 4) & 1) * 32 + (c.lane & 3) * 8 + (4 * c.hi + ((c.lane & 15) >> 2)) * 64;
    const char* const kB = pg8::uni((const char*)kb); const char* const vB = pg8::uni((const char*)vb);
    unsigned kl, vl;
    { const int key = c.tid >> 3, cp = c.tid & 7; kl = (unsigned)(key * pitch + (cp ^ ((key >> 1) & 7)) * 8) * 2u;
      const int w = c.tid >> 6, ln = c.tid & 63; vl = (unsigned)((16 * (w & 3) + (ln >> 2)) * pitch + (w >> 2) * 32 + (ln & 3) * 8) * 2u; }
    if (!PRE) { dma16(kB, kl, c, kslot_off(0)); dma16(vB, vl, c, vslot_off(0));
        if (nt > 1) dma16(kB, tsb + kl, c, kslot_off(1)); }
    asm volatile("s_waitcnt vmcnt(0)" ::: "memory"); __builtin_amdgcn_s_barrier(); asm volatile("" ::: "memory");
    if (nt > 2) dma16(kB, 2u * tsb + kl, c, kslot_off(2));
    if (nt > 1) dma16(vB, tsb + vl, c, vslot_off(1));
    f32x16 pa0, pa1, pb0, pb1;
    qkt(pa0, pa1, kq + kslot_off(0), qr, c.ksw);
    asm volatile("s_waitcnt lgkmcnt(0)" ::: "memory"); __builtin_amdgcn_s_barrier(); asm volatile("" ::: "memory");
#define SB() __builtin_amdgcn_sched_barrier(0)
#define NSA_STEP4(t, C0, C1, N0, N1, NEXT) do { \
        const bool ik = (t) + 3 < nt, iv = (t) + 2 < nt; \
        if (ik) dma16(kB, (unsigned)((t) + 3) * tsb + kl, c, kslot_off(((t) + 3) & 3)); \
        if (iv) dma16(vB, (unsigned)((t) + 2) * tsb + vl, c, vslot_off(((t) + 2) & 3)); \
        bf16x8 kf[4]; s16x4 vlo[4], vhi[4], wlo[4], whi[4]; \
        const LAS unsigned char* kp_ = kq + kslot_off(((t) + 1) & 3); \
        if (NEXT) { _Pragma("unroll") for (int d0 = 0; d0 < 2; ++d0) { const int co = ((2 * d0) ^ c.ksw) * 16; kf[2 * d0] = *(const LAS bf16x8*)(kp_ + co); kf[2 * d0 + 1] = *(const LAS bf16x8*)(kp_ + 4096 + co); } } \
        const LAS unsigned char* vp_ = c.lds + vslot_off((t) & 3) + vq; \
        vlo[0] = vtra<0>(vp_); vhi[0] = vtra<512>(vp_); vlo[1] = vtra<1024>(vp_); vhi[1] = vtra<1536>(vp_); vlo[2] = vtra<2048>(vp_); vhi[2] = vtra<2560>(vp_); vlo[3] = vtra<3072>(vp_); vhi[3] = vtra<3584>(vp_); \
        SB(); \
        const bool alive = maskf((t), C0, C1); \
        float rm = fmaxf(C0[0], C1[0]); \
        _Pragma("unroll") for (int r = 1; r < 16; ++r) rm = __builtin_fmaxf(__builtin_fmaxf(rm, C0[r]), C1[r]); \
        rm = alive ? swap_max(rm) * C2 : -INFINITY; \
        const bool need = rm > mref + THR; \
        if (__any(need)) { const float mnew = need ? rm : mref, f = __builtin_amdgcn_exp2f(mref - mnew); l *= f; mref = mnew; scale_o(o, c, f); } \
        const float nm = alive ? -mref : -INFINITY; \
        asm volatile("s_waitcnt lgkmcnt(0)" ::: "memory"); SB(); \
        if (NEXT) { N0 = __builtin_amdgcn_mfma_f32_32x32x16_bf16(kf[0], qr[0], (f32x16){0.f,0.f,0.f,0.f,0.f,0.f,0.f,0.f,0.f,0.f,0.f,0.f,0.f,0.f,0.f,0.f}, 0, 0, 0); } \
        _Pragma("unroll") for (int r = 0; r < 4; ++r) C0[r] = __builtin_amdgcn_exp2f(__builtin_fmaf(C0[r], C2, nm)); SB(); \
        if (NEXT) { N1 = __builtin_amdgcn_mfma_f32_32x32x16_bf16(kf[1], qr[0], (f32x16){0.f,0.f,0.f,0.f,0.f,0.f,0.f,0.f,0.f,0.f,0.f,0.f,0.f,0.f,0.f,0.f}, 0, 0, 0); } \
        _Pragma("unroll") for (int r = 4; r < 8; ++r) C0[r] = __builtin_amdgcn_exp2f(__builtin_fmaf(C0[r], C2, nm)); SB(); \
        if (NEXT) { N0 = __builtin_amdgcn_mfma_f32_32x32x16_bf16(kf[2], qr[1], N0, 0, 0, 0); } \
        _Pragma("unroll") for (int r = 8; r < 12; ++r) C0[r] = __builtin_amdgcn_exp2f(__builtin_fmaf(C0[r], C2, nm)); SB(); \
        if (NEXT) { N1 = __builtin_amdgcn_mfma_f32_32x32x16_bf16(kf[3], qr[1], N1, 0, 0, 0); } \
        SB(); \
        if (NEXT) { _Pragma("unroll") for (int d0 = 2; d0 < 4; ++d0) { const int co = ((2 * d0) ^ c.ksw) * 16; kf[2 * d0 - 4] = *(const LAS bf16x8*)(kp_ + co); kf[2 * d0 - 3] = *(const LAS bf16x8*)(kp_ + 4096 + co); } }        \
        SB(); \
        _Pragma("unroll") for (int r = 12; r < 16; ++r) C0[r] = __builtin_amdgcn_exp2f(__builtin_fmaf(C0[r], C2, nm)); SB(); \
        if (NEXT) { N0 = __builtin_amdgcn_mfma_f32_32x32x16_bf16(kf[0], qr[2], N0, 0, 0, 0); } \
        _Pragma("unroll") for (int r = 0; r < 4; ++r) C1[r] = __builtin_amdgcn_exp2f(__builtin_fmaf(C1[r], C2, nm)); SB(); \
        if (NEXT) { N1 = __builtin_amdgcn_mfma_f32_32x32x16_bf16(kf[1], qr[2], N1, 0, 0, 0); } \
        _Pragma("unroll") for (int r = 4; r < 8; ++r) C1[r] = __builtin_amdgcn_exp2f(__builtin_fmaf(C1[r], C2, nm)); SB(); \
        if (NEXT) { N0 = __builtin_amdgcn_mfma_f32_32x32x16_bf16(kf[2], qr[3], N0, 0, 0, 0); } \
        _Pragma("unroll") for (int r = 8; r < 12; ++r) C1[r] = __builtin_amdgcn_exp2f(__builtin_fmaf(C1[r], C2, nm)); SB(); \
        if (NEXT) { N1 = __builtin_amdgcn_mfma_f32_32x32x16_bf16(kf[3], qr[3], N1, 0, 0, 0); } \
        _Pragma("unroll") for (int r = 12; r < 16; ++r) C1[r] = __builtin_amdgcn_exp2f(__builtin_fmaf(C1[r], C2, nm)); SB(); \
        wlo[0] = vtra<4096>(vp_); whi[0] = vtra<4608>(vp_); wlo[1] = vtra<5120>(vp_); whi[1] = vtra<5632>(vp_); wlo[2] = vtra<6144>(vp_); whi[2] = vtra<6656>(vp_); wlo[3] = vtra<7168>(vp_); whi[3] = vtra<7680>(vp_);        \
        SB(); \
        { const f32x16 ps = C0 + C1; \
          l += ((ps[0] + ps[1]) + (ps[2] + ps[3])) + ((ps[4] + ps[5]) + (ps[6] + ps[7])) + (((ps[8] + ps[9]) + (ps[10] + ps[11])) + ((ps[12] + ps[13]) + (ps[14] + ps[15]))); } \
        { u32x4 pw[4]; \
          pw[0] = (u32x4){pk(C0[0], C0[1]), pk(C0[2], C0[3]), pk(C0[4], C0[5]), pk(C0[6], C0[7])}; pw[1] = (u32x4){pk(C0[8], C0[9]), pk(C0[10], C0[11]), pk(C0[12], C0[13]), pk(C0[14], C0[15])}; \
          pw[2] = (u32x4){pk(C1[0], C1[1]), pk(C1[2], C1[3]), pk(C1[4], C1[5]), pk(C1[6], C1[7])}; pw[3] = (u32x4){pk(C1[8], C1[9]), pk(C1[10], C1[11]), pk(C1[12], C1[13]), pk(C1[14], C1[15])}; \
          SB(); asm volatile("s_waitcnt lgkmcnt(0)" ::: "memory"); SB(); \
          _Pragma("unroll") for (int ks = 0; ks < 4; ++ks) { const s16x4 lo_ = vlo[ks], hh_ = vhi[ks]; \
              o[0] = __builtin_amdgcn_mfma_f32_32x32x16_bf16(__builtin_bit_cast(bf16x8, pw[ks]), (bf16x8){lo_[0], lo_[1], lo_[2], lo_[3], hh_[0], hh_[1], hh_[2], hh_[3]}, o[0], 0, 0, 0); } \
          _Pragma("unroll") for (int ks = 0; ks < 4; ++ks) { const s16x4 lo_ = wlo[ks], hh_ = whi[ks]; \
              o[1] = __builtin_amdgcn_mfma_f32_32x32x16_bf16(__builtin_bit_cast(bf16x8, pw[ks]), (bf16x8){lo_[0], lo_[1], lo_[2], lo_[3], hh_[0], hh_[1], hh_[2], hh_[3]}, o[1], 0, 0, 0); } } \
        if (ik) asm volatile("s_waitcnt vmcnt(2) lgkmcnt(0)" ::: "memory"); \
        else if (iv) asm volatile("s_waitcnt vmcnt(1) lgkmcnt(0)" ::: "memory"); \
        else asm volatile("s_waitcnt vmcnt(0) lgkmcnt(0)" ::: "memory"); \
        __builtin_amdgcn_s_barrier(); asm volatile("" ::: "memory"); } while (0)
    int tt = 0;
    for (; tt + 2 < nt; tt += 2) { NSA_STEP4(tt, pa0, pa1, pb0, pb1, true); NSA_STEP4(tt + 1, pb0, pb1, pa0, pa1, true); }
    if (tt + 2 == nt) { NSA_STEP4(tt, pa0, pa1, pb0, pb1, true); NSA_STEP4(tt + 1, pb0, pb1, pa0, pa1, false); }
    else { NSA_STEP4(tt, pa0, pa1, pb0, pb1, false); }
#undef NSA_STEP4
#undef SB
}
__device__ __forceinline__ void unit(int b, int g, int i, const bf16_t* proj, const bf16_t* kvc, const float* gates, const bf16_t* kc, const bf16_t* vc, bf16_t* ya, LAS unsigned char* lds) {
    Ctx c; { int t_ = threadIdx.x; asm volatile("" : "+v"(t_)); c.tid = t_; }
    c.lane = c.tid & 63; c.wid = __builtin_amdgcn_readfirstlane(c.tid >> 6); c.r32 = c.lane & 31; c.hi = c.lane >> 5; c.lds = lds;
    c.wsf = (LAS float*)(lds + L_WSF + c.wid * 256);
    c.ksw = ((c.r32 >> 1) & 7) ^ c.hi;
    const int tokl = 8 * c.wid + (c.r32 >> 2), h = c.r32 & 3, t = 64 * i + tokl;
    const size_t mrow = (size_t)b * T + t;
    LAS float* imp = (LAS float*)(lds + L_IMP);
    for (int k = c.tid; k < 64 * IMP_LD; k += 512) imp[k] = 0.f;
    bf16x8 qr[4];
#pragma unroll
    for (int d0 = 0; d0 < 4; ++d0) qr[d0] = *(const bf16x8*)(proj + mrow * LDP + C_Q + (g * 4 + h) * 64 + d0 * 16 + c.hi * 8);
    const float* gl = gates + mrow * 32 + (g * 4 + h) * 3;
    const float gt0 = sigmoidf_(gl[0]), gt1 = sigmoidf_(gl[1]), gt2 = sigmoidf_(gl[2]);
    const size_t tsz = (size_t)M * 128, bgo = (size_t)(b * 2 + g) * T * 64;
    const bf16_t* kslc = kvc + 2 * tsz + bgo; const bf16_t* vslc = kvc + 3 * tsz + bgo; const bf16_t* kwin = kvc + 4 * tsz + bgo; const bf16_t* vwin = kvc + 5 * tsz + bgo;
    const bf16_t* kcb = kc + (size_t)(b * 2 + g) * 512 * 64; const bf16_t* vcb = vc + (size_t)(b * 2 + g) * 512 * 64;
    f32x16 o[2];
    __syncthreads();
    const int ncv = (t >= 31) ? min((t - 31) / 16 + 1, 511) : 0;
    const int ntc = (4 * i + 3 + 63) / 64;
    float mref = -1e30f, l = 0.f;
    tile_loop<2>(ntc, kcb, vcb, 64, c, qr, [&](int tt, const LAS unsigned char* vp, f32x16& p0, f32x16& p1) {
        const int kb = 64 * tt + 4 * c.hi;
        if (!__all(64 * tt + 64 <= ncv)) {
#pragma unroll
            for (int r = 0; r < 16; ++r) { const int key = kb + (r & 3) + 8 * (r >> 2); if (key >= ncv) p0[r] = -INFINITY; if (key + 32 >= ncv) p1[r] = -INFINITY; }
        }
        softmax_tile<false>(p0, p1, mref, l, o, c);
    });
    {
        const float lt = swap_sum(l), invl = lt > 0.f ? 1.f / lt : 0.f;
#pragma unroll
        for (int r = 0; r < 16; ++r) { o[0][r] = 0.f; o[1][r] = 0.f; }
        tile_loop<2>(ntc, kcb, vcb, 64, c, qr, [&](int tt, const LAS unsigned char* vp, f32x16& p0, f32x16& p1) {
            const int kb = 64 * tt + 4 * c.hi;
#pragma unroll
            for (int r = 0; r < 16; ++r) { const int key = kb + (r & 3) + 8 * (r >> 2);
                p0[r] = (key >= ncv) ? 0.f : __builtin_amdgcn_exp2f(__builtin_fmaf(p0[r], C2, -mref)) * invl;
                p1[r] = (key + 32 >= ncv) ? 0.f : __builtin_amdgcn_exp2f(__builtin_fmaf(p1[r], C2, -mref)) * invl; }
#pragma unroll
            for (int sub = 0; sub < 2; ++sub)
#pragma unroll
                for (int g4 = 0; g4 < 4; ++g4) {
                    const f32x16& pp = sub ? p1 : p0;
                    float av = 2.f * (pp[4 * g4] + pp[4 * g4 + 1] + pp[4 * g4 + 2]) + pp[4 * g4 + 3], bv = pp[4 * g4 + 3];
                    av += __shfl_xor(av, 1); av += __shfl_xor(av, 2); bv += __shfl_xor(bv, 1); bv += __shfl_xor(bv, 2);
                    if (h == 0) { const int bk = 16 * tt + 8 * sub + 2 * g4 + c.hi; LAS float* ip = imp + tokl * IMP_LD + bk;
                        __hip_atomic_fetch_add(ip, av, __ATOMIC_RELAXED, __HIP_MEMORY_SCOPE_WORKGROUP); __hip_atomic_fetch_add(ip + 1, bv, __ATOMIC_RELAXED, __HIP_MEMORY_SCOPE_WORKGROUP); }
                }
            pv(o, vp, p0, p1);
        });
        acc_y<true>(o, c, gt0);
    }
    tile_loop4_prefetch(i + 1, kslc, vslc, c);
    unsigned mw0, mw1, mw2, mw3;
    if (i < 16) { mw0 = (1u << (i + 1)) - 1u; mw1 = 0u; mw2 = 0u; mw3 = 0u; }
    else {
        LAS unsigned* selm = (LAS unsigned*)(lds + L_SEL);
        for (int tl = 0; tl < 8; tl += 2) {
            const int tkA = 8 * c.wid + tl, tkB = tkA + 1;
            float v0A = imp[tkA * IMP_LD + c.lane], v1A = imp[tkA * IMP_LD + 64 + c.lane], v0B = imp[tkB * IMP_LD + c.lane], v1B = imp[tkB * IMP_LD + 64 + c.lane];
            const bool ok0 = (c.lane >= 1 && c.lane <= i - 2), ok1 = (c.lane + 64 <= i - 2);
            v0A = ok0 ? v0A : -1.f; v1A = ok1 ? v1A : -1.f; v0B = ok0 ? v0B : -1.f; v1B = ok1 ? v1B : -1.f;
            unsigned long long f0 = 1ull, f1 = 0ull;
            if (i - 1 < 64) f0 |= 1ull << (i - 1); else f1 |= 1ull << (i - 1 - 64);
            if (i < 64) f0 |= 1ull << i; else f1 |= 1ull << (i - 64);
            const int k0A = __float_as_int(v0A), k1A = __float_as_int(v1A), k0B = __float_as_int(v0B), k1B = __float_as_int(v1B);
            int KA = 0, KB = 0;
#pragma unroll
            for (int bit = 30; bit >= 0; --bit) { const int trA = KA | (1 << bit), trB = KB | (1 << bit);
                const int cA = __popcll(__ballot(k0A >= trA)) + __popcll(__ballot(k1A >= trA)), cB = __popcll(__ballot(k0B >= trB)) + __popcll(__ballot(k1B >= trB));
                if (cA >= 13) KA = trA; if (cB >= 13) KB = trB; }
#pragma unroll
            for (int q = 0; q < 2; ++q) { const int K = q ? KB : KA, k0 = q ? k0B : k0A, k1 = q ? k1B : k1A, tk = q ? tkB : tkA;
                unsigned long long s0 = f0, s1 = f1;
                const unsigned long long g0 = __ballot(k0 > K), g1 = __ballot(k1 > K);
                unsigned long long e0 = __ballot(k0 == K), e1 = __ballot(k1 == K);
                s0 |= g0; s1 |= g1;
                int needn = 13 - (__popcll(g0) + __popcll(g1));
                while (needn > 0 && (e0 | e1)) { if (e0) { s0 |= e0 & (~e0 + 1ull); e0 &= e0 - 1ull; } else { s1 |= e1 & (~e1 + 1ull); e1 &= e1 - 1ull; } --needn; }
                if (c.lane == 0) { selm[tk * 4 + 0] = (unsigned)s0; selm[tk * 4 + 1] = (unsigned)(s0 >> 32); selm[tk * 4 + 2] = (unsigned)s1; selm[tk * 4 + 3] = (unsigned)(s1 >> 32); } }
        }
        const u32x4 mm = *(const LAS u32x4*)(selm + tokl * 4); mw0 = mm.x; mw1 = mm.y; mw2 = mm.z; mw3 = mm.w;
    }
    {
        mref = -1e30f; l = 0.f;
#pragma unroll
        for (int r = 0; r < 16; ++r) { o[0][r] = 0.f; o[1][r] = 0.f; }
        auto selbit = [&](int tt) { const unsigned wsel = tt < 32 ? mw0 : (tt < 64 ? mw1 : (tt < 96 ? mw2 : mw3)); return (bool)((wsel >> (tt & 31)) & 1u); };
        tile_loop4<true>(i + 1, kslc, vslc, c, qr, mref, l, o, [&](int tt, f32x16& p0, f32x16& p1) {
            if (tt == i) {
                asm volatile("" ::: "memory");
#pragma unroll
                for (int r = 0; r < 16; ++r) { const int kl = 4 * c.hi + (r & 3) + 8 * (r >> 2); p0[r] = kl <= tokl ? p0[r] : -INFINITY; p1[r] = kl + 32 <= tokl ? p1[r] : -INFINITY; }
            }
            return selbit(tt);
        });
        const float lt = swap_sum(l);
        acc_y<false>(o, c, lt > 0.f ? gt1 / lt : 0.f);
    }
    {
        mref = -1e30f; l = 0.f;
#pragma unroll
        for (int r = 0; r < 16; ++r) { o[0][r] = 0.f; o[1][r] = 0.f; }
        const int j0 = i >= 8 ? i - 8 : 0, ntw = i - j0 + 1;
        tile_loop4(ntw, kwin + (size_t)j0 * 64 * 64, vwin + (size_t)j0 * 64 * 64, c, qr, mref, l, o, [&](int tt, f32x16& p0, f32x16& p1) {
            const int jt = j0 + tt;
            if (jt == i) {
#pragma unroll
                for (int r = 0; r < 16; ++r) { const int kl = 4 * c.hi + (r & 3) + 8 * (r >> 2); if (kl > tokl) p0[r] = -INFINITY; if (kl + 32 > tokl) p1[r] = -INFINITY; }
            } else if (jt == i - 8) {
#pragma unroll
                for (int r = 0; r < 16; ++r) { const int kl = 4 * c.hi + (r & 3) + 8 * (r >> 2); if (kl <= tokl) p0[r] = -INFINITY; if (kl + 32 <= tokl) p1[r] = -INFINITY; }
            }
            return true;
        });
        const float lt = swap_sum(l);
        acc_y<false>(o, c, lt > 0.f ? gt2 / lt : 0.f);
    }
    {
        const LAS float* stg = (const LAS float*)(lds + L_OST + c.wid * 8192);
#pragma unroll
        for (int k = 0; k < 4; ++k) { const int ci = c.lane + 64 * k, tl = ci >> 5, wi = ci & 31;
            const f32x4 a0 = *(const LAS f32x4*)(stg + ci * 8), a1 = *(const LAS f32x4*)(stg + ci * 8 + 4);
            *(u32x4*)(ya + ((size_t)b * T + 64 * i + 8 * c.wid + tl) * 512 + g * 256 + wi * 8) = (u32x4){pk(a0[0], a0[1]), pk(a0[2], a0[3]), pk(a1[0], a1[1]), pk(a1[2], a1[3])}; }
    }
}
__device__ __forceinline__ void phase(const bf16_t* proj, const bf16_t* kvc, const float* gates, const bf16_t* kc, const bf16_t* vc, bf16_t* ya, LAS unsigned char* lds, int bid, int nb) {
    const int per = nb == 256 ? 4 : (1024 + nb - 1) / nb;
#pragma unroll 1
    for (int k = 0; k < per; ++k) {
        int bg, i;
        if (nb == 256) { const int v = (bid & 7) * 32 + (bid >> 3), s5 = v & 31; bg = v >> 5; i = k == 0 ? s5 : (k == 1 ? 63 - s5 : (k == 2 ? 64 + s5 : 127 - s5)); }
        else { const int u = bid + k * nb; if (u >= 1024) break; bg = u >> 7; i = 127 - (u & 127); }
        unit(bg >> 1, bg & 1, i, proj, kvc, gates, kc, vc, ya, lds);
    }
}
}

namespace mls {
using nsa::bf16x8; using nsa::s16x4; using nsa::f32x16; using nsa::u32x4; using nsa::vtr; using nsa::pk; using nsa::swap_sum;
constexpr int XLD = 136;
constexpr int L_XC = 0, L_XM = 17408, L_Q = 34816, L_K = 51200, L_KW = 67584, L_V = 83968, L_EA = 100352, L_WC = L_EA + 256  , L1_END = L_WC + 2560 * 4;
__device__ __forceinline__ int vblk(int s, int e) { return ((e >> 5) * 4 + (s >> 4)) * 1024 + (s & 15) * 64 + (e & 31) * 2; }
__device__ __forceinline__ f32x16 zero16() { return (f32x16){0.f,0.f,0.f,0.f,0.f,0.f,0.f,0.f,0.f,0.f,0.f,0.f,0.f,0.f,0.f,0.f}; }

struct P1 { const bf16_t* proj; const float* gates; const float* w_conv; const float* b_conv; const float* b_i; const float* b_f; const bf16_t* wT;
            bf16_t* xc; bf16_t* mq; bf16_t* mk; bf16_t* mv; bf16_t* U; float* un; float* gB; float* gG; float* BL; };
__device__ __forceinline__ void ml1_unit(const P1& p, int b, int h, int c, LAS unsigned char* lds) {
    int t_ = threadIdx.x; asm volatile("" : "+v"(t_)); const int tid = t_, lane = tid & 63, wid = __builtin_amdgcn_readfirstlane(tid >> 6), r32 = lane & 31, hi = lane >> 5;
    const size_t m0 = (size_t)b * T + 64 * c; const int bh = b * 4 + h, unit = bh * 128 + c;
    __syncthreads();
    { const int t = tid >> 3, d0 = (tid & 7) * 16; float acc[16];
#pragma unroll
      for (int j = 0; j < 16; ++j) acc[j] = ((const LAS float*)(lds + L_WC))[2048 + h * 128 + d0 + j];
      u32x4 xm0 = (u32x4){0u, 0u, 0u, 0u}, xm1 = xm0;
#pragma unroll
      for (int r = 0; r < 4; ++r) { const int tt = 64 * c + t - 3 + r; u32x4 a0 = (u32x4){0u, 0u, 0u, 0u}, a1 = a0;
          if (tt >= 0) { const bf16_t* src = p.proj + ((size_t)b * T + tt) * LDP + C_XM + h * 128 + d0; a0 = *(const u32x4*)src; a1 = *(const u32x4*)(src + 8); }
          if (r == 3) { xm0 = a0; xm1 = a1; }
          f32x4 v0, v1, v2, v3; pg8::unpack8(a0, v0, v1); pg8::unpack8(a1, v2, v3);
          const LAS float* wc = (const LAS float*)(lds + L_WC) + r * 512 + h * 128 + d0;
#pragma unroll
          for (int j = 0; j < 4; ++j) { acc[j] += v0[j] * wc[j]; acc[4 + j] += v1[j] * wc[4 + j]; acc[8 + j] += v2[j] * wc[8 + j]; acc[12 + j] += v3[j] * wc[12 + j]; } }
#pragma unroll
      for (int j = 0; j < 16; ++j) acc[j] = acc[j] / (1.f + __expf(-acc[j]));
      const u32x4 c0 = (u32x4){pk(acc[0], acc[1]), pk(acc[2], acc[3]), pk(acc[4], acc[5]), pk(acc[6], acc[7])}, c1 = (u32x4){pk(acc[8], acc[9]), pk(acc[10], acc[11]), pk(acc[12], acc[13]), pk(acc[14], acc[15])};
      *(LAS u32x4*)(lds + L_XC + (t * XLD + d0) * 2) = c0; *(LAS u32x4*)(lds + L_XC + (t * XLD + d0 + 8) * 2) = c1;
      *(LAS u32x4*)(lds + L_XM + (t * XLD + d0) * 2) = xm0; *(LAS u32x4*)(lds + L_XM + (t * XLD + d0 + 8) * 2) = xm1;
      bf16_t* xo = p.xc + (m0 + t) * 512 + h * 128 + d0; *(u32x4*)xo = c0; *(u32x4*)(xo + 8) = c1; }
    if (wid == 0) {
        const float fp = p.gates[(m0 + lane) * 32 + 28 + h] + p.b_f[h], li = p.gates[(m0 + lane) * 32 + 24 + h] + p.b_i[h];
        float bs = fminf(fp, 0.f) - log1pf(__expf(-fabsf(fp)));
#pragma unroll
        for (int o = 1; o < 64; o <<= 1) { const float v = __shfl_up(bs, o); if (lane >= o) bs += v; }
        const float bl = __shfl(bs, 63);
        ((LAS float*)(lds + L_EA))[lane] = __expf(bl - bs + li);
        p.gB[(size_t)bh * T + 64 * c + lane] = bs; p.gG[(size_t)bh * T + 64 * c + lane] = li - bs; if (lane == 0) p.BL[unit] = bl;
    }
    __syncthreads();
    { const int tt = wid & 1, et = wid >> 1;
      f32x16 aq = zero16(), ak = zero16(), av = zero16();
      const LAS unsigned char* xcp = lds + L_XC + ((32 * tt + r32) * XLD + 8 * hi) * 2; const LAS unsigned char* xmp = lds + L_XM + ((32 * tt + r32) * XLD + 8 * hi) * 2;
      const bf16_t* wq = p.wT + (size_t)(0 * 4 + h) * 16384 + (size_t)(et * 512 + lane) * 8; const bf16_t* wk = wq + (size_t)4 * 128 * 128; const bf16_t* wv = wk + (size_t)4 * 128 * 128;
#pragma unroll
      for (int ks = 0; ks < 8; ++ks) {
          const bf16x8 xa = *(const LAS bf16x8*)(xcp + ks * 32), xb = *(const LAS bf16x8*)(xmp + ks * 32);
          aq = __builtin_amdgcn_mfma_f32_32x32x16_bf16(xa, *(const bf16x8*)(wq + ks * 512), aq, 0, 0, 0);
          ak = __builtin_amdgcn_mfma_f32_32x32x16_bf16(xa, *(const bf16x8*)(wk + ks * 512), ak, 0, 0, 0);
          av = __builtin_amdgcn_mfma_f32_32x32x16_bf16(xb, *(const bf16x8*)(wv + ks * 512), av, 0, 0, 0); }
      const LAS float* ea = (const LAS float*)(lds + L_EA);
#pragma unroll
      for (int r = 0; r < 16; ++r) { const int s = 32 * tt + (r & 3) + 8 * (r >> 2) + 4 * hi, o = vblk(s, 32 * et + r32); const float kk = ak[r] * 0.08838834764831845f;
          *(LAS bf16_t*)(lds + L_Q + o) = f2bf(aq[r]); *(LAS bf16_t*)(lds + L_K + o) = f2bf(kk); *(LAS bf16_t*)(lds + L_KW + o) = f2bf(kk * ea[s]); *(LAS bf16_t*)(lds + L_V + o) = f2bf(av[r]); } }
    __syncthreads();
#pragma unroll
    for (int i2 = 0; i2 < 2; ++i2) { const int cid = tid + 512 * i2, s = cid >> 4, e8 = cid & 15, o = vblk(s, e8 * 8); const size_t go = (m0 + s) * 512 + h * 128 + e8 * 8;
        *(u32x4*)(p.mq + go) = *(const LAS u32x4*)(lds + L_Q + o); *(u32x4*)(p.mk + go) = *(const LAS u32x4*)(lds + L_K + o); *(u32x4*)(p.mv + go) = *(const LAS u32x4*)(lds + L_V + o); }
    { const int dvt = wid >> 1; const int lo_ = ((lane >> 4) & 1) * 32 + (lane & 3) * 8 + (4 * hi + ((lane & 15) >> 2)) * 64;
      bf16_t* Uo = p.U + (size_t)unit * 16384;
#pragma unroll
      for (int j = 0; j < 2; ++j) { const int dkt = 2 * (wid & 1) + j; f32x16 u = zero16();
#pragma unroll
          for (int ks = 0; ks < 4; ++ks) {
              const s16x4 al = vtr(lds + L_V + lo_ + dvt * 4096 + ks * 1024), ah = vtr(lds + L_V + lo_ + dvt * 4096 + ks * 1024 + 512);
              const s16x4 bl = vtr(lds + L_KW + lo_ + dkt * 4096 + ks * 1024), bh2 = vtr(lds + L_KW + lo_ + dkt * 4096 + ks * 1024 + 512);
              u = __builtin_amdgcn_mfma_f32_32x32x16_bf16((bf16x8){al[0], al[1], al[2], al[3], ah[0], ah[1], ah[2], ah[3]}, (bf16x8){bl[0], bl[1], bl[2], bl[3], bh2[0], bh2[1], bh2[2], bh2[3]}, u, 0, 0, 0); }
#pragma unroll
          for (int r = 0; r < 16; ++r) *(LAS bf16_t*)(lds + wid * 4096 + ((r & 3) + 8 * (r >> 2) + 4 * hi) * 128 + (32 * j + r32) * 2) = f2bf(u[r]); }
#pragma unroll
      for (int k = 0; k < 4; ++k) { const int idx = lane + 64 * k, row = idx >> 3, c8 = idx & 7;
          *(u32x4*)(Uo + (32 * dvt + row) * 128 + 64 * (wid & 1) + c8 * 8) = *(const LAS u32x4*)(lds + wid * 4096 + row * 128 + c8 * 16); } }
    if (tid < 128) { float su = 0.f; for (int s = 0; s < 64; ++s) su += bf2f(*(const LAS bf16_t*)(lds + L_KW + vblk(s, tid))); p.un[(size_t)unit * 128 + tid] = su; }
}

__device__ __forceinline__ void ml2(const bf16_t* U, const float* un, const float* BL, bf16_t* Cst, float* nst, float* sm, int sb, int nsb) {
    const int tid = threadIdx.x, lane = tid & 63, w = tid >> 6;
    float* segS = sm; float* segF = sm + 8 * 256;
    pg8::u32x2 ur[16], un_[16]; float fb[16], fn_[16];
#define ML2_LOAD(itx, UR, FB) do { const int bh_ = (itx) >> 6, e0_ = ((itx) & 63) * 256 + 4 * lane; const size_t ub_ = (size_t)bh_ * 128 + 16 * w; \
        _Pragma("unroll") for (int j = 0; j < 16; ++j) { UR[j] = *(const pg8::u32x2*)(U + (ub_ + j) * 16384 + e0_); FB[j] = BL[ub_ + j]; } } while (0)
    if (sb < 16 * 64) ML2_LOAD(sb, ur, fb);
    for (int it = sb; it < 16 * 64; it += nsb) {
        const int bh = it >> 6, e0 = (it & 63) * 256 + 4 * lane; const size_t ub = (size_t)bh * 128 + 16 * w;
        const bool more = it + nsb < 16 * 64;
        if (more) ML2_LOAD(it + nsb, un_, fn_);
        f32x4 S = (f32x4){0.f, 0.f, 0.f, 0.f}; float F = 1.f;
        float fr_[16];
#pragma unroll
        for (int j = 0; j < 16; ++j) fr_[j] = __expf(fb[j]);
#pragma unroll
        for (int j = 0; j < 16; ++j) { const f32x4 x = (f32x4){__uint_as_float(ur[j].x << 16), __uint_as_float(ur[j].x & 0xffff0000u), __uint_as_float(ur[j].y << 16), __uint_as_float(ur[j].y & 0xffff0000u)};
            S = S * fr_[j] + x; F *= fr_[j]; }
        __syncthreads();
        *(f32x4*)(segS + w * 256 + 4 * lane) = S; if (lane == 0) segF[w] = F;
        __syncthreads();
        f32x4 C = (f32x4){0.f, 0.f, 0.f, 0.f};
        for (int sgm = 0; sgm < w; ++sgm) C = C * segF[sgm] + *(const f32x4*)(segS + sgm * 256 + 4 * lane);
#pragma unroll
        for (int j = 0; j < 16; ++j) { const f32x4 x = (f32x4){__uint_as_float(ur[j].x << 16), __uint_as_float(ur[j].x & 0xffff0000u), __uint_as_float(ur[j].y << 16), __uint_as_float(ur[j].y & 0xffff0000u)};
            pg8::u32x2 o; o.x = pg8::cvt_pk_bf16(C[0], C[1]); o.y = pg8::cvt_pk_bf16(C[2], C[3]); *(pg8::u32x2*)(Cst + (ub + j) * 16384 + e0) = o;
            C = C * fr_[j] + x; }
        if (more) {
#pragma unroll
            for (int j = 0; j < 16; ++j) { ur[j] = un_[j]; fb[j] = fn_[j]; } }
    }
#undef ML2_LOAD
    const int gt = (nsb - 1 - sb) * 512 + tid, ngt = nsb * 512;
    for (int g = gt; g < 16 * 128; g += ngt) { const int bh = g >> 7, k = g & 127; float C = 0.f;
#pragma unroll 1
        for (int c0 = 0; c0 < 128; c0 += 32) { float uv[32], fv[32];
#pragma unroll
            for (int j = 0; j < 32; ++j) { const size_t u = (size_t)bh * 128 + c0 + j; uv[j] = un[u * 128 + k]; fv[j] = BL[u]; }
#pragma unroll
            for (int j = 0; j < 32; ++j) { const size_t u = (size_t)bh * 128 + c0 + j; nst[u * 128 + k] = C; C = __expf(fv[j]) * C + uv[j]; } } }
}

constexpr int L3_V = 0, L3_G = 16384  , L3_WSF = 16384 + 1024, L3_H = 16384 + 1024 + 2048  , L3_Q = L3_H + 64 * 132 * 4  ,
              L3_K = L3_Q + 64 * XLD * 2, L3_C = L3_K + 64 * XLD * 2  , L3_END = L3_C + 128 * XLD * 2;
struct P3 { const bf16_t* proj; const bf16_t* xc; const bf16_t* mq; const bf16_t* mk; const bf16_t* mv; const bf16_t* Cst; const float* nst; const float* gB; const float* gG;
            const float* mh_gain; const float* skip; bf16_t* yb; };
__device__ __forceinline__ void ml3_unit(const P3& p, int b, int h, int c, LAS unsigned char* lds) {
    int t_ = threadIdx.x; asm volatile("" : "+v"(t_)); const int tid = t_, lane = tid & 63, wid = __builtin_amdgcn_readfirstlane(tid >> 6), r32 = lane & 31, hi = lane >> 5;
    const size_t m0 = (size_t)b * T + 64 * c; const int bh = b * 4 + h, unit = bh * 128 + c;
    LAS float* gl = (LAS float*)(lds + L3_G);
    __syncthreads();
#pragma unroll
    for (int i2 = 0; i2 < 2; ++i2) { const int cid = tid + 512 * i2, s = cid >> 4, e8 = cid & 15; const size_t go = (m0 + s) * 512 + h * 128 + e8 * 8;
        const u32x4 vv = *(const u32x4*)(p.mv + go), qq = *(const u32x4*)(p.mq + go), kk = *(const u32x4*)(p.mk + go);
        const u32x4 c0 = *(const u32x4*)(p.Cst + (size_t)unit * 16384 + (size_t)cid * 8), c1 = *(const u32x4*)(p.Cst + (size_t)unit * 16384 + (size_t)(cid + 1024) * 8);
        *(LAS u32x4*)(lds + L3_V + vblk(s, e8 * 8)) = vv; *(LAS u32x4*)(lds + L3_Q + (s * XLD + e8 * 8) * 2) = qq; *(LAS u32x4*)(lds + L3_K + (s * XLD + e8 * 8) * 2) = kk;
        *(LAS u32x4*)(lds + L3_C + (s * XLD + e8 * 8) * 2) = c0; *(LAS u32x4*)(lds + L3_C + ((s + 64) * XLD + e8 * 8) * 2) = c1; }
    if (tid < 64) { gl[tid] = p.gB[(size_t)bh * T + 64 * c + tid]; gl[64 + tid] = p.gG[(size_t)bh * T + 64 * c + tid]; }
    else if (tid < 192) gl[128 + tid - 64] = p.nst[(size_t)unit * 128 + tid - 64];
    __syncthreads();
    const int tt = wid & 1, d0 = wid >> 1, t = 32 * tt + r32;
    bf16x8 qf[8];
#pragma unroll
    for (int ks = 0; ks < 8; ++ks) qf[ks] = *(const LAS bf16x8*)(lds + L3_Q + (t * XLD + 16 * ks + 8 * hi) * 2);
    const float bt = gl[t], ebt = __expf(bt);
    f32x16 o = zero16(); float den = 0.f;
    const int lo_ = ((lane >> 4) & 1) * 32 + (lane & 3) * 8 + (4 * hi + ((lane & 15) >> 2)) * 64;
    for (int st = 0; st <= tt; ++st) {
        f32x16 ps = zero16();
#pragma unroll
        for (int ks = 0; ks < 8; ++ks) ps = __builtin_amdgcn_mfma_f32_32x32x16_bf16(*(const LAS bf16x8*)(lds + L3_K + ((32 * st + r32) * XLD + 16 * ks + 8 * hi) * 2), qf[ks], ps, 0, 0, 0);
#pragma unroll
        for (int g4 = 0; g4 < 4; ++g4) { const f32x4 gs = *(const LAS f32x4*)(gl + 64 + 32 * st + 8 * g4 + 4 * hi);
#pragma unroll
            for (int j = 0; j < 4; ++j) { const int s = 32 * st + 8 * g4 + 4 * hi + j; const float v = (s <= t) ? ps[4 * g4 + j] * __expf(bt + gs[j]) : 0.f; ps[4 * g4 + j] = v; den += v; } }
        const u32x4 pw0 = (u32x4){pk(ps[0], ps[1]), pk(ps[2], ps[3]), pk(ps[4], ps[5]), pk(ps[6], ps[7])}, pw1 = (u32x4){pk(ps[8], ps[9]), pk(ps[10], ps[11]), pk(ps[12], ps[13]), pk(ps[14], ps[15])};
#pragma unroll
        for (int k2 = 0; k2 < 2; ++k2) { const int kg = 2 * st + k2;
            const s16x4 vl = vtr(lds + L3_V + lo_ + d0 * 4096 + kg * 1024), vh = vtr(lds + L3_V + lo_ + d0 * 4096 + kg * 1024 + 512);
            o = __builtin_amdgcn_mfma_f32_32x32x16_bf16(__builtin_bit_cast(bf16x8, k2 ? pw1 : pw0), (bf16x8){vl[0], vl[1], vl[2], vl[3], vh[0], vh[1], vh[2], vh[3]}, o, 0, 0, 0); }
    }
    { float qn = 0.f; const LAS unsigned char* cp = lds + L3_C + ((32 * d0 + r32) * XLD + 8 * hi) * 2;
#pragma unroll
      for (int ks = 0; ks < 8; ++ks) { f32x4 a0, a1; pg8::unpack8(__builtin_bit_cast(u32x4, qf[ks]), a0, a1);
          const f32x4 n0 = *(const LAS f32x4*)(gl + 128 + 16 * ks + 8 * hi), n1 = *(const LAS f32x4*)(gl + 128 + 16 * ks + 8 * hi + 4);
          qn += (a0[0] * n0[0] + a0[1] * n0[1]) + (a0[2] * n0[2] + a0[3] * n0[3]) + (a1[0] * n1[0] + a1[1] * n1[1]) + (a1[2] * n1[2] + a1[3] * n1[3]);
          const u32x4 qs = pg8::pack8(a0 * ebt, a1 * ebt);
          o = __builtin_amdgcn_mfma_f32_32x32x16_bf16(__builtin_bit_cast(bf16x8, qs), *(const LAS bf16x8*)(cp + 32 * ks), o, 0, 0, 0); }
      den = swap_sum(den + ebt * qn); }
    { LAS float* wsf = (LAS float*)(lds + L3_WSF + wid * 256);
      if (hi == 0) wsf[r32] = 1.f / fmaxf(fabsf(den), 1.f);
      LAS float* H = (LAS float*)(lds + L3_H);
#pragma unroll
      for (int g4 = 0; g4 < 4; ++g4) { const f32x4 w = *(const LAS f32x4*)(wsf + 8 * g4 + 4 * hi);
#pragma unroll
          for (int j = 0; j < 4; ++j) { const int tq = 32 * tt + 8 * g4 + 4 * hi + j; H[tq * 132 + 32 * d0 + r32] = o[4 * g4 + j] * w[j]; } } }
    __syncthreads();
    { const LAS float* H = (const LAS float*)(lds + L3_H);
      const int tq = tid >> 3, cs = (tid & 7) * 16; const size_t m = m0 + tq; const int cb = h * 128 + cs;
      const u32x4 op0 = *(const u32x4*)(p.proj + m * LDP + C_OPRE + cb), op1 = *(const u32x4*)(p.proj + m * LDP + C_OPRE + cb + 8);
      const u32x4 xc0 = *(const u32x4*)(p.xc + m * 512 + cb), xc1 = *(const u32x4*)(p.xc + m * 512 + cb + 8);
      f32x4 og[4], xv[4], hv[4]; pg8::unpack8(op0, og[0], og[1]); pg8::unpack8(op1, og[2], og[3]); pg8::unpack8(xc0, xv[0], xv[1]); pg8::unpack8(xc1, xv[2], xv[3]);
      float s1 = 0.f, s2 = 0.f;
#pragma unroll
      for (int q4 = 0; q4 < 4; ++q4) { hv[q4] = *(const LAS f32x4*)(H + tq * 132 + cs + 4 * q4);
#pragma unroll
          for (int j = 0; j < 4; ++j) { const float v = hv[q4][j] * __builtin_amdgcn_rcpf(1.f + __expf(-og[q4][j])); hv[q4][j] = v; s1 += v; s2 += v * v; } }
      s1 += __shfl_xor(s1, 1); s2 += __shfl_xor(s2, 1); s1 += __shfl_xor(s1, 2); s2 += __shfl_xor(s2, 2); s1 += __shfl_xor(s1, 4); s2 += __shfl_xor(s2, 4);
      const float mu = s1 * (1.f / 128.f), rs = rsqrtf(fmaxf(s2 * (1.f / 128.f) - mu * mu, 0.f) + EPS);
      f32x4 yo[4];
#pragma unroll
      for (int q4 = 0; q4 < 4; ++q4) { const f32x4 gn = *(const f32x4*)(p.mh_gain + cb + 4 * q4), sk = *(const f32x4*)(p.skip + cb + 4 * q4);
#pragma unroll
          for (int j = 0; j < 4; ++j) yo[q4][j] = (hv[q4][j] - mu) * rs * gn[j] + sk[j] * xv[q4][j]; }
      *(u32x4*)(p.yb + m * 512 + cb) = pg8::pack8(yo[0], yo[1]); *(u32x4*)(p.yb + m * 512 + cb + 8) = pg8::pack8(yo[2], yo[3]); }
}
}

namespace xat {
using nsa::bf16x8; using nsa::s16x4; using nsa::f32x16; using nsa::u32x4; using nsa::vtr; using nsa::pk; using nsa::swap_sum; using nsa::swap_max;
constexpr int L_K = 0, L_V = 65536, L_WSF = 98304, L_END = L_WSF + 2048;
constexpr float C2X = 0.0625f * 1.4426950408889634f, THR = 6.f;
__device__ __forceinline__ void unit(int b, int h, int qb, const bf16_t* qx, const bf16_t* kx, const bf16_t* vx, int kvp, bf16_t* ox, LAS unsigned char* lds) {
    int t_ = threadIdx.x; asm volatile("" : "+v"(t_)); const int tid = t_, lane = tid & 63, wid = __builtin_amdgcn_readfirstlane(tid >> 6), r32 = lane & 31, hi = lane >> 5;
    LAS float* wsf = (LAS float*)(lds + L_WSF + wid * 256);
    const size_t mrow = (size_t)b * T + 256 * qb + 32 * wid + r32;
    bf16x8 qr[16];
#pragma unroll
    for (int d0 = 0; d0 < 16; ++d0) qr[d0] = *(const bf16x8*)(qx + mrow * D + h * 256 + d0 * 16 + hi * 8);
    const bf16_t* kb = kx + (size_t)b * NMEM * kvp + h * 256; const bf16_t* vb = vx + (size_t)b * NMEM * kvp + h * 256;
    const LAS unsigned char* kp0 = lds + L_K + hi * 1024 + r32 * 16;
    const LAS unsigned char* vp0 = lds + L_V + ((lane >> 4) & 1) * 32 + (lane & 3) * 8 + (4 * hi + ((lane & 15) >> 2)) * 64;
    for (int dh2 = 0; dh2 < 2; ++dh2) {
        f32x16 o[4];
#pragma unroll
        for (int d0 = 0; d0 < 4; ++d0) o[d0] = mls::zero16();
        float mref = -1e30f, l = 0.f;
#define XA_LOAD(jt, slot) do { _Pragma("unroll") for (int i2 = 0; i2 < 4; ++i2) { const int pid = tid + 512 * i2; \
                __builtin_amdgcn_global_load_lds((const unsigned*)(kb + (size_t)(64 * (jt) + (pid & 63)) * kvp + (pid >> 6) * 8), (LAS unsigned*)(lds + L_K + (slot) * 32768 + (wid * 64 + 512 * i2) * 16), 16, 0, 0); } \
            _Pragma("unroll") for (int i2 = 0; i2 < 2; ++i2) { const int pid = tid + 512 * i2, blk = pid >> 6, ln = pid & 63; \
                __builtin_amdgcn_global_load_lds((const unsigned*)(vb + (size_t)(64 * (jt) + 16 * (blk & 3) + (ln >> 2)) * kvp + 128 * dh2 + (blk >> 2) * 32 + (ln & 3) * 8), (LAS unsigned*)(lds + L_V + (slot) * 16384 + (wid * 64 + 512 * i2) * 16), 16, 0, 0); } } while (0)
        __syncthreads();
        XA_LOAD(0, 0); asm volatile("s_waitcnt vmcnt(0)" ::: "memory"); __syncthreads();
        for (int jt = 0; jt < 4; ++jt) { const int slot = jt & 1;
            if (jt + 1 < 4) XA_LOAD(jt + 1, slot ^ 1);
            f32x16 p0 = mls::zero16(), p1 = p0;
            { const LAS unsigned char* kp = kp0 + slot * 32768;
              bf16x8 ka0 = *(const LAS bf16x8*)(kp), ka1 = *(const LAS bf16x8*)(kp + 512), kb0, kb1;
#pragma unroll
              for (int d0 = 0; d0 < 16; d0 += 2) {
                  kb0 = *(const LAS bf16x8*)(kp + (d0 + 1) * 2048); kb1 = *(const LAS bf16x8*)(kp + (d0 + 1) * 2048 + 512);
                  __builtin_amdgcn_sched_barrier(0);
                  p0 = __builtin_amdgcn_mfma_f32_32x32x16_bf16(ka0, qr[d0], p0, 0, 0, 0); p1 = __builtin_amdgcn_mfma_f32_32x32x16_bf16(ka1, qr[d0], p1, 0, 0, 0);
                  __builtin_amdgcn_sched_barrier(0);
                  if (d0 + 2 < 16) { ka0 = *(const LAS bf16x8*)(kp + (d0 + 2) * 2048); ka1 = *(const LAS bf16x8*)(kp + (d0 + 2) * 2048 + 512); }
                  __builtin_amdgcn_sched_barrier(0);
                  p0 = __builtin_amdgcn_mfma_f32_32x32x16_bf16(kb0, qr[d0 + 1], p0, 0, 0, 0); p1 = __builtin_amdgcn_mfma_f32_32x32x16_bf16(kb1, qr[d0 + 1], p1, 0, 0, 0);
                  __builtin_amdgcn_sched_barrier(0); } }
            float rm = fmaxf(p0[0], p1[0]);
#pragma unroll
            for (int r = 1; r < 16; ++r) rm = fmaxf(rm, fmaxf(p0[r], p1[r]));
            rm = swap_max(rm) * C2X;
            const bool need = rm > mref + THR;
            if (__any(need)) {
                const float mnew = need ? rm : mref, f = __builtin_amdgcn_exp2f(mref - mnew);
                l *= f; mref = mnew;
#pragma unroll
                for (int r = 0; r < 16; ++r) { o[0][r] *= f; o[1][r] *= f; o[2][r] *= f; o[3][r] *= f; }
            }
            float sum = 0.f;
#pragma unroll
            for (int r = 0; r < 16; ++r) { p0[r] = __builtin_amdgcn_exp2f(__builtin_fmaf(p0[r], C2X, -mref)); p1[r] = __builtin_amdgcn_exp2f(__builtin_fmaf(p1[r], C2X, -mref)); sum += p0[r] + p1[r]; }
            l += sum;
            u32x4 pw[4];
            pw[0] = (u32x4){pk(p0[0], p0[1]), pk(p0[2], p0[3]), pk(p0[4], p0[5]), pk(p0[6], p0[7])}; pw[1] = (u32x4){pk(p0[8], p0[9]), pk(p0[10], p0[11]), pk(p0[12], p0[13]), pk(p0[14], p0[15])};
            pw[2] = (u32x4){pk(p1[0], p1[1]), pk(p1[2], p1[3]), pk(p1[4], p1[5]), pk(p1[6], p1[7])}; pw[3] = (u32x4){pk(p1[8], p1[9]), pk(p1[10], p1[11]), pk(p1[12], p1[13]), pk(p1[14], p1[15])};
            { const LAS unsigned char* vp = vp0 + slot * 16384;
#define XA_VLD(i, L0, H0, L1, H1) do { L0 = vtr(vp + ((i) >> 1) * 4096 + ((i) & 1) * 2048); H0 = vtr(vp + ((i) >> 1) * 4096 + ((i) & 1) * 2048 + 512); L1 = vtr(vp + ((i) >> 1) * 4096 + ((i) & 1) * 2048 + 1024); H1 = vtr(vp + ((i) >> 1) * 4096 + ((i) & 1) * 2048 + 1536); } while (0)
#define XA_VMM(i, L0, H0, L1, H1) do { o[(i) >> 1] = __builtin_amdgcn_mfma_f32_32x32x16_bf16((bf16x8){L0[0], L0[1], L0[2], L0[3], H0[0], H0[1], H0[2], H0[3]}, __builtin_bit_cast(bf16x8, pw[((i) & 1) * 2]), o[(i) >> 1], 0, 0, 0); \
                  o[(i) >> 1] = __builtin_amdgcn_mfma_f32_32x32x16_bf16((bf16x8){L1[0], L1[1], L1[2], L1[3], H1[0], H1[1], H1[2], H1[3]}, __builtin_bit_cast(bf16x8, pw[((i) & 1) * 2 + 1]), o[(i) >> 1], 0, 0, 0); } while (0)
              s16x4 al0, ah0, al1, ah1, bl0, bh0, bl1, bh1;
              XA_VLD(0, al0, ah0, al1, ah1);
#pragma unroll
              for (int i = 0; i < 8; i += 2) {
                  XA_VLD(i + 1, bl0, bh0, bl1, bh1);
                  __builtin_amdgcn_sched_barrier(0);
                  XA_VMM(i, al0, ah0, al1, ah1);
                  __builtin_amdgcn_sched_barrier(0);
                  if (i + 2 < 8) XA_VLD(i + 2, al0, ah0, al1, ah1);
                  __builtin_amdgcn_sched_barrier(0);
                  XA_VMM(i + 1, bl0, bh0, bl1, bh1);
                  __builtin_amdgcn_sched_barrier(0); }
#undef XA_VLD
#undef XA_VMM
            }
            asm volatile("s_waitcnt vmcnt(0)" ::: "memory"); __syncthreads();
        }
#undef XA_LOAD
        const float inv = 1.f / swap_sum(l);
        LAS unsigned char* ot = lds + wid * 8704;
#pragma unroll
        for (int d0 = 0; d0 < 4; ++d0)
#pragma unroll
            for (int g4 = 0; g4 < 4; ++g4) { pg8::u32x2 w; w.x = pk(o[d0][4 * g4] * inv, o[d0][4 * g4 + 1] * inv); w.y = pk(o[d0][4 * g4 + 2] * inv, o[d0][4 * g4 + 3] * inv);
                *(LAS pg8::u32x2*)(ot + r32 * 272 + (32 * d0 + 8 * g4 + 4 * hi) * 2) = w; }
#pragma unroll
        for (int i2 = 0; i2 < 8; ++i2) { const int row = 4 * i2 + (lane >> 4), c16 = lane & 15;
            *(u32x4*)(ox + ((size_t)b * T + 256 * qb + 32 * wid + row) * D + h * 256 + 128 * dh2 + c16 * 8) = *(const LAS u32x4*)(ot + row * 272 + c16 * 16); }
    }
}
}

__device__ __forceinline__ int conv_srccol(int kind, int r) {
    if (kind == 1) return r < IN_COLS ? my2orig(r) : -1;
    if (kind == 2) { const int pn = r >> 8, rr = r & 255; return (rr >> 7) * 1024 + pn * 128 + (rr & 127); }
    if (kind == 3) return r < NEXP ? r : -1;
    if (kind == 4) return r < 128 ? r : -1;
    return r;
}
template <bool F8>
__device__ __forceinline__ void conv_item(const float* W, int ldw, const float* gk, int kind, bf16_t* WT, int K, int k0, int r0, LAS float* scr, int lane) {
    const int c4 = (lane & 15) * 4; const int sc = conv_srccol(kind, r0 + c4);
    f32x4 vv[16];
#pragma unroll
    for (int i = 0; i < 16; ++i) { const int kk = 4 * i + (lane >> 4); vv[i] = (f32x4){0.f, 0.f, 0.f, 0.f}; if (sc >= 0) vv[i] = *(const f32x4*)(W + (size_t)(k0 + kk) * ldw + sc); }
    float gv[16];
#pragma unroll
    for (int i = 0; i < 16; ++i) gv[i] = gk ? gk[k0 + 4 * i + (lane >> 4)] : 1.f;
#pragma unroll
    for (int i = 0; i < 16; ++i) { const int kk = 4 * i + (lane >> 4); const f32x4 v = vv[i] * gv[i];
        LAS float* d = scr + kk * 65 + c4; d[0] = v[0]; d[1] = v[1]; d[2] = v[2]; d[3] = v[3]; }
    asm volatile("s_waitcnt lgkmcnt(0)" ::: "memory");
    const int ch = lane & 7;
#pragma unroll 2
    for (int i = 0; i < 8; ++i) { const int n = (lane >> 3) + 8 * i; const LAS float* s = scr + (8 * ch) * 65 + n;
        if constexpr (F8) {
            pg8::u32x2 o; o.x = pg8::pack4_fp8((f32x4){s[0 * 65], s[1 * 65], s[2 * 65], s[3 * 65]} * 32.f); o.y = pg8::pack4_fp8((f32x4){s[4 * 65], s[5 * 65], s[6 * 65], s[7 * 65]} * 32.f);
            *(pg8::u32x2*)((unsigned char*)WT + (size_t)(r0 + n) * K + k0 + 8 * ch) = o;
        } else {
        pg8::u32x4 o; o.x = pg8::cvt_pk_bf16(s[0 * 65], s[1 * 65]); o.y = pg8::cvt_pk_bf16(s[2 * 65], s[3 * 65]); o.z = pg8::cvt_pk_bf16(s[4 * 65], s[5 * 65]); o.w = pg8::cvt_pk_bf16(s[6 * 65], s[7 * 65]);
        bf16_t* dst = WT + (size_t)(r0 + n) * K + k0 + 8 * ch;
        if (kind == 5) dst = WT + (size_t)((((r0 + n) >> 5) * 8 + ((k0 + 8 * ch) >> 4)) * 64 + (((k0 + 8 * ch) >> 3) & 1) * 32 + ((r0 + n) & 31)) * 8;
        *(pg8::u32x4*)dst = o; } }
    asm volatile("s_waitcnt lgkmcnt(0)" ::: "memory");
}
template <bool F8 = false>
__device__ __forceinline__ bool conv_matrix(int& it, const float* W, int ldw, const float* gk, int kind, bf16_t* WT, int K, int rows, LAS float* scr, int lane) {
    const int nkb = K / 64, nrb = rows / 64, nit = nkb * nrb;
    if (it >= nit) { it -= nit; return false; }
    const int kbp = it / (2 * nrb), r2 = it % (2 * nrb), rb = r2 >> 1, kb = 2 * kbp + (r2 & 1);
    conv_item<F8>(W, ldw, gk, kind, WT, K, kb * 64, rb * 64, scr, lane);
    return true;
}

enum Stage { ST_PREP = 0, ST_PROJ, ST_A, ST_B, ST_C, ST_MRG, ST_OMIX, ST_QX, ST_XATT, ST_OX, ST_ROUTER, ST_RSCAT, ST_MOE1, ST_MOE2, ST_FINAL, ST_COUNT };
constexpr size_t W_1_T = 22 * MiB;

constexpr size_t W_IN_T = 0, W_UA_T = 9 * MiB, W_UB_T = 10 * MiB, W_OM_T = 11 * MiB, W_QX_T = 13 * MiB, W_OX_T = 15 * MiB, W_R_T = 17 * MiB, W_GU_T = 32 * MiB, W_D_T = 160 * MiB;
constexpr size_t SM_SSQ1 = 22 * MiB, SM_SSQ2 = 24 * MiB;
constexpr size_t W_KX_T = 18 * MiB, W_VX_T = 20 * MiB, W_MEMN = 26 * MiB, W_KVX = 28 * MiB;
constexpr size_t W_M_T = 24 * MiB;
constexpr size_t SM_ROWRS = 32 * MiB, SM_ROWW = 33 * MiB, SM_RPAIR = 34 * MiB, SM_TEND = 35 * MiB;
constexpr size_t SM_UN = 26 * MiB, SM_NST = 27 * MiB, SM_GB = 28 * MiB, SM_GG = 28 * MiB + 512 * 1024, SM_BL = 29 * MiB;

template <int stage> __device__ __forceinline__ void run_stage(const Args& a, float* sm) {
    int tid_ = threadIdx.x; asm volatile("" : "+v"(tid_));
    int bid_ = blockIdx.x; asm volatile("" : "+s"(bid_));
    const int bid = bid_, nb = gridDim.x, tid = tid_;
    LAS unsigned char* ldsb = (LAS unsigned char*)sm;
    unsigned long long ws_ = (unsigned long long)a.ws; asm volatile("" : "+s"(ws_)); unsigned char* ws = glb_ptr<unsigned char>(ws_);
    const LAS unsigned long long* ptab = (const LAS unsigned long long*)((LAS unsigned char*)sm + LDS_PTAB);
#define INP(k) glb_ptr<const float>(((unsigned long long)(unsigned)__builtin_amdgcn_readfirstlane((int)(ptab[k] >> 32)) << 32) | (unsigned long long)(unsigned)__builtin_amdgcn_readfirstlane((int)(unsigned)ptab[k]))
    const float* x = INP(0); const float* mem = INP(1); const float* g_mix = INP(2); const float* w_in = INP(3);
    const float* pe_k = INP(4); const float* pe_v = INP(5); const float* w1k = INP(6); const float* w2k = INP(7); const float* w1v = INP(8); const float* w2v = INP(9);
    const float* w_conv = INP(10); const float* b_conv = INP(11); const float* w_q_m = INP(12); const float* w_k_m = INP(13); const float* w_v_m = INP(14);
    const float* b_i = INP(15); const float* b_f = INP(16); const float* mh_gain = INP(17); const float* skip_m = INP(18);
    const float* w_up_a = INP(19); const float* w_up_b = INP(20); const float* w_o_mix = INP(21); const float* g_x = INP(22); const float* g_mem = INP(23);
    const float* w_q_x = INP(24); const float* w_k_x = INP(25); const float* w_v_x = INP(26); const float* w_o_x = INP(27);
    const float* g_ffn = INP(28); const float* w_router = INP(29); const float* b_router = INP(30); const float* w_gu = INP(31); const float* b_gu = INP(32);
    const float* w_down = INP(33); const float* b_down = INP(34); const float* g_final = INP(35);
    unsigned char* sml = ws + WS_SMALL;
    float* rstdm = (float*)(sml + SM_RSTDM);
    float* bias1 = (float*)(sml + SM_BIAS1); int* cnt = (int*)(sml + 30 * MiB);     int* ntl = (int*)(sml + SM_NT); int* texp = (int*)(sml + SM_TEXP);
    bf16_t* kc = (bf16_t*)(sml + SM_KC); bf16_t* vc = (bf16_t*)(sml + SM_VC); float* h1 = (float*)(sml + SM_H1);
    float* kx = (float*)(sml + SM_KX); float* vx = (float*)(sml + SM_VX); float* logit = (float*)(sml + SM_LOGIT);
    int* te = (int*)(sml + SM_TE); float* tw = (float*)(sml + SM_TW); int* tp = (int*)(sml + SM_TP); int* rslot = (int*)(sml + SM_RSLOT);
    float* ssq1 = (float*)(sml + SM_SSQ1); float* ssq2 = (float*)(sml + SM_SSQ2);
    float* gates = (float*)(ws + WS_GATES); bf16_t* proj = (bf16_t*)(ws + WS_PROJ); float* x1 = (float*)(ws + WS_X1);
    bf16_t* ya = (bf16_t*)(ws + WS_YA); bf16_t* yb = (bf16_t*)(ws + WS_YB);
    bf16_t* xb0 = (bf16_t*)(ws + WS_T1);
    bf16_t* xc = (bf16_t*)(ws + WS_T1); bf16_t* mq = (bf16_t*)(ws + WS_T1 + 32 * MiB); bf16_t* mk = (bf16_t*)(ws + WS_T1 + 64 * MiB); bf16_t* mv = (bf16_t*)(ws + WS_T1 + 96 * MiB);
    float* hbuf = (float*)(ws + WS_T1 + 128 * MiB);
    bf16_t* mg = (bf16_t*)(ws + WS_T1);
    bf16_t* xb1 = (bf16_t*)(ws + WS_T1 + 64 * MiB);
    bf16_t* xb2 = (bf16_t*)(ws + WS_X1);
    bf16_t* qx = (bf16_t*)(ws + WS_PROJ);
    bf16_t* ox = (bf16_t*)(ws + WS_PROJ + 64 * MiB);
    unsigned char* act8 = ws + WS_PROJ;
    unsigned char* xq8 = ws + WS_X1 + 64 * MiB;
    bf16_t* ys = (bf16_t*)(ws + WS_YA);
    bf16_t* wt = (bf16_t*)(ws + WS_W);
    bf16_t* memn = wt + W_MEMN / 2; bf16_t* kvx = wt + W_KVX / 2;
    bf16_t* kvc6 = (bf16_t*)(ws + 964 * MiB);
    const int G = nb;

    switch (stage) {
    case ST_PREP: {
        const int lane = tid & 63, wv = tid >> 6;
        LAS float* scr = (LAS float*)(ldsb + wv * 16640);
        const int gw = bid * 8 + wv, NGW = nb * 8;
        constexpr int I_IN = 16 * 72, I_U = 8 * 16, I_SQ = 16 * 16, I_R = 16 * 4, I_GU = 16 * 32, I_D = 16 * 16;
        constexpr int NITEMS = I_IN + 2 * I_U + 5 * I_SQ + I_R + 48 + 256;
        for (int item = gw; item < NITEMS; item += NGW) {
            int it = item;
            if (conv_matrix(it, w_in, IN_COLS, g_mix, 1, wt + W_IN_T / 2, D, LDP, scr, lane)) continue;
            if (conv_matrix(it, w_up_a, D, nullptr, 0, wt + W_UA_T / 2, 512, D, scr, lane)) continue;
            if (conv_matrix(it, w_up_b, D, nullptr, 0, wt + W_UB_T / 2, 512, D, scr, lane)) continue;
            if (conv_matrix(it, w_o_mix, D, nullptr, 0, wt + W_OM_T / 2, D, D, scr, lane)) continue;
            if (conv_matrix(it, w_q_x, D, g_x, 0, wt + W_QX_T / 2, D, D, scr, lane)) continue;
            if (conv_matrix(it, w_o_x, D, nullptr, 0, wt + W_OX_T / 2, D, D, scr, lane)) continue;
            if (conv_matrix(it, w_k_x, D, g_mem, 0, wt + W_KX_T / 2, D, D, scr, lane)) continue;
            if (conv_matrix(it, w_v_x, D, g_mem, 0, wt + W_VX_T / 2, D, D, scr, lane)) continue;
            if (conv_matrix(it, w_router, NEXP, g_ffn, 3, wt + W_R_T / 2, D, 256, scr, lane)) continue;
            if (it < 48) { const int mi = it >> 2; it &= 3; const float* wsrc = (mi < 4 ? w_q_m : mi < 8 ? w_k_m : w_v_m) + (size_t)(mi & 3) * 16384;
                conv_matrix(it, wsrc, 128, nullptr, 5, wt + W_M_T / 2 + (size_t)mi * 16384, 128, 128, scr, lane); continue; }
            it -= 48;
            if (conv_matrix(it, w1k, 128, nullptr, 4, wt + W_1_T / 2, 2048, 256, scr, lane)) continue;
            if (conv_matrix(it, w1v, 128, nullptr, 4, wt + W_1_T / 2 + 256 * 2048, 2048, 256, scr, lane)) continue;
        }
        for (int m = gw; m < M; m += NGW) {
            const f32x4* xr = (const f32x4*)(x + (size_t)m * D) + lane; f32x4 v[4]; float s = 0.f;
#pragma unroll
            for (int j = 0; j < 4; ++j) { v[j] = xr[64 * j]; s += v[j].x * v[j].x + v[j].y * v[j].y + v[j].z * v[j].z + v[j].w * v[j].w; }
            const float rs = rsqrtf(wave_sum(s) * (1.f / D) + EPS);
            pg8::u32x2* o = (pg8::u32x2*)(xb0 + (size_t)m * D) + lane;
#pragma unroll
            for (int j = 0; j < 4; ++j) { pg8::u32x2 w; w.x = pg8::cvt_pk_bf16(v[j].x * rs, v[j].y * rs); w.y = pg8::cvt_pk_bf16(v[j].z * rs, v[j].w * rs); o[64 * j] = w; }
        }
        for (int m = gw; m < NB * NMEM; m += NGW) {
            const f32x4* xr = (const f32x4*)(mem + (size_t)m * D) + lane; f32x4 v[4]; float s = 0.f;
#pragma unroll
            for (int j = 0; j < 4; ++j) { v[j] = xr[64 * j]; s += v[j].x * v[j].x + v[j].y * v[j].y + v[j].z * v[j].z + v[j].w * v[j].w; }
            const float rs = rsqrtf(wave_sum(s) * (1.f / D) + EPS);
            pg8::u32x2* o = (pg8::u32x2*)(memn + (size_t)m * D) + lane;
#pragma unroll
            for (int j = 0; j < 4; ++j) { pg8::u32x2 w; w.x = pg8::cvt_pk_bf16(v[j].x * rs, v[j].y * rs); w.y = pg8::cvt_pk_bf16(v[j].z * rs, v[j].w * rs); o[64 * j] = w; }
        }
        for (int i = bid; i < 256; i += nb) {
            const float* pe = i < 128 ? pe_k : pe_v; const float* w1 = i < 128 ? w1k : w1v; const int j = i & 127; float sacc = 0.f;
#pragma unroll
            for (int q4 = 0; q4 < 4; ++q4) { const int kk = tid + 512 * q4; sacc += pe[kk] * w1[(size_t)kk * 128 + j]; }
            sacc = wave_sum(sacc);
            __syncthreads();
            if (lane == 0) sm[wv] = sacc;
            __syncthreads();
            if (tid == 0) bias1[i] = ((sm[0] + sm[1]) + (sm[2] + sm[3])) + ((sm[4] + sm[5]) + (sm[6] + sm[7]));
        }
        if (bid == 0 && tid < 32) cnt[tid * 64] = 0;
    } break;
    case ST_PROJ: {
        pg8::DenseSched S{(const char*)xb0, (const char*)(wt + W_IN_T / 2), nullptr, nullptr, 2048u, 2048u, 128, 16, M / 256, LDP / 256, G, bid, 1};
        pg8::EpiProj E{proj, gates, kvc6};
        pg8::gemm_phase(ldsb, S, E);
    } break;
    case ST_A: {
        { pg8::CmpSched S{kvc6, (const char*)(wt + W_1_T / 2), 2048u, 4096u, (size_t)128, 32, G, bid};
          pg8::EpiCmp E{h1, bias1};
          pg8::gemm_phase(ldsb, S, E); }
        mls::P1 P{proj, gates, w_conv, b_conv, b_i, b_f, wt + W_M_T / 2, xc, mq, mk, mv, (bf16_t*)(ws + WS_X1), (float*)(sml + SM_UN), (float*)(sml + SM_GB), (float*)(sml + SM_GG), (float*)(sml + SM_BL)};
        for (int k = tid; k < 2560; k += 512) ((LAS float*)(ldsb + mls::L_WC))[k] = k < 2048 ? w_conv[k] : b_conv[k - 2048];
        if (nb == 256) {
            const int u0 = bid < 32 ? 2016 + bid : (bid - 32) * 9, nu = bid < 32 ? 1 : 9;
#pragma unroll 1
            for (int k = 0; k < nu; ++k) { const int u = u0 + k; mls::ml1_unit(P, u >> 9, (u >> 7) & 3, u & 127, ldsb); }
        } else {
#pragma unroll 1
            for (int u = bid; u < 2048; u += nb) mls::ml1_unit(P, u >> 9, (u >> 7) & 3, u & 127, ldsb);
        }
    } break;
    case ST_B: {
        { pg8::DenseSched S{(const char*)memn, (const char*)(wt + W_KX_T / 2), nullptr, nullptr, 2048u, 2048u, 128, 16, NB * NMEM / 256, 2 * D / 256, G, bid, 1};
          pg8::EpiScaleBf16 E{kvx, 2 * D, nullptr};
          pg8::gemm_phase(ldsb, S, E); }
        const int ncg = nb >= 128 ? 64 : 0;
        if (ncg == 0 || bid < ncg) {
            const int cb = ncg ? bid : bid, cn = ncg ? ncg : nb;
            for (int kv = 0; kv < 2; ++kv) {
                const float* w2 = kv ? w2v : w2k; bf16_t* o = kv ? vc : kc;
                nv_gemm(4096, 64, 128,
                    [&](int row, int kk) { return h1[((size_t)kv * 4096 + row) * 128 + kk]; },
                    [&](int kk, int n, int) { return w2[(size_t)kk * 64 + n]; },
                    [&](int row, int n, const float* acc) { const bool pad = (row & 511) == 511;
#pragma unroll
                        for (int j = 0; j < 4; ++j) o[(size_t)row * 64 + n + j] = pad ? (bf16_t)0 : f2bf(acc[j]); },
                    sm, kv ? cb : (cb + cn / 2) % cn, cn);
            }
        }
        if (ncg == 0 || bid >= ncg)
            mls::ml2((const bf16_t*)(ws + WS_X1), (const float*)(sml + SM_UN), (const float*)(sml + SM_BL), (bf16_t*)(ws + WS_T1 + 128 * MiB), (float*)(sml + SM_NST), sm, ncg ? bid - ncg : bid, ncg ? nb - ncg : nb);
    } break;
    case ST_C: {
#define MOE_CONVERT() do { constexpr int I_GU = 16 * 32, I_D = 16 * 16, NMOE = NEXP * (I_GU + I_D); \
            int tid2 = threadIdx.x, bid2 = blockIdx.x; asm volatile("" : "+v"(tid2), "+s"(bid2)); \
            const int lane = tid2 & 63, wv = __builtin_amdgcn_readfirstlane(tid2 >> 6), gw = bid2 * 8 + wv, NGW = gridDim.x * 8; \
            LAS float* scr = (LAS float*)((LAS unsigned char*)sm + wv * 16640); \
            __syncthreads(); \
            _Pragma("unroll 1") for (int it0 = gw; it0 < NMOE; it0 += NGW) { int it = it0; unsigned char* wdst = ws + WS_W; \
                if (it < NEXP * I_GU) { const int e = it / I_GU; it -= e * I_GU; conv_matrix<true>(it, INP(31) + (size_t)e * D * 2048, 2048, INP(28), 2, (bf16_t*)(wdst + W_GU_T + (size_t)e * 2048 * D), D, 2048, scr, lane); } \
                else { it -= NEXP * I_GU; const int e = it / I_D; it -= e * I_D; conv_matrix<true>(it, INP(33) + (size_t)e * D * D, D, nullptr, 0, (bf16_t*)(wdst + W_D_T + (size_t)e * D * D), D, D, scr, lane); } } \
            __syncthreads(); } while (0)
        if (bid & 1) MOE_CONVERT();
        nsa::phase(proj, kvc6, gates, kc, vc, ya, ldsb, bid, nb);
        { mls::P3 P{proj, xc, mq, mk, mv, (const bf16_t*)(ws + WS_T1 + 128 * MiB), (const float*)(sml + SM_NST), (const float*)(sml + SM_GB), (const float*)(sml + SM_GG), mh_gain, skip_m, yb};
#pragma unroll 1
          for (int u = bid; u < 2048; u += nb) mls::ml3_unit(P, u >> 9, (u >> 7) & 3, u & 127, ldsb); }
        if (!(bid & 1)) MOE_CONVERT();
#undef MOE_CONVERT
    } break;
    case ST_MRG: {
        pg8::DenseSched S{(const char*)ya, (const char*)(wt + W_UA_T / 2), (const char*)yb, (const char*)(wt + W_UB_T / 2), 1024u, 1024u, 128, 8, M / 256, D / 256, G, bid, 2};
        pg8::EpiMerged E{proj, mg};
        pg8::gemm_phase(ldsb, S, E);
    } break;
    case ST_OMIX: {
        pg8::DenseSched S{(const char*)mg, (const char*)(wt + W_OM_T / 2), nullptr, nullptr, 2048u, 2048u, 128, 16, M / 256, D / 256, G, bid, 1};
        pg8::EpiResid<false> E{x, xb1, ssq1, nullptr};
        pg8::gemm_phase(ldsb, S, E);
    } break;
    case ST_QX: {
        pg8::DenseSched S{(const char*)xb1, (const char*)(wt + W_QX_T / 2), nullptr, nullptr, 2048u, 2048u, 128, 16, M / 256, D / 256, G, bid, 1};
        pg8::EpiScaleBf16 E{qx, D, ssq1};
        pg8::gemm_phase(ldsb, S, E);
    } break;
    case ST_XATT: {
#pragma unroll 1
        for (int u = bid; u < 512; u += nb) xat::unit(u >> 7, (u >> 5) & 3, u & 31, qx, kvx, kvx + D, 2 * D, ox, ldsb);
    } break;
    case ST_OX: {
        pg8::DenseSched S{(const char*)ox, (const char*)(wt + W_OX_T / 2), nullptr, nullptr, 2048u, 2048u, 128, 16, M / 256, D / 256, G, bid, 1};
        pg8::EpiResid<true> E{xb1, xb2, ssq2, xq8};
        pg8::gemm_phase(ldsb, S, E);
    } break;
    case ST_ROUTER: {
        typedef short bf16x8_t __attribute__((ext_vector_type(8)));
        const int lane = tid & 63, wv = tid >> 6;
        constexpr int WLD = 2064;
        LAS unsigned char* wl = ldsb;
        LAS float* lgs = (LAS float*)(ldsb + 66560) + wv * (16 * 33);
        int* hist = (int*)(sm + (66560 + 8 * 16 * 33 * 4) / 4); int* gbase = hist + 32;
        for (int i = bid * 512 + tid; i < MOE_ROWS_MAX; i += nb * 512) { rslot[i] = -1; ((float*)(sml + SM_ROWRS))[i] = 0.f; ((float*)(sml + SM_ROWW))[i] = 0.f; if (i < MOE_ROWS_MAX / 2) ((unsigned*)(sml + SM_RPAIR))[i] = 0u; }
        for (int i = tid; i < 32 * 128; i += 512) { const int r = i >> 7, c16 = i & 127; *(LAS pg8::u32x4*)(wl + r * WLD + c16 * 16) = *(const pg8::u32x4*)(wt + W_R_T / 2 + (size_t)r * D + c16 * 8); }
        for (int ch = bid; ch < M / 128; ch += nb) {
            __syncthreads();
            if (tid < 32) hist[tid] = 0;
            const size_t row0 = (size_t)ch * 128 + wv * 16;
            f32x4 a0 = (f32x4){0.f, 0.f, 0.f, 0.f}, a1 = a0;
            const bf16_t* ap = xb2 + (row0 + (lane & 15)) * D + (lane >> 4) * 8;
            const LAS unsigned char* bp = wl + (lane & 15) * WLD + (lane >> 4) * 16;
#pragma unroll 8
            for (int ks = 0; ks < 32; ++ks) {
                const bf16x8_t af = *(const bf16x8_t*)(ap + ks * 32);
                const bf16x8_t b0 = *(const LAS bf16x8_t*)(bp + ks * 64), b1 = *(const LAS bf16x8_t*)(bp + 16 * WLD + ks * 64);
                a0 = __builtin_amdgcn_mfma_f32_16x16x32_bf16(af, b0, a0, 0, 0, 0); a1 = __builtin_amdgcn_mfma_f32_16x16x32_bf16(af, b1, a1, 0, 0, 0);
            }
#pragma unroll
            for (int j = 0; j < 4; ++j) { lgs[((lane >> 4) * 4 + j) * 33 + (lane & 15)] = a0[j]; lgs[((lane >> 4) * 4 + j) * 33 + 16 + (lane & 15)] = a1[j]; }
            __syncthreads();
            int ei[4]; float ex[4]; int lp[4]; float ssum = 0.f; const size_t m = row0 + lane;
            if (lane < 16) {
                const float rs = pg8::rstd_from_ssq(ssq2, m);
                float lv[NEXP];
#pragma unroll
                for (int e = 0; e < NEXP; ++e) lv[e] = lgs[lane * 33 + e] * rs + b_router[e];
                float ev[4];
#pragma unroll
                for (int k = 0; k < 4; ++k) { float best = -INFINITY; int bi_ = 0;
#pragma unroll
                    for (int e = 0; e < NEXP; ++e) { if (lv[e] > best) { best = lv[e]; bi_ = e; } }
                    ei[k] = bi_; ev[k] = best;
#pragma unroll
                    for (int e = 0; e < NEXP; ++e) if (e == bi_) lv[e] = -INFINITY; }
#pragma unroll
                for (int k = 0; k < 4; ++k) { ex[k] = __expf(ev[k] - ev[0]); ssum += ex[k]; lp[k] = atomicAdd(&hist[ei[k]], 1); }
            }
            __syncthreads();
            if (tid < 32) gbase[tid] = atomicAdd(&cnt[tid * 64], hist[tid]);
            __syncthreads();
            if (lane < 16) {
#pragma unroll
                for (int k = 0; k < 4; ++k) { te[m * 4 + k] = ei[k]; tw[m * 4 + k] = ex[k] / ssum; tp[m * 4 + k] = gbase[ei[k]] + lp[k]; }
            }
        }
    } break;
    case ST_RSCAT: {
        int* eb = (int*)sm;
        if (tid < 32) { int acc = 0; for (int e = 0; e < tid; ++e) acc += (cnt[e * 64] + MOE_PAD - 1) / MOE_PAD * MOE_PAD; eb[tid] = acc; }
        __syncthreads();
        if (bid == 0 && tid < 32) { const int te_ = (eb[tid] + (cnt[tid * 64] + MOE_PAD - 1) / MOE_PAD * MOE_PAD) / MOE_PAD; ((int*)(sml + SM_TEND))[tid] = te_; if (tid == 31) ntl[0] = te_; }
        for (int i = bid * 512 + tid; i < NASG; i += nb * 512) { const int row = eb[te[i]] + tp[i]; rslot[row] = i;
            ((float*)(sml + SM_ROWRS))[row] = pg8::rstd_from_ssq(ssq2, i >> 2); ((float*)(sml + SM_ROWW))[row] = tw[i];
            ((unsigned short*)(sml + SM_RPAIR))[(((row >> 8) * 2 + ((row >> 7) & 1)) * 64 + (row & 63)) * 2 + ((row >> 6) & 1)] = (unsigned short)(i >> 2); }
    } break;
    case ST_MOE1: {
        pg8::MoeSched1 S; S.A = (const char*)xq8; S.Bt = (const char*)wt + W_GU_T; S.lda2 = 1024u; S.ldb2 = 1024u; S.kstepA = 128; S.ntk = 8; S.nM = ntl[0]; S.nN = 8; S.G = G; S.c = bid;
        S.bexp = (size_t)2048 * D; S.tend = (const LAS int*)(ldsb + 131072); S.rowpair = (const unsigned*)(sml + SM_RPAIR);
        if (tid < 32) ((LAS int*)(ldsb + 131072))[tid] = ((const int*)(sml + SM_TEND))[tid];
        __syncthreads();
        pg8::EpiMoe1 E{act8, (const float*)(sml + SM_ROWRS), b_gu};
        pg8::gemm_phase(ldsb, S, E);
    } break;
    case ST_MOE2: {
        pg8::MoeSched2 S; S.A = (const char*)act8; S.Bt = (const char*)wt + W_D_T; S.lda2 = 1024u; S.ldb2 = 1024u; S.kstepA = 128; S.ntk = 8; S.nM = ntl[0]; S.nN = 4; S.G = G; S.c = bid;
        S.bexp = (size_t)D * D; S.tend = (const LAS int*)(ldsb + 131072); S.rowpair = nullptr;
        if (tid < 32) ((LAS int*)(ldsb + 131072))[tid] = ((const int*)(sml + SM_TEND))[tid];
        __syncthreads();
        pg8::EpiMoe2 E{ys, rslot, (const float*)(sml + SM_ROWW), b_down};
        pg8::gemm_phase(ldsb, S, E);
    } break;
    case ST_FINAL: {
        const int lane = tid & 63, wv = tid >> 6;
        for (int m = bid * 8 + wv; m < M; m += nb * 8) {
            const pg8::u32x2* xr = (const pg8::u32x2*)(xb2 + (size_t)m * D) + lane; f32x4 v[4]; float s = 0.f;
#pragma unroll
            for (int j = 0; j < 4; ++j) { const pg8::u32x2 w = xr[64 * j]; v[j] = (f32x4){__uint_as_float(w.x << 16), __uint_as_float(w.x & 0xffff0000u), __uint_as_float(w.y << 16), __uint_as_float(w.y & 0xffff0000u)}; }
#pragma unroll
            for (int k = 0; k < 4; ++k) { const pg8::u32x2* yr = (const pg8::u32x2*)(ys + ((size_t)m * 4 + k) * D) + lane;
#pragma unroll
                for (int j = 0; j < 4; ++j) { const pg8::u32x2 w = yr[64 * j]; v[j].x += __uint_as_float(w.x << 16); v[j].y += __uint_as_float(w.x & 0xffff0000u); v[j].z += __uint_as_float(w.y << 16); v[j].w += __uint_as_float(w.y & 0xffff0000u); } }
#pragma unroll
            for (int j = 0; j < 4; ++j) s += v[j].x * v[j].x + v[j].y * v[j].y + v[j].z * v[j].z + v[j].w * v[j].w;
            const float rs = rsqrtf(wave_sum(s) * (1.f / D) + EPS);
            f32x4* o = (f32x4*)(as_global(a.out) + (size_t)m * D) + lane; const f32x4* gf = (const f32x4*)g_final + lane;
#pragma unroll
            for (int j = 0; j < 4; ++j) o[64 * j] = v[j] * rs * gf[64 * j];
        }
    } break;
    default: break;
    }
#undef INP
}

#define XB_TMO      128
#define XB_XCNT(j)  (256  + 64 * (j))
#define XB_XSUB(j)  (1280 + 64 * (j))
#define XB_XGEN(j)  (2304 + 64 * (j))
#define XB_TOP      3328
#define XB_TOPGEN   3392
#define XCD_BAR_WORDS 3456
#define XB_SPIN_CAP (1u << 20)
#define LAS __attribute__((address_space(3)))
__device__ __forceinline__ unsigned xb_ld(unsigned* p)              { return __hip_atomic_load(p, __ATOMIC_RELAXED, __HIP_MEMORY_SCOPE_AGENT); }
__device__ __forceinline__ unsigned xb_add(unsigned* p, unsigned v) { return __hip_atomic_fetch_add(p, v, __ATOMIC_RELAXED, __HIP_MEMORY_SCOPE_AGENT); }
__device__ __forceinline__ unsigned xb_xcc_id() { return (unsigned)__builtin_amdgcn_s_getreg((3 << 11) | 20) & 0xFu; }
#define XB_SPIN(cond, bar) do { unsigned _sp = 0; while (cond) { __builtin_amdgcn_s_sleep(1); \
    if ((++_sp & 255u) == 0u) { if (xb_ld(&(bar)[XB_TMO])) break; if (_sp > XB_SPIN_CAP) { atomicAdd(&(bar)[XB_TMO], 1u); break; } } } } while (0)
struct XcdBarrier { unsigned* bar; unsigned x; volatile LAS unsigned* st; };
__device__ __forceinline__ XcdBarrier xcd_barrier_post(unsigned* bar, volatile LAS unsigned* st) {
    XcdBarrier b; b.bar = bar; b.x = xb_xcc_id(); b.st = st;
    if (threadIdx.x == 0) (void)xb_add(&bar[XB_XCNT(b.x)], 1u);
    return b;
}
__device__ __forceinline__ void xcd_barrier_complete(unsigned* bar, unsigned x, unsigned& nloc, unsigned& nx) {
    const unsigned G = gridDim.x * gridDim.y * gridDim.z;
    unsigned sum, cnt, mine, sp = 0u;
    for (;;) {
        sum = 0u; cnt = 0u; mine = 0u;
#pragma unroll
        for (unsigned j = 0; j < 16; ++j) { const unsigned c = xb_ld(&bar[XB_XCNT(j)]); sum += c; cnt += (c > 0u) ? 1u : 0u; mine = (j == x) ? c : mine; }
        if (sum == G) break;
        __builtin_amdgcn_s_sleep(1);
        if ((++sp & 255u) == 0u) { if (xb_ld(&bar[XB_TMO])) break; if (sp > XB_SPIN_CAP) { atomicAdd(&bar[XB_TMO], 1u); break; } }
    }
    nloc = mine > 0u ? mine : 1u; nx = cnt > 0u ? cnt : 1u;
}
__device__ __forceinline__ void xcd_barrier(const XcdBarrier& b) {
    asm volatile("s_waitcnt vmcnt(0)" ::: "memory");
    __syncthreads();
    if (threadIdx.x == 0) {
        unsigned* bar = b.bar;
        __builtin_amdgcn_s_waitcnt(0);
        unsigned nloc = b.st[0], nx = b.st[1];
        if (nloc == 0u) { xcd_barrier_complete(bar, b.x, nloc, nx); b.st[0] = nloc; b.st[1] = nx; }
        const unsigned old = xb_add(&bar[XB_XSUB(b.x)], 1u);
        const unsigned gen = old / nloc;
        if (old + 1u == (gen + 1u) * nloc) {
            __builtin_amdgcn_fence(__ATOMIC_RELEASE, "agent");
            asm volatile("s_waitcnt vmcnt(0)" ::: "memory");
            const unsigned og = xb_add(&bar[XB_TOP], 1u);
            const unsigned tg = og / nx;
            if (og + 1u == (tg + 1u) * nx) xb_add(&bar[XB_TOPGEN], 1u);
            else XB_SPIN(xb_ld(&bar[XB_TOPGEN]) == tg, bar);
            __builtin_amdgcn_fence(__ATOMIC_ACQUIRE, "agent");
            xb_add(&bar[XB_XGEN(b.x)], 1u);
            asm volatile("s_waitcnt vmcnt(0)" ::: "memory");
        } else {
            XB_SPIN(xb_ld(&bar[XB_XGEN(b.x)]) == gen, bar);
            __builtin_amdgcn_fence(__ATOMIC_ACQUIRE, "agent");
            asm volatile("s_waitcnt vmcnt(0)" ::: "memory");
        }
    }
    __syncthreads();
}

constexpr int LDS_BYTES = 147456;
constexpr int CW_BAR = 4096;

template <int S> __device__ __forceinline__ void run_stages(const Args& a, float* sm, const XcdBarrier& bar) {
    if constexpr (S < ST_COUNT) {
        run_stage<S>(a, sm);
#ifdef DUP_MASK
        if constexpr ((DUP_MASK >> S) & 1) { __syncthreads(); run_stage<S>(a, sm); }
#endif
        if (S + 1 < ST_COUNT) xcd_barrier(bar);
        run_stages<S + 1>(a, sm, bar);
    }
}
__global__ void __launch_bounds__(512, 2) mega(Args a) {
    extern __shared__ __attribute__((aligned(16))) unsigned char lds[];
    float* sm = (float*)lds;
    volatile LAS unsigned* misc = (volatile LAS unsigned*)((LAS unsigned char*)lds + LDS_MISC);
    if (threadIdx.x < 32) misc[threadIdx.x] = 0u;
    if (threadIdx.x < 36) ((LAS unsigned long long*)((LAS unsigned char*)lds + LDS_PTAB))[threadIdx.x] = (unsigned long long)a.in[threadIdx.x];
    __syncthreads();
    XcdBarrier bar = xcd_barrier_post((unsigned*)(as_global(a.ws) + WS_CTL) + CW_BAR, misc + 8);
    run_stages<0>(a, sm, bar);
}

extern "C" void kernel_launch(void* const* d_in, const int* in_sizes, int n_in, void* d_out, int out_size, void* d_ws, size_t ws_size, hipStream_t stream) {
    static int grid = 0;
    if (grid == 0) {
        if (n_in != 36 || out_size != M * D || ws_size < WS_END) { fprintf(stderr, "kernel_launch: unexpected n_in %d / out %d / ws %zu\n", n_in, out_size, ws_size); grid = -1; return; }
        int dev = 0, cus = 0;
        if (hipGetDevice(&dev) != hipSuccess || hipDeviceGetAttribute(&cus, hipDeviceAttributeMultiprocessorCount, dev) != hipSuccess) { grid = -1; return; }
        if (hipFuncSetAttribute((const void*)mega, hipFuncAttributeMaxDynamicSharedMemorySize, LDS_BYTES) != hipSuccess) { fprintf(stderr, "kernel_launch: hipFuncSetAttribute failed\n"); grid = -1; return; }
        int per_cu = 0;
        if (hipOccupancyMaxActiveBlocksPerMultiprocessor(&per_cu, (const void*)mega, 512, LDS_BYTES) != hipSuccess || per_cu < 1) { fprintf(stderr, "kernel_launch: occupancy query says %d\n", per_cu); }
        (void)hipGetLastError();
        grid = cus;
    }
    if (grid < 0) return;
    (void)hipMemsetAsync((char*)d_ws + WS_CTL, 0, 1 * MiB, stream);
    Args a{};
    for (int i = 0; i < 36; ++i) a.in[i] = (const float*)d_in[i];
    a.out = (float*)d_out; a.ws = (unsigned char*)d_ws;
    a.stage = 0; a.pad = ST_COUNT;
    hipLaunchKernelGGL(mega, dim3(grid), dim3(512), LDS_BYTES, stream, a);
}
```

```cpp
#include <hip/hip_runtime.h>
#include <cstdio>
#include <cstdint>

typedef unsigned short bf16_t;
typedef float f32x4 __attribute__((ext_vector_type(4)));

constexpr int D = 1024, NB = 4, T = 8192, M = NB * T, NMEM = 256;
constexpr int IN_COLS = 4384, LDP = 4608;
constexpr int C_Q = 0, C_KCMP = 512, C_VCMP = 640, C_KSLC = 768, C_VSLC = 896, C_KWIN = 1024, C_VWIN = 1152, C_XM = 1280, C_OPRE = 1792, C_GA = 2304, C_GB = 3328, C_SMALL = 4352;
constexpr int NEXP = 32, TOPK = 4, NASG = M * TOPK, MOE_PAD = 256, MOE_ROWS_MAX = NASG + NEXP * MOE_PAD;
constexpr float EPS = 1e-5f;
constexpr int LDS_MISC = 131072 + 8192, LDS_PTAB = LDS_MISC + 1024;

__host__ __device__ constexpr int my2orig(int c) { return c < 1280 ? c : (c < 2304 ? c + 24 : (c < 4352 ? c + 32 : (c < 4376 ? 1280 + (c - 4352) : 2328 + (c - 4376)))); }

constexpr size_t MiB = 1u << 20;
constexpr size_t WS_CTL = 0;
constexpr size_t WS_SMALL = 1 * MiB;
constexpr size_t WS_W = 48 * MiB;
constexpr size_t WS_GATES = 288 * MiB;
constexpr size_t WS_PROJ = 292 * MiB;
constexpr size_t WS_X1 = 580 * MiB;
constexpr size_t WS_YA = 708 * MiB;
constexpr size_t WS_YB = 740 * MiB;
constexpr size_t WS_T1 = 772 * MiB;
constexpr size_t WS_END = 1024 * MiB;
constexpr size_t SM_RSTD0 = 0, SM_RSTD1 = 128 * 1024, SM_RSTD2 = 256 * 1024, SM_RSTDM = 384 * 1024, SM_BIAS1 = 392 * 1024  ,
    SM_CNT = 400 * 1024  , SM_NT = 401 * 1024  , SM_TEXP = 402 * 1024  ,
    SM_KC = 1 * MiB  , SM_VC = 1 * MiB + 512 * 1024, SM_H1 = 2 * MiB  ,
    SM_KX = 6 * MiB  , SM_VX = 10 * MiB, SM_LOGIT = 14 * MiB  ,
    SM_TE = 18 * MiB  , SM_TW = 18 * MiB + 512 * 1024  , SM_TP = 19 * MiB  ,
    SM_RSLOT = 20 * MiB  ;

struct Args {
    const float* in[36];
    float* out;
    unsigned char* ws;
    int stage, pad;
};

#define GLB __attribute__((address_space(1)))
template <class T> __device__ __forceinline__ T* glb_ptr(unsigned long long v) { return (T*)((GLB T*)v); }
template <class T> __device__ __forceinline__ T* as_global(T* p) { return glb_ptr<T>((unsigned long long)p); }
__device__ __forceinline__ float bf2f(bf16_t v) { return __uint_as_float(((unsigned)v) << 16); }
__device__ __forceinline__ bf16_t f2bf(float f) { unsigned u = __float_as_uint(f); u += 0x7fffu + ((u >> 16) & 1u); return (bf16_t)(u >> 16); }
__device__ __forceinline__ float sigmoidf_(float x) { return 1.f / (1.f + __expf(-x)); }
__device__ __forceinline__ float wave_sum(float v) {
#pragma unroll
    for (int o = 1; o < 64; o <<= 1) v += __shfl_xor(v, o);
    return v;
}
__device__ __forceinline__ float wave_max(float v) {
#pragma unroll
    for (int o = 1; o < 64; o <<= 1) v = fmaxf(v, __shfl_xor(v, o));
    return v;
}

__device__ void nv_rstd(const float* x, float* rstd, int rows, int bid, int nb) {
    const int lane = threadIdx.x & 63, wv = threadIdx.x >> 6, nwv = blockDim.x >> 6;
    for (int m = bid * nwv + wv; m < rows; m += nb * nwv) {
        const f32x4* xr = (const f32x4*)(x + (size_t)m * D) + lane;
        float s = 0.f;
#pragma unroll
        for (int j = 0; j < 4; ++j) { f32x4 v = xr[64 * j]; s += v.x * v.x + v.y * v.y + v.z * v.z + v.w * v.w; }
        s = wave_sum(s);
        if (lane == 0) rstd[m] = rsqrtf(s * (1.f / D) + EPS);
    }
}

template <class FA, class FB, class FE>
__device__ void nv_gemm(int Mr, int N, int K, FA fa, FB fb, FE fe, float* sm, int bid, int nb) {
    const int tid = threadIdx.x, tx = tid & 15, ty = tid >> 4;
    float* As = sm; float* Bs = sm + 16 * 132;
    const int tm = (Mr + 127) / 128, tn = (N + 63) / 64;
    for (int tile = bid; tile < tm * tn; tile += nb) {
        const int m0 = (tile / tn) * 128, n0 = (tile % tn) * 64;
        float acc[4][4];
#pragma unroll
        for (int i = 0; i < 4; ++i)
#pragma unroll
            for (int j = 0; j < 4; ++j) acc[i][j] = 0.f;
        for (int k0 = 0; k0 < K; k0 += 16) {
#pragma unroll
            for (int i = 0; i < 4; ++i) { const int idx = tid + 512 * i, r = idx >> 4, kk = idx & 15; As[kk * 132 + r] = (m0 + r < Mr && k0 + kk < K) ? fa(m0 + r, k0 + kk) : 0.f; }
#pragma unroll
            for (int i = 0; i < 2; ++i) { const int idx = tid + 512 * i, kk = idx >> 6, c = idx & 63; Bs[kk * 64 + c] = (n0 + c < N && k0 + kk < K) ? fb(k0 + kk, n0 + c, m0) : 0.f; }
            __syncthreads();
#pragma unroll
            for (int kk = 0; kk < 16; ++kk) {
                const f32x4 a = *(const f32x4*)&As[kk * 132 + ty * 4], b = *(const f32x4*)&Bs[kk * 64 + tx * 4];
#pragma unroll
                for (int i = 0; i < 4; ++i)
#pragma unroll
                    for (int j = 0; j < 4; ++j) acc[i][j] += a[i] * b[j];
            }
            __syncthreads();
        }
#pragma unroll
        for (int i = 0; i < 4; ++i) if (m0 + ty * 4 + i < Mr && n0 + tx * 4 < N) fe(m0 + ty * 4 + i, n0 + tx * 4, acc[i]);
    }
}

constexpr int NSA_SM_FLOATS = 256 + 4096 + 16 + 512 + 128 + 128 + 16 + 512;
__device__ __forceinline__ void nsa_head_softmax(float* sch, int n, int h, int lt, float* red) {
    float mx = -INFINITY;
    for (int j = lt; j < n; j += 128) mx = fmaxf(mx, sch[j]);
    mx = wave_max(mx);
    if ((lt & 63) == 0) red[h * 2 + (lt >> 6)] = mx;
    __syncthreads();
    mx = fmaxf(red[h * 2], red[h * 2 + 1]);
    float s = 0.f;
    for (int j = lt; j < n; j += 128) { const float e = (mx == -INFINITY) ? 0.f : __expf(sch[j] - mx); sch[j] = e; s += e; }
    s = wave_sum(s);
    __syncthreads();
    if ((lt & 63) == 0) red[8 + h * 2 + (lt >> 6)] = s;
    __syncthreads();
    s = red[8 + h * 2] + red[8 + h * 2 + 1];
    const float inv = s > 0.f ? 1.f / s : 0.f;
    for (int j = lt; j < n; j += 128) sch[j] *= inv;
    __syncthreads();
}
template <class FV>
__device__ __forceinline__ float nsa_head_pv(const float* sch, int n, int h, int lt, float* opart, FV fv) {
    const int d = lt & 63, half = lt >> 6;
    float o = 0.f;
    for (int j = half; j < n; j += 2) { const float p = sch[j]; if (p != 0.f) o += p * fv(j, d); }
    opart[(h * 2 + half) * 64 + d] = o;
    __syncthreads();
    o = opart[(h * 2) * 64 + d] + opart[(h * 2 + 1) * 64 + d];
    __syncthreads();
    return o;
}
__device__ void nv_nsa(const bf16_t* proj, const float* gates, const bf16_t* kc, const bf16_t* vc, bf16_t* ya, float* sm, int bid, int nb) {
    const int tid = threadIdx.x, h = tid >> 7, lt = tid & 127;
    float* q = sm; float* sc = sm + 256; float* red = sc + 4096; float* pg = red + 16; float* impv = pg + 512; float* scorev = impv + 128; int* sel = (int*)(scorev + 128); float* opart = (float*)(sel + 16);
    float* sch = sc + h * 1024;
    for (int unit = bid; unit < NB * 2 * T; unit += nb) {
        const int t = unit % T, g = (unit / T) & 1, b = unit / (2 * T);
        const size_t m = (size_t)b * T + t;
        if (lt < 64) q[h * 64 + lt] = bf2f(proj[m * LDP + C_Q + (g * 4 + h) * 64 + lt]) * 0.125f;
        __syncthreads();
        float yacc = 0.f;
        const int ncv = (t >= 31) ? min((t - 31) / 16 + 1, 511) : 0;
        const bf16_t* kcb = kc + (size_t)(b * 2 + g) * 512 * 64; const bf16_t* vcb = vc + (size_t)(b * 2 + g) * 512 * 64;
        for (int j = lt; j < 512; j += 128) {
            float s = -INFINITY;
            if (j < ncv) { s = 0.f; for (int d = 0; d < 64; ++d) s += q[h * 64 + d] * bf2f(kcb[j * 64 + d]); }
            sch[j] = s;
        }
        __syncthreads();
        nsa_head_softmax(sch, 512, h, lt, red);
        { const float o = nsa_head_pv(sch, 512, h, lt, opart, [&](int j, int d) { return bf2f(vcb[j * 64 + d]); });
          yacc += sigmoidf_(gates[m * 32 + (g * 4 + h) * 3 + 0]) * o; }
        pg[tid] = sc[tid] + sc[1024 + tid] + sc[2048 + tid] + sc[3072 + tid];
        __syncthreads();
        const int cur = t >> 6;
        if (tid < 128) {
            const int bk = tid; float im = 0.f;
            { const int i0 = 4 * bk - 1; if (i0 >= 0 && i0 < 511) im += pg[i0]; }
#pragma unroll
            for (int e = 0; e < 3; ++e) { const int i1 = 4 * bk + e; if (i1 < 511) im += 2.f * pg[i1]; }
            { const int i4 = 4 * bk + 3; if (i4 < 511) im += pg[i4]; }
            const bool valid = bk <= cur, forced = (bk == 0) || (bk == cur) || (bk == cur - 1);
            scorev[bk] = valid ? (forced ? 1e30f : im) : -1e30f;
        }
        __syncthreads();
        if (tid < 128) {
            const float sv = scorev[tid]; int rank = 0;
            for (int k = 0; k < 128; ++k) { const float o = scorev[k]; rank += (o > sv || (o == sv && k < tid)) ? 1 : 0; }
            if (rank < 16) sel[rank] = tid;
        }
        __syncthreads();
        for (int idx = lt; idx < 1024; idx += 128) {
            const int kpos = sel[idx >> 6] * 64 + (idx & 63);
            float s = -INFINITY;
            if (kpos <= t) { const bf16_t* kr = proj + ((size_t)b * T + kpos) * LDP + C_KSLC + g * 64; s = 0.f; for (int d = 0; d < 64; ++d) s += q[h * 64 + d] * bf2f(kr[d]); }
            sch[idx] = s;
        }
        __syncthreads();
        nsa_head_softmax(sch, 1024, h, lt, red);
        { const float o = nsa_head_pv(sch, 1024, h, lt, opart, [&](int j, int d) { const int kpos = sel[j >> 6] * 64 + (j & 63); return bf2f(proj[((size_t)b * T + kpos) * LDP + C_VSLC + g * 64 + d]); });
          yacc += sigmoidf_(gates[m * 32 + (g * 4 + h) * 3 + 1]) * o; }
        for (int idx = lt; idx < 512; idx += 128) {
            const int kp = t - 511 + idx;
            float s = -INFINITY;
            if (kp >= 0) { const bf16_t* kr = proj + ((size_t)b * T + kp) * LDP + C_KWIN + g * 64; s = 0.f; for (int d = 0; d < 64; ++d) s += q[h * 64 + d] * bf2f(kr[d]); }
            sch[idx] = s;
        }
        __syncthreads();
        nsa_head_softmax(sch, 512, h, lt, red);
        { const float o = nsa_head_pv(sch, 512, h, lt, opart, [&](int j, int d) { const int kp = t - 511 + j; return bf2f(proj[((size_t)b * T + kp) * LDP + C_VWIN + g * 64 + d]); });
          yacc += sigmoidf_(gates[m * 32 + (g * 4 + h) * 3 + 2]) * o; }
        if (lt < 64) ya[m * 512 + (g * 4 + h) * 64 + lt] = f2bf(yacc);
        __syncthreads();
    }
}

__device__ void nv_mlstm_seq(const bf16_t* qb, const bf16_t* kb, const bf16_t* vb, const float* gates, const float* b_i, const float* b_f, float* hbuf, float* sm, int bid, int nb) {
    const int tid = threadIdx.x, col = tid >> 1, half = tid & 1;
    for (int unit = bid; unit < NB * 4; unit += nb) {
        const int b = unit >> 2, h = unit & 3;
        float C[64];
#pragma unroll
        for (int i = 0; i < 64; ++i) C[i] = 0.f;
        float mprev = 0.f;
        const float bi = b_i[h], bfv = b_f[h];
        for (int t = 0; t < T; ++t) {
            const size_t m = (size_t)b * T + t;
            const float fp = gates[m * 32 + 28 + h] + bfv, li = gates[m * 32 + 24 + h] + bi;
            const float lf = fminf(fp, 0.f) - log1pf(__expf(-fabsf(fp)));
            const float mnew = fmaxf(lf + mprev, li);
            const float fs = __expf(lf + mprev - mnew), is = __expf(li - mnew);
            float num = 0.f;
            if (col <= 128) {
                const float vt = (col < 128) ? bf2f(vb[m * 512 + h * 128 + col]) : 1.f;
                const float iv = is * vt;
                const bf16_t* kr = kb + m * 512 + h * 128 + half * 64; const bf16_t* qr = qb + m * 512 + h * 128 + half * 64;
#pragma unroll
                for (int i = 0; i < 64; ++i) { C[i] = fs * C[i] + iv * bf2f(kr[i]); num += bf2f(qr[i]) * C[i]; }
            }
            num += __shfl_xor(num, 1);
            if (tid == 256) sm[t & 1] = num;
            __syncthreads();
            if (col < 128 && half == 0) { const float den = sm[t & 1]; hbuf[m * 512 + h * 128 + col] = num / fmaxf(fabsf(den), __expf(-mnew)); }
            mprev = mnew;
        }
        __syncthreads();
    }
}

#define LAS __attribute__((address_space(3)))
namespace pg8 {
typedef short bf16x8 __attribute__((ext_vector_type(8)));
typedef unsigned u32x4 __attribute__((ext_vector_type(4)));
typedef unsigned u32x2 __attribute__((ext_vector_type(2)));
typedef int v4i __attribute__((ext_vector_type(4)));
typedef int v8i __attribute__((ext_vector_type(8)));
constexpr int BM = 256, BK = 64, HALF = 128, HTB = HALF * BK * 2, STAGE_BYTES = 8 * HTB, NXCD = 8, WGM = 8;
__host__ __device__ __forceinline__ int lds_byte(int r, int c) { const int st = (r >> 4) * 2 + (c >> 5), rr = r & 15, cc = c & 31, ob = rr * 64 + cc * 2; return st * 1024 + (ob ^ (((ob >> 9) & 1) << 5)); }
__host__ __device__ __forceinline__ void stage_rc(int b, int& R, int& C) { const int st = b / 1024, sb = b % 1024, swz = sb ^ (((sb >> 9) & 1) << 5); R = (st >> 1) * 16 + swz / 64; C = (st & 1) * 32 + (swz % 64) / 2; }
__host__ __device__ __forceinline__ int perm32(int rho) { const int n = rho >> 4, i = rho & 15; return 8 * (i >> 2) + 4 * n + (i & 3); }
struct Unit { int pm, pn, e, part; };
struct Off4 { unsigned p0, p1; };
__device__ __forceinline__ void tile_of(int L, int nM, int nN, int& pm, int& pn) {
    const int nwg = nM * nN; int wgid = L;
    { const int q = nwg / NXCD, r = nwg % NXCD, xcd = wgid % NXCD, off = wgid / NXCD; wgid = (xcd < r ? xcd * (q + 1) : r * (q + 1) + (xcd - r) * q) + off; }
    const int nig = WGM * nN, gid = wgid / nig, fm = gid * WGM, gsz = (nM - fm) < WGM ? (nM - fm) : WGM;
    pm = fm + ((wgid % nig) % gsz); pn = (wgid % nig) / gsz;
}
__device__ __forceinline__ unsigned cvt_pk_bf16(float lo, float hi) { unsigned r; asm volatile("v_cvt_pk_bf16_f32 %0, %1, %2" : "=v"(r) : "v"(lo), "v"(hi)); return r; }

__device__ __forceinline__ const char* uni(const char* p) {
    const unsigned long long v = (unsigned long long)p;
    return glb_ptr<const char>(((unsigned long long)(unsigned)__builtin_amdgcn_readfirstlane((int)(v >> 32)) << 32) | (unsigned long long)(unsigned)__builtin_amdgcn_readfirstlane((int)(unsigned)v)); }
template <class Epi, class Sched>
__device__ __forceinline__ void gemm_phase(LAS unsigned char* lds, const Sched& S, const Epi& E) {
    int tid_ = threadIdx.x; asm volatile("" : "+v"(tid_));
    const int tid = tid_, wid = __builtin_amdgcn_readfirstlane(tid >> 6), lane = tid & 63, wr = wid >> 2, wc = wid & 3, fr = lane & 15, fq = lane >> 4;
    const int nt = S.ntk;
    int Rr[2], Cc[2]; unsigned voffA[2], voffB[2];
#pragma unroll
    for (int i = 0; i < 2; ++i) { stage_rc(tid * 16 + i * 8192, Rr[i], Cc[i]); const int Rb = Epi::PERM ? ((Rr[i] & ~31) + perm32(Rr[i] & 31)) : Rr[i];
        voffA[i] = (unsigned)Rr[i] * S.lda2 + (unsigned)Cc[i] * 2u; voffB[i] = (unsigned)Rb * S.ldb2 + (unsigned)Cc[i] * 2u; }
    const unsigned kA = (unsigned)S.kstepA, hA = (unsigned)HALF * S.lda2, hB = (unsigned)HALF * S.ldb2; constexpr unsigned kB = BK * 2;
    const char* const baseA = uni(S.abase()); const char* const baseB = uni(S.bbase());
    const unsigned ldsw = (unsigned)wid * 1024u;
    const int aoff = lds_byte(wr * 64 + fr, fq * 8), boff = lds_byte(wc * 32 + fr, fq * 8);
#define PG8_SA(b, h) (((b) * 2 + (h)) * HTB)
#define PG8_SB(b, h) ((4 + (b) * 2 + (h)) * HTB)
#define PG8_STG(bufoff, p0, p1) do { __builtin_amdgcn_global_load_lds((const unsigned*)(p0), (LAS unsigned*)(lds + (bufoff) + ldsw), 16, 0, 0); \
        __builtin_amdgcn_global_load_lds((const unsigned*)(p1), (LAS unsigned*)(lds + (bufoff) + ldsw + 8192), 16, 0, 0); } while (0)
#define PG8_STA(bufoff, ao, h, vv) do { if constexpr (Sched::GATHER) { const unsigned _pp = (h) ? vv.p1 : vv.p0; PG8_STG(bufoff, baseA + ((ao) + (_pp & 0xffffu) * S.lda2 + gcol), baseA + ((ao) + (_pp >> 16) * S.lda2 + gcol)); } \
        else { const unsigned _p = (ao) + (h) * hA; PG8_STG(bufoff, baseA + (_p + voffA[0]), baseA + (_p + voffA[1])); } } while (0)
#define PG8_STB(bufoff, bo, h) do { const unsigned _q = (bo) + (h) * hB; PG8_STG(bufoff, baseB + (_q + voffB[0]), baseB + (_q + voffB[1])); } while (0)
#define PG8_CAT(x0, x1) __builtin_shufflevector(x0, x1, 0, 1, 2, 3, 4, 5, 6, 7)
#define PG8_LDA(dst, b, h) do { _Pragma("unroll") for (int m = 0; m < 4; ++m) { if constexpr (Sched::FP8) dst##8[m] = PG8_CAT(*(const LAS v4i*)(lds + PG8_SA(b, h) + aoff + m * 2048), *(const LAS v4i*)(lds + PG8_SA(b, h) + aoff + m * 2048 + 1024)); \
        else { _Pragma("unroll") for (int k = 0; k < 2; ++k) dst[m][k] = *(const LAS bf16x8*)(lds + PG8_SA(b, h) + aoff + m * 2048 + k * 1024); } } } while (0)
#define PG8_LDB(dst, b, h) do { _Pragma("unroll") for (int n = 0; n < 2; ++n) { if constexpr (Sched::FP8) dst##8[n] = PG8_CAT(*(const LAS v4i*)(lds + PG8_SB(b, h) + boff + n * 2048), *(const LAS v4i*)(lds + PG8_SB(b, h) + boff + n * 2048 + 1024)); \
        else { _Pragma("unroll") for (int k = 0; k < 2; ++k) dst[n][k] = *(const LAS bf16x8*)(lds + PG8_SB(b, h) + boff + n * 2048 + k * 1024); } } } while (0)
#define PG8_MMA(ai, bj, At, Bt) do { __builtin_amdgcn_s_setprio(1); _Pragma("unroll") for (int m = 0; m < 4; ++m) _Pragma("unroll") for (int n = 0; n < 2; ++n) { \
        if constexpr (Sched::FP8) asm volatile("v_mfma_scale_f32_16x16x128_f8f6f4 %0, %1, %2, %0, %3, %4 op_sel_hi:[0,0,0]" : "+v"(acc[ai][bj][m][n]) : "v"(Bt##8[n]), "v"(At##8[m]), "v"(sclB), "v"(sclA)); \
        else { _Pragma("unroll") for (int k = 0; k < 2; ++k) acc[ai][bj][m][n] = __builtin_amdgcn_mfma_f32_16x16x32_bf16(Bt[n][k], At[m][k], acc[ai][bj][m][n], 0, 0, 0); } } \
        __builtin_amdgcn_s_setprio(0); } while (0)
#define PG8_WAIT_V(n) asm volatile("s_waitcnt vmcnt(" #n ")" ::: "memory")
#define PG8_WAIT_L(n) asm volatile("s_waitcnt lgkmcnt(" #n ")" ::: "memory")
#define PG8_BAR __builtin_amdgcn_s_barrier()
#define PG8_SCHED __builtin_amdgcn_sched_barrier(0)
#define PG8_ZERO() do { _Pragma("unroll") for (int a_ = 0; a_ < 2; ++a_) _Pragma("unroll") for (int b_ = 0; b_ < 2; ++b_) _Pragma("unroll") for (int m_ = 0; m_ < 4; ++m_) _Pragma("unroll") for (int n_ = 0; n_ < 2; ++n_) acc[a_][b_][m_][n_] = (f32x4){0.f, 0.f, 0.f, 0.f}; } while (0)
    Unit cur, nxt; int ui = 0;
    if (!S.next(0, cur)) return;
    f32x4 acc[2][2][4][2];
    PG8_ZERO();
    int sclB = Sched::SB, sclA = 127; asm volatile("" : "+v"(sclB), "+v"(sclA));
    bf16x8 At[4][2], B0[2][2], B1[2][2]; v8i At8[4], B08[2], B18[2];
    unsigned cA = (unsigned)__builtin_amdgcn_readfirstlane((int)S.a_off(cur)), cB = (unsigned)__builtin_amdgcn_readfirstlane((int)S.b_off(cur));
    Off4 cvA{0u, 0u}, nvA{0u, 0u};
    const unsigned gcol = (unsigned)Cc[0] * 2u;
    if constexpr (Sched::GATHER) S.a_gather(cur, Rr[0], cvA);
    PG8_STB(PG8_SB(0, 0), cB, 0); PG8_STB(PG8_SB(0, 1), cB, 1); PG8_STA(PG8_SA(0, 0), cA, 0, cvA); PG8_STA(PG8_SA(0, 1), cA, 1, cvA);
    if (wr == 1) PG8_BAR;
    PG8_WAIT_V(2); PG8_BAR;
    PG8_STB(PG8_SB(1, 0), cB + kB, 0); PG8_STA(PG8_SA(1, 0), cA + kA, 0, cvA); PG8_STB(PG8_SB(1, 1), cB + kB, 1);
    PG8_WAIT_V(6); PG8_BAR;
    for (;;) {
        const bool has_next = S.next(ui + 1, nxt);
        const unsigned nA = has_next ? (unsigned)__builtin_amdgcn_readfirstlane((int)S.a_off(nxt)) : cA, nB = has_next ? (unsigned)__builtin_amdgcn_readfirstlane((int)S.b_off(nxt)) : cB;
        if constexpr (Sched::GATHER) { if (has_next) S.a_gather(nxt, Rr[0], nvA); else nvA = cvA; }
        for (int t = 0; t < nt; t += 2) {
            const bool last = (t == nt - 2);
            const unsigned a1 = cA + (unsigned)(t + 1) * kA;
            const unsigned a2 = last ? nA : cA + (unsigned)(t + 2) * kA, b2 = last ? nB : cB + (unsigned)(t + 2) * kB;
            const unsigned a3 = a2 + kA, b3 = b2 + kB;
#define v2 (last ? nvA : cvA)
            PG8_LDB(B0, 0, 0); PG8_LDB(B1, 0, 1); PG8_SCHED; PG8_LDA(At, 0, 0); PG8_STA(PG8_SA(1, 1), a1, 1, cvA);
            PG8_WAIT_V(8); PG8_WAIT_L(0); PG8_BAR; PG8_MMA(0, 0, At, B0); PG8_MMA(0, 1, At, B1); PG8_BAR; PG8_SCHED;
            PG8_LDA(At, 0, 1); PG8_STB(PG8_SB(0, 0), b2, 0); PG8_STB(PG8_SB(0, 1), b2, 1); PG8_STA(PG8_SA(0, 0), a2, 0, v2);
            PG8_WAIT_V(8); PG8_WAIT_L(0); PG8_BAR; PG8_MMA(1, 0, At, B0); PG8_MMA(1, 1, At, B1); PG8_BAR; PG8_SCHED;
            PG8_LDB(B0, 1, 0); PG8_LDB(B1, 1, 1); PG8_SCHED; PG8_LDA(At, 1, 0); PG8_STA(PG8_SA(0, 1), a2, 1, v2);
            PG8_WAIT_V(8); PG8_WAIT_L(0); PG8_BAR; PG8_MMA(0, 0, At, B0); PG8_MMA(0, 1, At, B1); PG8_BAR; PG8_SCHED;
            PG8_LDA(At, 1, 1); PG8_STB(PG8_SB(1, 0), b3, 0); PG8_STB(PG8_SB(1, 1), b3, 1); PG8_STA(PG8_SA(1, 0), a3, 0, v2);
            PG8_WAIT_V(8); PG8_WAIT_L(0); PG8_BAR; PG8_MMA(1, 0, At, B0); PG8_MMA(1, 1, At, B1); PG8_BAR; PG8_SCHED;
#undef v2
        }
        if (wr == 0) PG8_BAR;
        if constexpr (Sched::FP8) asm volatile("s_nop 15\n\ts_nop 15" ::: "memory");
        const bool keep = S.keep(cur);
        if (keep) E.mid(acc, cur, wr, wc, fr, fq); else E(acc, cur, wr, wc, fr, fq);
        if (!has_next) break;
        if (!keep) PG8_ZERO();
        cur = nxt; cA = nA; cB = nB; ++ui; cvA = nvA;
        if (wr == 1) PG8_BAR;
    }
    PG8_WAIT_V(0);
    PG8_BAR;
#undef PG8_SA
#undef PG8_SB
#undef PG8_STG
#undef PG8_STA
#undef PG8_STB
#undef PG8_LDA
#undef PG8_LDB
#undef PG8_MMA
#undef PG8_CAT
#undef PG8_WAIT_V
#undef PG8_WAIT_L
#undef PG8_BAR
#undef PG8_SCHED
#undef PG8_ZERO
}

struct DenseSched {
    static constexpr bool GATHER = false, FP8 = false; static constexpr int SB = 127;
    const char* A0; const char* B0; const char* A1; const char* B1; unsigned lda2, ldb2; size_t kstepA; int ntk, nM, nN, G, c, parts;
    __device__ __forceinline__ bool next(int i, Unit& u) const { const int ti = parts == 2 ? (i >> 1) : i; const long L = (long)ti * G + c; if (L >= (long)nM * nN) return false;
        tile_of((int)L, nM, nN, u.pm, u.pn); u.e = 0; u.part = parts == 2 ? (i & 1) : 0; return true; }
    __device__ __forceinline__ const char* abase() const { return A0; }
    __device__ __forceinline__ const char* bbase() const { return B0; }
    __device__ __forceinline__ unsigned a_off(const Unit& u) const { return (u.part ? (unsigned)(A1 - A0) : 0u) + (unsigned)u.pm * BM * lda2; }
    __device__ __forceinline__ unsigned b_off(const Unit& u) const { return (u.part ? (unsigned)(B1 - B0) : 0u) + (unsigned)u.pn * BM * ldb2; }
    __device__ __forceinline__ bool keep(const Unit& u) const { return parts == 2 && u.part == 0; }
    __device__ __forceinline__ void a_gather(const Unit&, int, Off4&) const {}
};
struct MoeSched {
    const char* A; const char* Bt; unsigned lda2, ldb2; size_t kstepA; int ntk, nM, nN, G, c; size_t bexp;
    const LAS int* tend; const unsigned* rowpair;
    __device__ __forceinline__ bool next(int i, Unit& u) const { const long L = (long)i * G + c; if (L >= (long)nM * nN) return false;
        tile_of((int)L, nM, nN, u.pm, u.pn); int e = 0;
#pragma unroll
        for (int j = 0; j < 31; ++j) e += (u.pm >= tend[j]) ? 1 : 0;
        u.e = __builtin_amdgcn_readfirstlane(e); u.part = 0; return true; }
    __device__ __forceinline__ const char* abase() const { return A; }
    __device__ __forceinline__ const char* bbase() const { return Bt; }
    __device__ __forceinline__ unsigned b_off(const Unit& u) const { return (unsigned)u.e * (unsigned)bexp + (unsigned)u.pn * BM * ldb2; }
    __device__ __forceinline__ bool keep(const Unit&) const { return false; }
};
struct MoeSched1 : MoeSched { static constexpr bool GATHER = true, FP8 = true; static constexpr int SB = 122;
    __device__ __forceinline__ unsigned a_off(const Unit&) const { return 0u; }
    __device__ __forceinline__ void a_gather(const Unit& u, int R0, Off4& off) const {
        off.p0 = rowpair[(u.pm * 2) * 64 + R0]; off.p1 = rowpair[(u.pm * 2 + 1) * 64 + R0]; }
};
struct MoeSched2 : MoeSched { static constexpr bool GATHER = false, FP8 = true; static constexpr int SB = 122;
    __device__ __forceinline__ unsigned a_off(const Unit& u) const { return (unsigned)u.pm * BM * lda2; }
    __device__ __forceinline__ void a_gather(const Unit&, int, Off4&) const {}
};

typedef f32x4 Acc[2][2][4][2];
__device__ __forceinline__ float rstd_from_ssq(const float* ssq, size_t row) {
    const f32x4* p = (const f32x4*)(ssq + row * 16); const f32x4 a = p[0], b = p[1], c = p[2], d = p[3];
    const float s = ((a.x + a.y) + (a.z + a.w)) + ((b.x + b.y) + (b.z + b.w)) + ((c.x + c.y) + (c.z + c.w)) + ((d.x + d.y) + (d.z + d.w));
    return rsqrtf(s * (1.f / 1024.f) + 1e-5f);
}
__device__ __forceinline__ unsigned pack4_fp8(const f32x4& v) { int w = __builtin_amdgcn_cvt_pk_fp8_f32(v[0], v[1], 0, false); w = __builtin_amdgcn_cvt_pk_fp8_f32(v[2], v[3], w, true); return (unsigned)w; }
__device__ __forceinline__ u32x4 pack8(const f32x4& v0, const f32x4& v1) { u32x4 w; w.x = cvt_pk_bf16(v0[0], v0[1]); w.y = cvt_pk_bf16(v0[2], v0[3]); w.z = cvt_pk_bf16(v1[0], v1[1]); w.w = cvt_pk_bf16(v1[2], v1[3]); return w; }
__device__ __forceinline__ void unpack8(const u32x4& w, f32x4& v0, f32x4& v1) {
    v0[0] = __uint_as_float(w.x << 16); v0[1] = __uint_as_float(w.x & 0xffff0000u); v0[2] = __uint_as_float(w.y << 16); v0[3] = __uint_as_float(w.y & 0xffff0000u);
    v1[0] = __uint_as_float(w.z << 16); v1[1] = __uint_as_float(w.z & 0xffff0000u); v1[2] = __uint_as_float(w.w << 16); v1[3] = __uint_as_float(w.w & 0xffff0000u); }

struct EpiProj { static constexpr bool PERM = true;
    bf16_t* proj; float* gates; bf16_t* kvc;
    __device__ __forceinline__ void mid(Acc&, const Unit&, int, int, int, int) const {}
    __device__ __forceinline__ void operator()(const Acc& acc, const Unit& u, int wr, int wc, int fr, int fq) const {
        const int row0 = u.pm * BM + wr * 64 + fr, col0 = u.pn * BM + wc * 32 + 8 * fq;
#pragma unroll
        for (int ai = 0; ai < 2; ++ai)
#pragma unroll
            for (int m = 0; m < 4; ++m) { const size_t row = row0 + ai * HALF + m * 16; bf16_t* rowp = proj + row * LDP + col0;
                if (u.pn >= 2 && u.pn <= 4) { const int cc = wc * 32 + 8 * fq, g = cc >> 6, d = cc & 63; const size_t bt = ((row >> 13) * 2 + g) * (size_t)T + (row & (T - 1));
#pragma unroll
                    for (int bj = 0; bj < 2; ++bj) *(u32x4*)(kvc + ((size_t)((u.pn - 2) * 2 + bj) * M * 128) + bt * 64 + d) = pack8(acc[ai][bj][m][0], acc[ai][bj][m][1]);
                    continue; }
#pragma unroll
                for (int bj = 0; bj < 2; ++bj) *(u32x4*)(rowp + bj * HALF) = pack8(acc[ai][bj][m][0], acc[ai][bj][m][1]);
                if (u.pn == 17 && wc == 0) { *(f32x4*)(gates + row * 32 + 8 * fq) = acc[ai][0][m][0]; *(f32x4*)(gates + row * 32 + 8 * fq + 4) = acc[ai][0][m][1]; } }
    }
};
struct EpiMerged { static constexpr bool PERM = true;
    const bf16_t* proj; bf16_t* mg;
    __device__ __forceinline__ void mid(Acc& acc, const Unit& u, int wr, int wc, int fr, int fq) const {
        const int row0 = u.pm * BM + wr * 64 + fr, col0 = u.pn * BM + wc * 32 + 8 * fq;
#pragma unroll
        for (int ai = 0; ai < 2; ++ai) { u32x4 ga[4][2], gb[4][2];
#pragma unroll
            for (int m = 0; m < 4; ++m)
#pragma unroll
                for (int bj = 0; bj < 2; ++bj) { const bf16_t* pp = proj + (size_t)(row0 + ai * HALF + m * 16) * LDP + col0 + bj * HALF; ga[m][bj] = *(const u32x4*)(pp + C_GA); gb[m][bj] = *(const u32x4*)(pp + C_GB); }
#pragma unroll
            for (int m = 0; m < 4; ++m)
#pragma unroll
                for (int bj = 0; bj < 2; ++bj) { f32x4 a0, a1, b0, b1; unpack8(ga[m][bj], a0, a1); unpack8(gb[m][bj], b0, b1);
#pragma unroll
                    for (int j = 0; j < 4; ++j) { acc[ai][bj][m][0][j] *= (1.f + __expf(-b0[j])) * __builtin_amdgcn_rcpf(1.f + __expf(-a0[j])); acc[ai][bj][m][1][j] *= (1.f + __expf(-b1[j])) * __builtin_amdgcn_rcpf(1.f + __expf(-a1[j])); } } }
    }
    __device__ __forceinline__ void operator()(const Acc& acc, const Unit& u, int wr, int wc, int fr, int fq) const {
        const int row0 = u.pm * BM + wr * 64 + fr, col0 = u.pn * BM + wc * 32 + 8 * fq;
        u32x4 gba[2][4][2];
#pragma unroll
        for (int ai = 0; ai < 2; ++ai)
#pragma unroll
            for (int m = 0; m < 4; ++m)
#pragma unroll
                for (int bj = 0; bj < 2; ++bj) gba[ai][m][bj] = *(const u32x4*)(proj + (size_t)(row0 + ai * HALF + m * 16) * LDP + C_GB + col0 + bj * HALF);
#pragma unroll
        for (int ai = 0; ai < 2; ++ai) {
#pragma unroll
            for (int m = 0; m < 4; ++m)
#pragma unroll
                for (int bj = 0; bj < 2; ++bj) { f32x4 b0, b1; unpack8(gba[ai][m][bj], b0, b1); f32x4 v0 = acc[ai][bj][m][0], v1 = acc[ai][bj][m][1];
#pragma unroll
                    for (int j = 0; j < 4; ++j) { v0[j] *= __builtin_amdgcn_rcpf(1.f + __expf(-b0[j])); v1[j] *= __builtin_amdgcn_rcpf(1.f + __expf(-b1[j])); }
                    *(u32x4*)(mg + (size_t)(row0 + ai * HALF + m * 16) * D + col0 + bj * HALF) = pack8(v0, v1); } }
    }
};
template <bool BASE_BF16>
struct EpiResid { static constexpr bool PERM = false;
    const void* base; bf16_t* xb; float* ssq; unsigned char* xq;
    __device__ __forceinline__ void mid(Acc&, const Unit&, int, int, int, int) const {}
    __device__ __forceinline__ void operator()(const Acc& acc, const Unit& u, int wr, int wc, int fr, int fq) const {
        const int row0 = u.pm * BM + wr * 64 + fr, col0 = u.pn * BM + wc * 32 + 4 * fq;
        if constexpr (BASE_BF16) {
            u32x2 bw[2][4][2][2];
#pragma unroll
            for (int ai = 0; ai < 2; ++ai)
#pragma unroll
                for (int m = 0; m < 4; ++m)
#pragma unroll
                    for (int bj = 0; bj < 2; ++bj)
#pragma unroll
                        for (int n = 0; n < 2; ++n) bw[ai][m][bj][n] = *(const u32x2*)((const bf16_t*)base + (size_t)(row0 + ai * HALF + m * 16) * D + col0 + bj * HALF + n * 16);
#pragma unroll
            for (int ai = 0; ai < 2; ++ai)
#pragma unroll
                for (int m = 0; m < 4; ++m) { const size_t row = row0 + ai * HALF + m * 16; float s = 0.f;
#pragma unroll
                    for (int bj = 0; bj < 2; ++bj)
#pragma unroll
                        for (int n = 0; n < 2; ++n) { const size_t o = row * D + col0 + bj * HALF + n * 16; const u32x2 b2 = bw[ai][m][bj][n];
                            const f32x4 v = (f32x4){__uint_as_float(b2.x << 16), __uint_as_float(b2.x & 0xffff0000u), __uint_as_float(b2.y << 16), __uint_as_float(b2.y & 0xffff0000u)} + acc[ai][bj][m][n];
                            u32x2 w; w.x = cvt_pk_bf16(v[0], v[1]); w.y = cvt_pk_bf16(v[2], v[3]); *(u32x2*)(xb + o) = w;
                            if (xq) *(unsigned*)(xq + o) = pack4_fp8(v);
                            s += (v[0] * v[0] + v[1] * v[1]) + (v[2] * v[2] + v[3] * v[3]); }
                    s += __shfl_xor(s, 16); s += __shfl_xor(s, 32);
                    if (fq == 0) ssq[row * 16 + u.pn * 4 + wc] = s; }
            return; }
#pragma unroll
        for (int ai = 0; ai < 2; ++ai) { f32x4 bv[4][2][2];
#pragma unroll
            for (int m = 0; m < 4; ++m)
#pragma unroll
                for (int bj = 0; bj < 2; ++bj)
#pragma unroll
                    for (int n = 0; n < 2; ++n) { const size_t o = (size_t)(row0 + ai * HALF + m * 16) * D + col0 + bj * HALF + n * 16;
                        if constexpr (BASE_BF16) { const u32x2 bw = *(const u32x2*)((const bf16_t*)base + o); bv[m][bj][n] = (f32x4){__uint_as_float(bw.x << 16), __uint_as_float(bw.x & 0xffff0000u), __uint_as_float(bw.y << 16), __uint_as_float(bw.y & 0xffff0000u)}; }
                        else bv[m][bj][n] = *(const f32x4*)((const float*)base + o); }
#pragma unroll
            for (int m = 0; m < 4; ++m) { const size_t row = row0 + ai * HALF + m * 16; float s = 0.f;
#pragma unroll
                for (int bj = 0; bj < 2; ++bj)
#pragma unroll
                    for (int n = 0; n < 2; ++n) { const size_t o = row * D + col0 + bj * HALF + n * 16; const f32x4 v = bv[m][bj][n] + acc[ai][bj][m][n];
                        u32x2 w; w.x = cvt_pk_bf16(v[0], v[1]); w.y = cvt_pk_bf16(v[2], v[3]); *(u32x2*)(xb + o) = w;
                        if (xq) *(unsigned*)(xq + o) = pack4_fp8(v);
                        s += (v[0] * v[0] + v[1] * v[1]) + (v[2] * v[2] + v[3] * v[3]); }
                s += __shfl_xor(s, 16); s += __shfl_xor(s, 32);
                if (fq == 0) ssq[row * 16 + u.pn * 4 + wc] = s; } }
    }
};
struct EpiScaleBf16 { static constexpr bool PERM = true;
    bf16_t* o; int ldo; const float* ssq;
    __device__ __forceinline__ void mid(Acc&, const Unit&, int, int, int, int) const {}
    __device__ __forceinline__ void operator()(const Acc& acc, const Unit& u, int wr, int wc, int fr, int fq) const {
        const int row0 = u.pm * BM + wr * 64 + fr, col0 = u.pn * BM + wc * 32 + 8 * fq;
        float rsa[2][4];
        if (ssq) { f32x4 qv[2][4];
#pragma unroll
            for (int ai = 0; ai < 2; ++ai)
#pragma unroll
                for (int m = 0; m < 4; ++m) qv[ai][m] = *(const f32x4*)(ssq + (size_t)(row0 + ai * HALF + m * 16) * 16 + 4 * fq);
#pragma unroll
            for (int ai = 0; ai < 2; ++ai)
#pragma unroll
                for (int m = 0; m < 4; ++m) { float sq = (qv[ai][m][0] + qv[ai][m][1]) + (qv[ai][m][2] + qv[ai][m][3]); sq += __shfl_xor(sq, 16); sq += __shfl_xor(sq, 32); rsa[ai][m] = rsqrtf(sq * (1.f / 1024.f) + 1e-5f); } }
        else {
#pragma unroll
            for (int ai = 0; ai < 2; ++ai)
#pragma unroll
                for (int m = 0; m < 4; ++m) rsa[ai][m] = 1.f; }
#pragma unroll
        for (int ai = 0; ai < 2; ++ai)
#pragma unroll
            for (int m = 0; m < 4; ++m) { const size_t row = row0 + ai * HALF + m * 16;
#pragma unroll
                for (int bj = 0; bj < 2; ++bj) *(u32x4*)(o + row * ldo + col0 + bj * HALF) = pack8(acc[ai][bj][m][0] * rsa[ai][m], acc[ai][bj][m][1] * rsa[ai][m]); }
    }
};
struct EpiLogit { static constexpr bool PERM = false;
    float* logit; const float* ssq; const float* bias;
    __device__ __forceinline__ void mid(Acc&, const Unit&, int, int, int, int) const {}
    __device__ __forceinline__ void operator()(const Acc& acc, const Unit& u, int wr, int wc, int fr, int fq) const {
        if (wc != 0) return;
        const int row0 = u.pm * BM + wr * 64 + fr;
#pragma unroll
        for (int ai = 0; ai < 2; ++ai)
#pragma unroll
            for (int m = 0; m < 4; ++m) { const size_t row = row0 + ai * HALF + m * 16; const float rs = rstd_from_ssq(ssq, row);
#pragma unroll
                for (int n = 0; n < 2; ++n) { const int c = n * 16 + 4 * fq; *(f32x4*)(logit + row * 32 + c) = acc[ai][0][m][n] * rs + *(const f32x4*)(bias + c); } }
    }
};
struct EpiMoe1 { static constexpr bool PERM = true;
    unsigned char* act; const float* rowrs; const float* bgu;
    __device__ __forceinline__ void mid(Acc&, const Unit&, int, int, int, int) const {}
    __device__ __forceinline__ void operator()(const Acc& acc, const Unit& u, int wr, int wc, int fr, int fq) const {
        const int row0 = u.pm * BM + wr * 64 + fr, c0 = u.pn * HALF + wc * 32 + 8 * fq;
        const float* bg = bgu + (size_t)u.e * 2048 + c0;
        float rsa[2][4];
#pragma unroll
        for (int ai = 0; ai < 2; ++ai)
#pragma unroll
            for (int m = 0; m < 4; ++m) rsa[ai][m] = rowrs[row0 + ai * HALF + m * 16];
        const f32x4 bg0 = *(const f32x4*)bg, bg1 = *(const f32x4*)(bg + 4), bu0 = *(const f32x4*)(bg + 1024), bu1 = *(const f32x4*)(bg + 1028);
#pragma unroll
        for (int ai = 0; ai < 2; ++ai)
            {
#pragma unroll
              for (int m = 0; m < 4; ++m) { const size_t row = row0 + ai * HALF + m * 16; const float rs = rsa[ai][m];
                f32x4 o0, o1;
#pragma unroll
                for (int j = 0; j < 4; ++j) {
                    float g0 = fminf(acc[ai][0][m][0][j] * rs + bg0[j], 7.f), u0 = fminf(fmaxf(acc[ai][1][m][0][j] * rs + bu0[j], -7.f), 7.f);
                    float g1 = fminf(acc[ai][0][m][1][j] * rs + bg1[j], 7.f), u1 = fminf(fmaxf(acc[ai][1][m][1][j] * rs + bu1[j], -7.f), 7.f);
                    o0[j] = (u0 + 1.f) * g0 * __builtin_amdgcn_rcpf(1.f + __expf(-1.702f * g0)); o1[j] = (u1 + 1.f) * g1 * __builtin_amdgcn_rcpf(1.f + __expf(-1.702f * g1)); }
                u32x2 w8; w8.x = pack4_fp8(o0); w8.y = pack4_fp8(o1); *(u32x2*)(act + row * D + c0) = w8; } }
    }
};
struct EpiMoe2 { static constexpr bool PERM = true;
    bf16_t* ys; const int* rslot; const float* roww; const float* bd;
    __device__ __forceinline__ void mid(Acc&, const Unit&, int, int, int, int) const {}
    __device__ __forceinline__ void operator()(const Acc& acc, const Unit& u, int wr, int wc, int fr, int fq) const {
        const int row0 = u.pm * BM + wr * 64 + fr, col0 = u.pn * BM + wc * 32 + 8 * fq;
        const float* bp = bd + (size_t)u.e * D + col0;
        int slv[2][4]; float wv_[2][4];
#pragma unroll
        for (int ai = 0; ai < 2; ++ai)
#pragma unroll
            for (int m = 0; m < 4; ++m) { slv[ai][m] = rslot[row0 + ai * HALF + m * 16]; wv_[ai][m] = roww[row0 + ai * HALF + m * 16]; }
        f32x4 bb[2][2];
#pragma unroll
        for (int bj = 0; bj < 2; ++bj) { bb[bj][0] = *(const f32x4*)(bp + bj * HALF); bb[bj][1] = *(const f32x4*)(bp + bj * HALF + 4); }
#pragma unroll
        for (int ai = 0; ai < 2; ++ai)
#pragma unroll
            for (int m = 0; m < 4; ++m) asm volatile("" : "+v"(wv_[ai][m]));
#pragma unroll
        for (int ai = 0; ai < 2; ++ai)
#pragma unroll
            for (int m = 0; m < 4; ++m) { const int sl = slv[ai][m]; const float w = wv_[ai][m]; if (sl < 0) continue;
#pragma unroll
                for (int bj = 0; bj < 2; ++bj) *(u32x4*)(ys + (size_t)sl * D + col0 + bj * HALF) = pack8((acc[ai][bj][m][0] + bb[bj][0]) * w, (acc[ai][bj][m][1] + bb[bj][1]) * w); }
    }
};
struct CmpSched {
    static constexpr bool GATHER = false, FP8 = false; static constexpr int SB = 127;
    const bf16_t* kvc; const char* Bt; unsigned lda2, ldb2; size_t kstepA; int ntk, G, c;
    __device__ __forceinline__ bool next(int i, Unit& u) const { const int L = i * G + c; if (L >= 32) return false; u.pm = L & 15; u.pn = 0; u.e = L >> 4; u.part = 0; return true; }
    __device__ __forceinline__ const char* abase() const { return (const char*)kvc; }
    __device__ __forceinline__ const char* bbase() const { return Bt; }
    __device__ __forceinline__ unsigned a_off(const Unit& u) const { const int bg = u.pm >> 1; return (unsigned)(((size_t)u.e * M * 128 + ((size_t)bg * T + 4096 * (u.pm & 1)) * 64) * 2); }
    __device__ __forceinline__ unsigned b_off(const Unit& u) const { return (unsigned)u.e * 256u * 2048u * 2u; }
    __device__ __forceinline__ bool keep(const Unit&) const { return false; }
    __device__ __forceinline__ void a_gather(const Unit&, int, Off4&) const {}
};
struct EpiCmp { static constexpr bool PERM = false;
    float* h1; const float* bias1;
    __device__ __forceinline__ void mid(Acc&, const Unit&, int, int, int, int) const {}
    __device__ __forceinline__ void operator()(const Acc& acc, const Unit& u, int wr, int wc, int fr, int fq) const {
        const int row0 = u.pm * BM + wr * 64 + fr, col0 = wc * 32 + 4 * fq;
        f32x4 bcv[2];
#pragma unroll
        for (int n = 0; n < 2; ++n) bcv[n] = *(const f32x4*)(bias1 + u.e * 128 + col0 + n * 16);
#pragma unroll
        for (int ai = 0; ai < 2; ++ai)
#pragma unroll
            for (int m = 0; m < 4; ++m) { const size_t row = (size_t)u.e * 4096 + row0 + ai * HALF + m * 16;
#pragma unroll
                for (int n = 0; n < 2; ++n) { const int c = col0 + n * 16; f32x4 v = acc[ai][0][m][n] + bcv[n];
#pragma unroll
                    for (int j = 0; j < 4; ++j) { const float t = v[j]; v[j] = 0.5f * t * (1.f + tanhf(0.7978845608028654f * (t + 0.044715f * t * t * t))); }
                    *(f32x4*)(h1 + row * 128 + c) = v; } }
    }
};
}

namespace nsa {
typedef short bf16x8 __attribute__((ext_vector_type(8)));
typedef short s16x4 __attribute__((ext_vector_type(4)));
typedef float f32x16 __attribute__((ext_vector_type(16)));
typedef unsigned u32x4 __attribute__((ext_vector_type(4)));
constexpr int L_K = 0, L_V = 16384, L_IMP = 32768, IMP_LD = 132, L_SEL = L_IMP + 64 * IMP_LD * 4, L_WSF = L_SEL + 1024, L_OST = L_WSF + 2048, L_END = L_OST + 65536;
constexpr float C2 = 0.125f * 1.4426950408889634f, THR = 6.f;
__device__ __forceinline__ s16x4 vtr(const LAS unsigned char* p) { typedef short v4i16_t __attribute__((ext_vector_type(4))); return __builtin_bit_cast(s16x4, __builtin_amdgcn_ds_read_tr16_b64_v4i16((LAS v4i16_t*)p)); }
template <int OFF> __device__ __forceinline__ s16x4 vtra(const LAS unsigned char* p) { s16x4 r; asm volatile("ds_read_b64_tr_b16 %0, %1 offset:%2" : "=v"(r) : "v"(p), "n"(OFF) : "memory"); return r; }
__device__ __forceinline__ float swap_max(float v) { auto rr = __builtin_amdgcn_permlane32_swap(__float_as_uint(v), __float_as_uint(v), false, false); return fmaxf(__uint_as_float(rr[0]), __uint_as_float(rr[1])); }
__device__ __forceinline__ float swap_sum(float v) { auto rr = __builtin_amdgcn_permlane32_swap(__float_as_uint(v), __float_as_uint(v), false, false); return __uint_as_float(rr[0]) + __uint_as_float(rr[1]); }
__device__ __forceinline__ unsigned pk(float lo, float hi) { return pg8::cvt_pk_bf16(lo, hi); }

struct Ctx { int tid, lane, wid, r32, hi, ksw; LAS unsigned char* lds; LAS float* wsf; };

__device__ __forceinline__ void qkt(f32x16& p0, f32x16& p1, const LAS unsigned char* kp, const bf16x8 (&qr)[4], int sw) {
    bf16x8 kf[8];
#pragma unroll
    for (int d0 = 0; d0 < 4; ++d0) { const int co = ((2 * d0) ^ sw) * 16; kf[2 * d0] = *(const LAS bf16x8*)(kp + co); kf[2 * d0 + 1] = *(const LAS bf16x8*)(kp + 4096 + co); }
    __builtin_amdgcn_sched_barrier(0);
    p0 = __builtin_amdgcn_mfma_f32_32x32x16_bf16(kf[0], qr[0], (f32x16){0.f,0.f,0.f,0.f,0.f,0.f,0.f,0.f,0.f,0.f,0.f,0.f,0.f,0.f,0.f,0.f}, 0, 0, 0);
    p1 = __builtin_amdgcn_mfma_f32_32x32x16_bf16(kf[1], qr[0], (f32x16){0.f,0.f,0.f,0.f,0.f,0.f,0.f,0.f,0.f,0.f,0.f,0.f,0.f,0.f,0.f,0.f}, 0, 0, 0);
#pragma unroll
    for (int d0 = 1; d0 < 4; ++d0) { p0 = __builtin_amdgcn_mfma_f32_32x32x16_bf16(kf[2 * d0], qr[d0], p0, 0, 0, 0); p1 = __builtin_amdgcn_mfma_f32_32x32x16_bf16(kf[2 * d0 + 1], qr[d0], p1, 0, 0, 0); }
}
__device__ __forceinline__ void pv(f32x16 (&o)[2], const LAS unsigned char* vp, const f32x16& p0, const f32x16& p1) {
    u32x4 pw[4];
    pw[0] = (u32x4){pk(p0[0], p0[1]), pk(p0[2], p0[3]), pk(p0[4], p0[5]), pk(p0[6], p0[7])}; pw[1] = (u32x4){pk(p0[8], p0[9]), pk(p0[10], p0[11]), pk(p0[12], p0[13]), pk(p0[14], p0[15])};
    pw[2] = (u32x4){pk(p1[0], p1[1]), pk(p1[2], p1[3]), pk(p1[4], p1[5]), pk(p1[6], p1[7])}; pw[3] = (u32x4){pk(p1[8], p1[9]), pk(p1[10], p1[11]), pk(p1[12], p1[13]), pk(p1[14], p1[15])};
    s16x4 vlo[8], vhi[8];
#pragma unroll
    for (int j = 0; j < 8; ++j) { vlo[j] = vtr(vp + (j >> 2) * 4096 + (j & 3) * 1024); vhi[j] = vtr(vp + (j >> 2) * 4096 + (j & 3) * 1024 + 512); }
    __builtin_amdgcn_sched_barrier(0);
#pragma unroll
    for (int j = 0; j < 8; ++j) { const s16x4 lo = vlo[j], hh = vhi[j];
        o[j >> 2] = __builtin_amdgcn_mfma_f32_32x32x16_bf16(__builtin_bit_cast(bf16x8, pw[j & 3]), (bf16x8){lo[0], lo[1], lo[2], lo[3], hh[0], hh[1], hh[2], hh[3]}, o[j >> 2], 0, 0, 0); }
}
__device__ __forceinline__ void scale_o(f32x16 (&o)[2], const Ctx& c, float f) {
    if (c.hi == 0) c.wsf[c.r32] = f;
#pragma unroll
    for (int g4 = 0; g4 < 4; ++g4) { const f32x4 w = *(const LAS f32x4*)(c.wsf + 8 * g4 + 4 * c.hi);
#pragma unroll
        for (int j = 0; j < 4; ++j) { o[0][4 * g4 + j] *= w[j]; o[1][4 * g4 + j] *= w[j]; } }
}
template <bool FIRST>
__device__ __forceinline__ void acc_y(const f32x16 (&o)[2], const Ctx& c, float f) {
    if (c.hi == 0) c.wsf[c.r32] = f;
    LAS float* stg = (LAS float*)(c.lds + L_OST + c.wid * 8192);
#pragma unroll
    for (int g4 = 0; g4 < 4; ++g4) { const f32x4 w = *(const LAS f32x4*)(c.wsf + 8 * g4 + 4 * c.hi);
#pragma unroll
        for (int j = 0; j < 4; ++j) { const int q = 8 * g4 + 4 * c.hi + j; LAS float* y0 = stg + q * 64 + c.r32;
            if (FIRST) { y0[0] = o[0][4 * g4 + j] * w[j]; y0[32] = o[1][4 * g4 + j] * w[j]; } else { y0[0] += o[0][4 * g4 + j] * w[j]; y0[32] += o[1][4 * g4 + j] * w[j]; } } }
}
template <bool HAS_O>
__device__ __forceinline__ void softmax_tile(f32x16& p0, f32x16& p1, float& mref, float& l, f32x16 (&o)[2], const Ctx& c, const bool alive = true) {
    float rm = fmaxf(p0[0], p1[0]);
#pragma unroll
    for (int r = 1; r < 16; ++r) rm = __builtin_fmaxf(__builtin_fmaxf(rm, p0[r]), p1[r]);
    rm = alive ? swap_max(rm) * C2 : -INFINITY;
    const bool need = rm > mref + THR;
    if (__any(need)) {
        const float mnew = need ? rm : mref, f = __builtin_amdgcn_exp2f(mref - mnew);
        l *= f; mref = mnew;
        if constexpr (HAS_O) scale_o(o, c, f);
    }
    const float nm = alive ? -mref : -INFINITY;
#pragma unroll
    for (int r = 0; r < 16; ++r) { p0[r] = __builtin_amdgcn_exp2f(__builtin_fmaf(p0[r], C2, nm)); p1[r] = __builtin_amdgcn_exp2f(__builtin_fmaf(p1[r], C2, nm)); }
    const f32x16 ps = p0 + p1;
    l += ((ps[0] + ps[1]) + (ps[2] + ps[3])) + ((ps[4] + ps[5]) + (ps[6] + ps[7])) + (((ps[8] + ps[9]) + (ps[10] + ps[11])) + ((ps[12] + ps[13]) + (ps[14] + ps[15])));
}

__device__ __forceinline__ int kslot_off(int s) { return L_K + ((s & 1) << 13) + ((s >> 1) << 15); }
__device__ __forceinline__ int vslot_off(int s) { return L_V + ((s & 1) << 13) + ((s >> 1) << 15); }
static_assert(L_K == 0 && L_V == 16384 && L_IMP == 32768, "slot maps");
__device__ __forceinline__ void dma16(const char* base, unsigned off, const Ctx& c, int ldsoff) {
    __builtin_amdgcn_global_load_lds((const unsigned*)(base + off), (LAS unsigned*)(c.lds + ldsoff + c.wid * 1024), 16, 0, 0); }
template <int NS, class FB>
__device__ __forceinline__ void tile_loop(int nt, const bf16_t* kb, const bf16_t* vb, int pitch, const Ctx& c, const bf16x8 (&qr)[4], FB body) {
    const size_t ts = (size_t)64 * pitch;
    constexpr int KD = NS == 4 ? 3 : 2, VD = NS == 4 ? 2 : 1;
    const LAS unsigned char* kq = c.lds + c.r32 * 128;
    const int vq = ((c.lane >> 4) & 1) * 32 + (c.lane & 3) * 8 + (4 * c.hi + ((c.lane & 15) >> 2)) * 64;
    const char* const kB = pg8::uni((const char*)kb); const char* const vB = pg8::uni((const char*)vb); const unsigned tsb = (unsigned)ts * 2u;
    unsigned kl, vl;
    { const int key = c.tid >> 3, cp = c.tid & 7; kl = (unsigned)(key * pitch + (cp ^ ((key >> 1) & 7)) * 8) * 2u;
      const int w = c.tid >> 6, ln = c.tid & 63; vl = (unsigned)((16 * (w & 3) + (ln >> 2)) * pitch + (w >> 2) * 32 + (ln & 3) * 8) * 2u; }
    dma16(kB, kl, c, kslot_off(0)); dma16(vB, vl, c, vslot_off(0));
    if (nt > 1) dma16(kB, tsb + kl, c, kslot_off(1));
    asm volatile("s_waitcnt vmcnt(0)" ::: "memory"); __builtin_amdgcn_s_barrier(); asm volatile("" ::: "memory");
    if (NS == 4) { if (nt > 2) dma16(kB, 2u * tsb + kl, c, kslot_off(2)); if (nt > 1) dma16(vB, tsb + vl, c, vslot_off(1)); }
    f32x16 pa0, pa1, pb0, pb1;
    qkt(pa0, pa1, kq + kslot_off(0), qr, c.ksw);
    asm volatile("s_waitcnt lgkmcnt(0)" ::: "memory"); __builtin_amdgcn_s_barrier(); asm volatile("" ::: "memory");
#define NSA_STEP(t, C0, C1, N0, N1, NEXT) do { \
        const bool ik = (t) + KD < nt, iv = (t) + VD < nt; \
        if (ik) dma16(kB, (unsigned)((t) + KD) * tsb + kl, c, kslot_off(((t) + KD) & (NS - 1))); \
        if (iv) dma16(vB, (unsigned)((t) + VD) * tsb + vl, c, vslot_off(((t) + VD) & (NS - 1))); \
        if (NEXT) qkt(N0, N1, kq + kslot_off(((t) + 1) & (NS - 1)), qr, c.ksw); \
        body((t), c.lds + vslot_off((t) & (NS - 1)) + vq, C0, C1); \
        if (NS == 4 && ik) asm volatile("s_waitcnt vmcnt(2) lgkmcnt(0)" ::: "memory"); \
        else if (NS == 4 && iv) asm volatile("s_waitcnt vmcnt(1) lgkmcnt(0)" ::: "memory"); \
        else asm volatile("s_waitcnt vmcnt(0) lgkmcnt(0)" ::: "memory"); \
        __builtin_amdgcn_s_barrier(); asm volatile("" ::: "memory"); } while (0)
    int tt = 0;
    for (; tt + 2 < nt; tt += 2) { NSA_STEP(tt, pa0, pa1, pb0, pb1, true); NSA_STEP(tt + 1, pb0, pb1, pa0, pa1, true); }
    if (tt + 2 == nt) { NSA_STEP(tt, pa0, pa1, pb0, pb1, true); NSA_STEP(tt + 1, pb0, pb1, pa0, pa1, false); }
    else { NSA_STEP(tt, pa0, pa1, pb0, pb1, false); }
#undef NSA_STEP
}
__device__ __forceinline__ void tile_loop4_prefetch(int nt, const bf16_t* kb, const bf16_t* vb, const Ctx& c) {
    constexpr int pitch = 64; const unsigned tsb = 64u * pitch * 2u;
    const char* const kB = pg8::uni((const char*)kb); const char* const vB = pg8::uni((const char*)vb);
    const int key = c.tid >> 3, cp = c.tid & 7; const unsigned kl = (unsigned)(key * pitch + (cp ^ ((key >> 1) & 7)) * 8) * 2u;
    const int w = c.tid >> 6, ln = c.tid & 63; const unsigned vl = (unsigned)((16 * (w & 3) + (ln >> 2)) * pitch + (w >> 2) * 32 + (ln & 3) * 8) * 2u;
    dma16(kB, kl, c, kslot_off(0)); dma16(vB, vl, c, vslot_off(0));
    if (nt > 1) dma16(kB, tsb + kl, c, kslot_off(1));
}
template <bool PRE = false, class FM>
__device__ __forceinline__ void tile_loop4(int nt, const bf16_t* kb, const bf16_t* vb, const Ctx& c, const bf16x8 (&qr)[4], float& mref, float& l, f32x16 (&o)[2], FM maskf) {
    constexpr int pitch = 64; const unsigned tsb = 64u * pitch * 2u;
    const LAS unsigned char* kq = c.lds + c.r32 * 128;
    const int vq = ((c.lane >> 4) & 1) * 32 + (c.lane & 3) * 8 + (4 * c.hi + ((c.lane & 15) >> 2)) * 64;
    const char* const kB = pg8::uni((const char*)kb); const char* const vB = pg8::uni((const char*)vb);
    unsigned kl, vl;
    { const int key = c.tid >> 3, cp = c.tid & 7; kl = (unsigned)(key * pitch + (cp ^ ((key >> 1) & 7)) * 8) * 2u;
      const int w = c.tid >> 6, ln = c.tid & 63; vl = (unsigned)((16 * (w & 3) + (ln >> 2)) * pitch + (w >> 2) * 32 + (ln & 3) * 8) * 2u; }
    if (!PRE) { dma16(kB, kl, c, kslot_off(0)); dma16(vB, vl, c, vslot_off(0));
        if (nt > 1) dma16(kB, tsb + kl, c, kslot_off(1)); }
    asm volatile("s_waitcnt vmcnt(0)" ::: "memory"); __builtin_amdgcn_s_barrier(); asm volatile("" ::: "memory");
    if (nt > 2) dma16(kB, 2u * tsb + kl, c, kslot_off(2));
    if (nt > 1) dma16(vB, tsb + vl, c, vslot_off(1));
    f32x16 pa0, pa1, pb0, pb1;
    qkt(pa0, pa1, kq + kslot_off(0), qr, c.ksw);
    asm volatile("s_waitcnt lgkmcnt(0)" ::: "memory"); __builtin_amdgcn_s_barrier(); asm volatile("" ::: "memory");
#define SB() __builtin_amdgcn_sched_barrier(0)
#define NSA_STEP4(t, C0, C1, N0, N1, NEXT) do { \
        const bool ik = (t) + 3 < nt, iv = (t) + 2 < nt; \
        if (ik) dma16(kB, (unsigned)((t) + 3) * tsb + kl, c, kslot_off(((t) + 3) & 3)); \
        if (iv) dma16(vB, (unsigned)((t) + 2) * tsb + vl, c, vslot_off(((t) + 2) & 3)); \
        bf16x8 kf[4]; s16x4 vlo[4], vhi[4], wlo[4], whi[4]; \
        const LAS unsigned char* kp_ = kq + kslot_off(((t) + 1) & 3); \
        if (NEXT) { _Pragma("unroll") for (int d0 = 0; d0 < 2; ++d0) { const int co = ((2 * d0) ^ c.ksw) * 16; kf[2 * d0] = *(const LAS bf16x8*)(kp_ + co); kf[2 * d0 + 1] = *(const LAS bf16x8*)(kp_ + 4096 + co); } } \
        const LAS unsigned char* vp_ = c.lds + vslot_off((t) & 3) + vq; \
        vlo[0] = vtra<0>(vp_); vhi[0] = vtra<512>(vp_); vlo[1] = vtra<1024>(vp_); vhi[1] = vtra<1536>(vp_); vlo[2] = vtra<2048>(vp_); vhi[2] = vtra<2560>(vp_); vlo[3] = vtra<3072>(vp_); vhi[3] = vtra<3584>(vp_); \
        SB(); \
        const bool alive = maskf((t), C0, C1); \
        float rm = fmaxf(C0[0], C1[0]); \
        _Pragma("unroll") for (int r = 1; r < 16; ++r) rm = __builtin_fmaxf(__builtin_fmaxf(rm, C0[r]), C1[r]); \
        rm = alive ? swap_max(rm) * C2 : -INFINITY; \
        const bool need = rm > mref + THR; \
        if (__any(need)) { const float mnew = need ? rm : mref, f = __builtin_amdgcn_exp2f(mref - mnew); l *= f; mref = mnew; scale_o(o, c, f); } \
        const float nm = alive ? -mref : -INFINITY; \
        asm volatile("s_waitcnt lgkmcnt(0)" ::: "memory"); SB(); \
        if (NEXT) { N0 = __builtin_amdgcn_mfma_f32_32x32x16_bf16(kf[0], qr[0], (f32x16){0.f,0.f,0.f,0.f,0.f,0.f,0.f,0.f,0.f,0.f,0.f,0.f,0.f,0.f,0.f,0.f}, 0, 0, 0); } \
        _Pragma("unroll") for (int r = 0; r < 4; ++r) C0[r] = __builtin_amdgcn_exp2f(__builtin_fmaf(C0[r], C2, nm)); SB(); \
        if (NEXT) { N1 = __builtin_amdgcn_mfma_f32_32x32x16_bf16(kf[1], qr[0], (f32x16){0.f,0.f,0.f,0.f,0.f,0.f,0.f,0.f,0.f,0.f,0.f,0.f,0.f,0.f,0.f,0.f}, 0, 0, 0); } \
        _Pragma("unroll") for (int r = 4; r < 8; ++r) C0[r] = __builtin_amdgcn_exp2f(__builtin_fmaf(C0[r], C2, nm)); SB(); \
        if (NEXT) { N0 = __builtin_amdgcn_mfma_f32_32x32x16_bf16(kf[2], qr[1], N0, 0, 0, 0); } \
        _Pragma("unroll") for (int r = 8; r < 12; ++r) C0[r] = __builtin_amdgcn_exp2f(__builtin_fmaf(C0[r], C2, nm)); SB(); \
        if (NEXT) { N1 = __builtin_amdgcn_mfma_f32_32x32x16_bf16(kf[3], qr[1], N1, 0, 0, 0); } \
        SB(); \
        if (NEXT) { _Pragma("unroll") for (int d0 = 2; d0 < 4; ++d0) { const int co = ((2 * d0) ^ c.ksw) * 16; kf[2 * d0 - 4] = *(const LAS bf16x8*)(kp_ + co); kf[2 * d0 - 3] = *(const LAS bf16x8*)(kp_ + 4096 + co); } }        \
        SB(); \
        _Pragma("unroll") for (int r = 12; r < 16; ++r) C0[r] = __builtin_amdgcn_exp2f(__builtin_fmaf(C0[r], C2, nm)); SB(); \
        if (NEXT) { N0 = __builtin_amdgcn_mfma_f32_32x32x16_bf16(kf[0], qr[2], N0, 0, 0, 0); } \
        _Pragma("unroll") for (int r = 0; r < 4; ++r) C1[r] = __builtin_amdgcn_exp2f(__builtin_fmaf(C1[r], C2, nm)); SB(); \
        if (NEXT) { N1 = __builtin_amdgcn_mfma_f32_32x32x16_bf16(kf[1], qr[2], N1, 0, 0, 0); } \
        _Pragma("unroll") for (int r = 4; r < 8; ++r) C1[r] = __builtin_amdgcn_exp2f(__builtin_fmaf(C1[r], C2, nm)); SB(); \
        if (NEXT) { N0 = __builtin_amdgcn_mfma_f32_32x32x16_bf16(kf[2], qr[3], N0, 0, 0, 0); } \
        _Pragma("unroll") for (int r = 8; r < 12; ++r) C1[r] = __builtin_amdgcn_exp2f(__builtin_fmaf(C1[r], C2, nm)); SB(); \
        if (NEXT) { N1 = __builtin_amdgcn_mfma_f32_32x32x16_bf16(kf[3], qr[3], N1, 0, 0, 0); } \
        _Pragma("unroll") for (int r = 12; r < 16; ++r) C1[r] = __builtin_amdgcn_exp2f(__builtin_fmaf(C1[r], C2, nm)); SB(); \
        wlo[0] = vtra<4096>(vp_); whi[0] = vtra<4608>(vp_); wlo[1] = vtra<5120>(vp_); whi[1] = vtra<5632>(vp_); wlo[2] = vtra<6144>(vp_); whi[2] = vtra<6656>(vp_); wlo[3] = vtra<7168>(vp_); whi[3] = vtra<7680>(vp_);        \
        SB(); \
        { const f32x16 ps = C0 + C1; \
          l += ((ps[0] + ps[1]) + (ps[2] + ps[3])) + ((ps[4] + ps[5]) + (ps[6] + ps[7])) + (((ps[8] + ps[9]) + (ps[10] + ps[11])) + ((ps[12] + ps[13]) + (ps[14] + ps[15]))); } \
        { u32x4 pw[4]; \
          pw[0] = (u32x4){pk(C0[0], C0[1]), pk(C0[2], C0[3]), pk(C0[4], C0[5]), pk(C0[6], C0[7])}; pw[1] = (u32x4){pk(C0[8], C0[9]), pk(C0[10], C0[11]), pk(C0[12], C0[13]), pk(C0[14], C0[15])}; \
          pw[2] = (u32x4){pk(C1[0], C1[1]), pk(C1[2], C1[3]), pk(C1[4], C1[5]), pk(C1[6], C1[7])}; pw[3] = (u32x4){pk(C1[8], C1[9]), pk(C1[10], C1[11]), pk(C1[12], C1[13]), pk(C1[14], C1[15])}; \
          SB(); asm volatile("s_waitcnt lgkmcnt(0)" ::: "memory"); SB(); \
          _Pragma("unroll") for (int ks = 0; ks < 4; ++ks) { const s16x4 lo_ = vlo[ks], hh_ = vhi[ks]; \
              o[0] = __builtin_amdgcn_mfma_f32_32x32x16_bf16(__builtin_bit_cast(bf16x8, pw[ks]), (bf16x8){lo_[0], lo_[1], lo_[2], lo_[3], hh_[0], hh_[1], hh_[2], hh_[3]}, o[0], 0, 0, 0); } \
          _Pragma("unroll") for (int ks = 0; ks < 4; ++ks) { const s16x4 lo_ = wlo[ks], hh_ = whi[ks]; \
              o[1] = __builtin_amdgcn_mfma_f32_32x32x16_bf16(__builtin_bit_cast(bf16x8, pw[ks]), (bf16x8){lo_[0], lo_[1], lo_[2], lo_[3], hh_[0], hh_[1], hh_[2], hh_[3]}, o[1], 0, 0, 0); } } \
        if (ik) asm volatile("s_waitcnt vmcnt(2) lgkmcnt(0)" ::: "memory"); \
        else if (iv) asm volatile("s_waitcnt vmcnt(1) lgkmcnt(0)" ::: "memory"); \
        else asm volatile("s_waitcnt vmcnt(0) lgkmcnt(0)" ::: "memory"); \
        __builtin_amdgcn_s_barrier(); asm volatile("" ::: "memory"); } while (0)
    int tt = 0;
    for (; tt + 2 < nt; tt += 2) { NSA_STEP4(tt, pa0, pa1, pb0, pb1, true); NSA_STEP4(tt + 1, pb0, pb1, pa0, pa1, true); }
    if (tt + 2 == nt) { NSA_STEP4(tt, pa0, pa1, pb0, pb1, true); NSA_STEP4(tt + 1, pb0, pb1, pa0, pa1, false); }
    else { NSA_STEP4(tt, pa0, pa1, pb0, pb1, false); }
#undef NSA_STEP4
#undef SB
}
__device__ __forceinline__ void unit(int b, int g, int i, const bf16_t* proj, const bf16_t* kvc, const float* gates, const bf16_t* kc, const bf16_t* vc, bf16_t* ya, LAS unsigned char* lds) {
    Ctx c; { int t_ = threadIdx.x; asm volatile("" : "+v"(t_)); c.tid = t_; }
    c.lane = c.tid & 63; c.wid = __builtin_amdgcn_readfirstlane(c.tid >> 6); c.r32 = c.lane & 31; c.hi = c.lane >> 5; c.lds = lds;
    c.wsf = (LAS float*)(lds + L_WSF + c.wid * 256);
    c.ksw = ((c.r32 >> 1) & 7) ^ c.hi;
    const int tokl = 8 * c.wid + (c.r32 >> 2), h = c.r32 & 3, t = 64 * i + tokl;
    const size_t mrow = (size_t)b * T + t;
    LAS float* imp = (LAS float*)(lds + L_IMP);
    for (int k = c.tid; k < 64 * IMP_LD; k += 512) imp[k] = 0.f;
    bf16x8 qr[4];
#pragma unroll
    for (int d0 = 0; d0 < 4; ++d0) qr[d0] = *(const bf16x8*)(proj + mrow * LDP + C_Q + (g * 4 + h) * 64 + d0 * 16 + c.hi * 8);
    const float* gl = gates + mrow * 32 + (g * 4 + h) * 3;
    const float gt0 = sigmoidf_(gl[0]), gt1 = sigmoidf_(gl[1]), gt2 = sigmoidf_(gl[2]);
    const size_t tsz = (size_t)M * 128, bgo = (size_t)(b * 2 + g) * T * 64;
    const bf16_t* kslc = kvc + 2 * tsz + bgo; const bf16_t* vslc = kvc + 3 * tsz + bgo; const bf16_t* kwin = kvc + 4 * tsz + bgo; const bf16_t* vwin = kvc + 5 * tsz + bgo;
    const bf16_t* kcb = kc + (size_t)(b * 2 + g) * 512 * 64; const bf16_t* vcb = vc + (size_t)(b * 2 + g) * 512 * 64;
    f32x16 o[2];
    __syncthreads();
    const int ncv = (t >= 31) ? min((t - 31) / 16 + 1, 511) : 0;
    const int ntc = (4 * i + 3 + 63) / 64;
    float mref = -1e30f, l = 0.f;
    tile_loop<2>(ntc, kcb, vcb, 64, c, qr, [&](int tt, const LAS unsigned char* vp, f32x16& p0, f32x16& p1) {
        const int kb = 64 * tt + 4 * c.hi;
        if (!__all(64 * tt + 64 <= ncv)) {
#pragma unroll
            for (int r = 0; r < 16; ++r) { const int key = kb + (r & 3) + 8 * (r >> 2); if (key >= ncv) p0[r] = -INFINITY; if (key + 32 >= ncv) p1[r] = -INFINITY; }
        }
        softmax_tile<false>(p0, p1, mref, l, o, c);
    });
    {
        const float lt = swap_sum(l), invl = lt > 0.f ? 1.f / lt : 0.f;
#pragma unroll
        for (int r = 0; r < 16; ++r) { o[0][r] = 0.f; o[1][r] = 0.f; }
        tile_loop<2>(ntc, kcb, vcb, 64, c, qr, [&](int tt, const LAS unsigned char* vp, f32x16& p0, f32x16& p1) {
            const int kb = 64 * tt + 4 * c.hi;
#pragma unroll
            for (int r = 0; r < 16; ++r) { const int key = kb + (r & 3) + 8 * (r >> 2);
                p0[r] = (key >= ncv) ? 0.f : __builtin_amdgcn_exp2f(__builtin_fmaf(p0[r], C2, -mref)) * invl;
                p1[r] = (key + 32 >= ncv) ? 0.f : __builtin_amdgcn_exp2f(__builtin_fmaf(p1[r], C2, -mref)) * invl; }
#pragma unroll
            for (int sub = 0; sub < 2; ++sub)
#pragma unroll
                for (int g4 = 0; g4 < 4; ++g4) {
                    const f32x16& pp = sub ? p1 : p0;
                    float av = 2.f * (pp[4 * g4] + pp[4 * g4 + 1] + pp[4 * g4 + 2]) + pp[4 * g4 + 3], bv = pp[4 * g4 + 3];
                    av += __shfl_xor(av, 1); av += __shfl_xor(av, 2); bv += __shfl_xor(bv, 1); bv += __shfl_xor(bv, 2);
                    if (h == 0) { const int bk = 16 * tt + 8 * sub + 2 * g4 + c.hi; LAS float* ip = imp + tokl * IMP_LD + bk;
                        __hip_atomic_fetch_add(ip, av, __ATOMIC_RELAXED, __HIP_MEMORY_SCOPE_WORKGROUP); __hip_atomic_fetch_add(ip + 1, bv, __ATOMIC_RELAXED, __HIP_MEMORY_SCOPE_WORKGROUP); }
                }
            pv(o, vp, p0, p1);
        });
        acc_y<true>(o, c, gt0);
    }
    tile_loop4_prefetch(i + 1, kslc, vslc, c);
    unsigned mw0, mw1, mw2, mw3;
    if (i < 16) { mw0 = (1u << (i + 1)) - 1u; mw1 = 0u; mw2 = 0u; mw3 = 0u; }
    else {
        LAS unsigned* selm = (LAS unsigned*)(lds + L_SEL);
        for (int tl = 0; tl < 8; tl += 2) {
            const int tkA = 8 * c.wid + tl, tkB = tkA + 1;
            float v0A = imp[tkA * IMP_LD + c.lane], v1A = imp[tkA * IMP_LD + 64 + c.lane], v0B = imp[tkB * IMP_LD + c.lane], v1B = imp[tkB * IMP_LD + 64 + c.lane];
            const bool ok0 = (c.lane >= 1 && c.lane <= i - 2), ok1 = (c.lane + 64 <= i - 2);
            v0A = ok0 ? v0A : -1.f; v1A = ok1 ? v1A : -1.f; v0B = ok0 ? v0B : -1.f; v1B = ok1 ? v1B : -1.f;
            unsigned long long f0 = 1ull, f1 = 0ull;
            if (i - 1 < 64) f0 |= 1ull << (i - 1); else f1 |= 1ull << (i - 1 - 64);
            if (i < 64) f0 |= 1ull << i; else f1 |= 1ull << (i - 64);
            const int k0A = __float_as_int(v0A), k1A = __float_as_int(v1A), k0B = __float_as_int(v0B), k1B = __float_as_int(v1B);
            int KA = 0, KB = 0;
#pragma unroll
            for (int bit = 30; bit >= 0; --bit) { const int trA = KA | (1 << bit), trB = KB | (1 << bit);
                const int cA = __popcll(__ballot(k0A >= trA)) + __popcll(__ballot(k1A >= trA)), cB = __popcll(__ballot(k0B >= trB)) + __popcll(__ballot(k1B >= trB));
                if (cA >= 13) KA = trA; if (cB >= 13) KB = trB; }
#pragma unroll
            for (int q = 0; q < 2; ++q) { const int K = q ? KB : KA, k0 = q ? k0B : k0A, k1 = q ? k1B : k1A, tk = q ? tkB : tkA;
                unsigned long long s0 = f0, s1 = f1;
                const unsigned long long g0 = __ballot(k0 > K), g1 = __ballot(k1 > K);
                unsigned long long e0 = __ballot(k0 == K), e1 = __ballot(k1 == K);
                s0 |= g0; s1 |= g1;
                int needn = 13 - (__popcll(g0) + __popcll(g1));
                while (needn > 0 && (e0 | e1)) { if (e0) { s0 |= e0 & (~e0 + 1ull); e0 &= e0 - 1ull; } else { s1 |= e1 & (~e1 + 1ull); e1 &= e1 - 1ull; } --needn; }
                if (c.lane == 0) { selm[tk * 4 + 0] = (unsigned)s0; selm[tk * 4 + 1] = (unsigned)(s0 >> 32); selm[tk * 4 + 2] = (unsigned)s1; selm[tk * 4 + 3] = (unsigned)(s1 >> 32); } }
        }
        const u32x4 mm = *(const LAS u32x4*)(selm + tokl * 4); mw0 = mm.x; mw1 = mm.y; mw2 = mm.z; mw3 = mm.w;
    }
    {
        mref = -1e30f; l = 0.f;
#pragma unroll
        for (int r = 0; r < 16; ++r) { o[0][r] = 0.f; o[1][r] = 0.f; }
        auto selbit = [&](int tt) { const unsigned wsel = tt < 32 ? mw0 : (tt < 64 ? mw1 : (tt < 96 ? mw2 : mw3)); return (bool)((wsel >> (tt & 31)) & 1u); };
        tile_loop4<true>(i + 1, kslc, vslc, c, qr, mref, l, o, [&](int tt, f32x16& p0, f32x16& p1) {
            if (tt == i) {
                asm volatile("" ::: "memory");
#pragma unroll
                for (int r = 0; r < 16; ++r) { const int kl = 4 * c.hi + (r & 3) + 8 * (r >> 2); p0[r] = kl <= tokl ? p0[r] : -INFINITY; p1[r] = kl + 32 <= tokl ? p1[r] : -INFINITY; }
            }
            return selbit(tt);
        });
        const float lt = swap_sum(l);
        acc_y<false>(o, c, lt > 0.f ? gt1 / lt : 0.f);
    }
    {
        mref = -1e30f; l = 0.f;
#pragma unroll
        for (int r = 0; r < 16; ++r) { o[0][r] = 0.f; o[1][r] = 0.f; }
        const int j0 = i >= 8 ? i - 8 : 0, ntw = i - j0 + 1;
        tile_loop4(ntw, kwin + (size_t)j0 * 64 * 64, vwin + (size_t)j0 * 64 * 64, c, qr, mref, l, o, [&](int tt, f32x16& p0, f32x16& p1) {
            const int jt = j0 + tt;
            if (jt == i) {
#pragma unroll
                for (int r = 0; r < 16; ++r) { const int kl = 4 * c.hi + (r & 3) + 8 * (r >> 2); if (kl > tokl) p0[r] = -INFINITY; if (kl + 32 > tokl) p1[r] = -INFINITY; }
            } else if (jt == i - 8) {
#pragma unroll
                for (int r = 0; r < 16; ++r) { const int kl = 4 * c.hi + (r & 3) + 8 * (r >> 2); if (kl <= tokl) p0[r] = -INFINITY; if (kl + 32 <= tokl) p1[r] = -INFINITY; }
            }
            return true;
        });
        const float lt = swap_sum(l);
        acc_y<false>(o, c, lt > 0.f ? gt2 / lt : 0.f);
    }
    {
        const LAS float* stg = (const LAS float*)(lds + L_OST + c.wid * 8192);
#pragma unroll
        for (int k = 0; k < 4; ++k) { const int ci = c.lane + 64 * k, tl = ci >> 5, wi = ci & 31;
            const f32x4 a0 = *(const LAS f32x4*)(stg + ci * 8), a1 = *(const LAS f32x4*)(stg + ci * 8 + 4);
            *(u32x4*)(ya + ((size_t)b * T + 64 * i + 8 * c.wid + tl) * 512 + g * 256 + wi * 8) = (u32x4){pk(a0[0], a0[1]), pk(a0[2], a0[3]), pk(a1[0], a1[1]), pk(a1[2], a1[3])}; }
    }
}
__device__ __forceinline__ void phase(const bf16_t* proj, const bf16_t* kvc, const float* gates, const bf16_t* kc, const bf16_t* vc, bf16_t* ya, LAS unsigned char* lds, int bid, int nb) {
    const int per = nb == 256 ? 4 : (1024 + nb - 1) / nb;
#pragma unroll 1
    for (int k = 0; k < per; ++k) {
        int bg, i;
        if (nb == 256) { const int v = (bid & 7) * 32 + (bid >> 3), s5 = v & 31; bg = v >> 5; i = k == 0 ? s5 : (k == 1 ? 63 - s5 : (k == 2 ? 64 + s5 : 127 - s5)); }
        else { const int u = bid + k * nb; if (u >= 1024) break; bg = u >> 7; i = 127 - (u & 127); }
        unit(bg >> 1, bg & 1, i, proj, kvc, gates, kc, vc, ya, lds);
    }
}
}

namespace mls {
using nsa::bf16x8; using nsa::s16x4; using nsa::f32x16; using nsa::u32x4; using nsa::vtr; using nsa::pk; using nsa::swap_sum;
constexpr int XLD = 136;
constexpr int L_XC = 0, L_XM = 17408, L_Q = 34816, L_K = 51200, L_KW = 67584, L_V = 83968, L_EA = 100352, L_WC = L_EA + 256  , L1_END = L_WC + 2560 * 4;
__device__ __forceinline__ int vblk(int s, int e) { return ((e >> 5) * 4 + (s >> 4)) * 1024 + (s & 15) * 64 + (e & 31) * 2; }
__device__ __forceinline__ f32x16 zero16() { return (f32x16){0.f,0.f,0.f,0.f,0.f,0.f,0.f,0.f,0.f,0.f,0.f,0.f,0.f,0.f,0.f,0.f}; }

struct P1 { const bf16_t* proj; const float* gates; const float* w_conv; const float* b_conv; const float* b_i; const float* b_f; const bf16_t* wT;
            bf16_t* xc; bf16_t* mq; bf16_t* mk; bf16_t* mv; bf16_t* U; float* un; float* gB; float* gG; float* BL; };
__device__ __forceinline__ void ml1_unit(const P1& p, int b, int h, int c, LAS unsigned char* lds) {
    int t_ = threadIdx.x; asm volatile("" : "+v"(t_)); const int tid = t_, lane = tid & 63, wid = __builtin_amdgcn_readfirstlane(tid >> 6), r32 = lane & 31, hi = lane >> 5;
    const size_t m0 = (size_t)b * T + 64 * c; const int bh = b * 4 + h, unit = bh * 128 + c;
    __syncthreads();
    { const int t = tid >> 3, d0 = (tid & 7) * 16; float acc[16];
#pragma unroll
      for (int j = 0; j < 16; ++j) acc[j] = ((const LAS float*)(lds + L_WC))[2048 + h * 128 + d0 + j];
      u32x4 xm0 = (u32x4){0u, 0u, 0u, 0u}, xm1 = xm0;
#pragma unroll
      for (int r = 0; r < 4; ++r) { const int tt = 64 * c + t - 3 + r; u32x4 a0 = (u32x4){0u, 0u, 0u, 0u}, a1 = a0;
          if (tt >= 0) { const bf16_t* src = p.proj + ((size_t)b * T + tt) * LDP + C_XM + h * 128 + d0; a0 = *(const u32x4*)src; a1 = *(const u32x4*)(src + 8); }
          if (r == 3) { xm0 = a0; xm1 = a1; }
          f32x4 v0, v1, v2, v3; pg8::unpack8(a0, v0, v1); pg8::unpack8(a1, v2, v3);
          const LAS float* wc = (const LAS float*)(lds + L_WC) + r * 512 + h * 128 + d0;
#pragma unroll
          for (int j = 0; j < 4; ++j) { acc[j] += v0[j] * wc[j]; acc[4 + j] += v1[j] * wc[4 + j]; acc[8 + j] += v2[j] * wc[8 + j]; acc[12 + j] += v3[j] * wc[12 + j]; } }
#pragma unroll
      for (int j = 0; j < 16; ++j) acc[j] = acc[j] / (1.f + __expf(-acc[j]));
      const u32x4 c0 = (u32x4){pk(acc[0], acc[1]), pk(acc[2], acc[3]), pk(acc[4], acc[5]), pk(acc[6], acc[7])}, c1 = (u32x4){pk(acc[8], acc[9]), pk(acc[10], acc[11]), pk(acc[12], acc[13]), pk(acc[14], acc[15])};
      *(LAS u32x4*)(lds + L_XC + (t * XLD + d0) * 2) = c0; *(LAS u32x4*)(lds + L_XC + (t * XLD + d0 + 8) * 2) = c1;
      *(LAS u32x4*)(lds + L_XM + (t * XLD + d0) * 2) = xm0; *(LAS u32x4*)(lds + L_XM + (t * XLD + d0 + 8) * 2) = xm1;
      bf16_t* xo = p.xc + (m0 + t) * 512 + h * 128 + d0; *(u32x4*)xo = c0; *(u32x4*)(xo + 8) = c1; }
    if (wid == 0) {
        const float fp = p.gates[(m0 + lane) * 32 + 28 + h] + p.b_f[h], li = p.gates[(m0 + lane) * 32 + 24 + h] + p.b_i[h];
        float bs = fminf(fp, 0.f) - log1pf(__expf(-fabsf(fp)));
#pragma unroll
        for (int o = 1; o < 64; o <<= 1) { const float v = __shfl_up(bs, o); if (lane >= o) bs += v; }
        const float bl = __shfl(bs, 63);
        ((LAS float*)(lds + L_EA))[lane] = __expf(bl - bs + li);
        p.gB[(size_t)bh * T + 64 * c + lane] = bs; p.gG[(size_t)bh * T + 64 * c + lane] = li - bs; if (lane == 0) p.BL[unit] = bl;
    }
    __syncthreads();
    { const int tt = wid & 1, et = wid >> 1;
      f32x16 aq = zero16(), ak = zero16(), av = zero16();
      const LAS unsigned char* xcp = lds + L_XC + ((32 * tt + r32) * XLD + 8 * hi) * 2; const LAS unsigned char* xmp = lds + L_XM + ((32 * tt + r32) * XLD + 8 * hi) * 2;
      const bf16_t* wq = p.wT + (size_t)(0 * 4 + h) * 16384 + (size_t)(et * 512 + lane) * 8; const bf16_t* wk = wq + (size_t)4 * 128 * 128; const bf16_t* wv = wk + (size_t)4 * 128 * 128;
#pragma unroll
      for (int ks = 0; ks < 8; ++ks) {
          const bf16x8 xa = *(const LAS bf16x8*)(xcp + ks * 32), xb = *(const LAS bf16x8*)(xmp + ks * 32);
          aq = __builtin_amdgcn_mfma_f32_32x32x16_bf16(xa, *(const bf16x8*)(wq + ks * 512), aq, 0, 0, 0);
          ak = __builtin_amdgcn_mfma_f32_32x32x16_bf16(xa, *(const bf16x8*)(wk + ks * 512), ak, 0, 0, 0);
          av = __builtin_amdgcn_mfma_f32_32x32x16_bf16(xb, *(const bf16x8*)(wv + ks * 512), av, 0, 0, 0); }
      const LAS float* ea = (const LAS float*)(lds + L_EA);
#pragma unroll
      for (int r = 0; r < 16; ++r) { const int s = 32 * tt + (r & 3) + 8 * (r >> 2) + 4 * hi, o = vblk(s, 32 * et + r32); const float kk = ak[r] * 0.08838834764831845f;
          *(LAS bf16_t*)(lds + L_Q + o) = f2bf(aq[r]); *(LAS bf16_t*)(lds + L_K + o) = f2bf(kk); *(LAS bf16_t*)(lds + L_KW + o) = f2bf(kk * ea[s]); *(LAS bf16_t*)(lds + L_V + o) = f2bf(av[r]); } }
    __syncthreads();
#pragma unroll
    for (int i2 = 0; i2 < 2; ++i2) { const int cid = tid + 512 * i2, s = cid >> 4, e8 = cid & 15, o = vblk(s, e8 * 8); const size_t go = (m0 + s) * 512 + h * 128 + e8 * 8;
        *(u32x4*)(p.mq + go) = *(const LAS u32x4*)(lds + L_Q + o); *(u32x4*)(p.mk + go) = *(const LAS u32x4*)(lds + L_K + o); *(u32x4*)(p.mv + go) = *(const LAS u32x4*)(lds + L_V + o); }
    { const int dvt = wid >> 1; const int lo_ = ((lane >> 4) & 1) * 32 + (lane & 3) * 8 + (4 * hi + ((lane & 15) >> 2)) * 64;
      bf16_t* Uo = p.U + (size_t)unit * 16384;
#pragma unroll
      for (int j = 0; j < 2; ++j) { const int dkt = 2 * (wid & 1) + j; f32x16 u = zero16();
#pragma unroll
          for (int ks = 0; ks < 4; ++ks) {
              const s16x4 al = vtr(lds + L_V + lo_ + dvt * 4096 + ks * 1024), ah = vtr(lds + L_V + lo_ + dvt * 4096 + ks * 1024 + 512);
              const s16x4 bl = vtr(lds + L_KW + lo_ + dkt * 4096 + ks * 1024), bh2 = vtr(lds + L_KW + lo_ + dkt * 4096 + ks * 1024 + 512);
              u = __builtin_amdgcn_mfma_f32_32x32x16_bf16((bf16x8){al[0], al[1], al[2], al[3], ah[0], ah[1], ah[2], ah[3]}, (bf16x8){bl[0], bl[1], bl[2], bl[3], bh2[0], bh2[1], bh2[2], bh2[3]}, u, 0, 0, 0); }
#pragma unroll
          for (int r = 0; r < 16; ++r) *(LAS bf16_t*)(lds + wid * 4096 + ((r & 3) + 8 * (r >> 2) + 4 * hi) * 128 + (32 * j + r32) * 2) = f2bf(u[r]); }
#pragma unroll
      for (int k = 0; k < 4; ++k) { const int idx = lane + 64 * k, row = idx >> 3, c8 = idx & 7;
          *(u32x4*)(Uo + (32 * dvt + row) * 128 + 64 * (wid & 1) + c8 * 8) = *(const LAS u32x4*)(lds + wid * 4096 + row * 128 + c8 * 16); } }
    if (tid < 128) { float su = 0.f; for (int s = 0; s < 64; ++s) su += bf2f(*(const LAS bf16_t*)(lds + L_KW + vblk(s, tid))); p.un[(size_t)unit * 128 + tid] = su; }
}

__device__ __forceinline__ void ml2(const bf16_t* U, const float* un, const float* BL, bf16_t* Cst, float* nst, float* sm, int sb, int nsb) {
    const int tid = threadIdx.x, lane = tid & 63, w = tid >> 6;
    float* segS = sm; float* segF = sm + 8 * 256;
    pg8::u32x2 ur[16], un_[16]; float fb[16], fn_[16];
#define ML2_LOAD(itx, UR, FB) do { const int bh_ = (itx) >> 6, e0_ = ((itx) & 63) * 256 + 4 * lane; const size_t ub_ = (size_t)bh_ * 128 + 16 * w; \
        _Pragma("unroll") for (int j = 0; j < 16; ++j) { UR[j] = *(const pg8::u32x2*)(U + (ub_ + j) * 16384 + e0_); FB[j] = BL[ub_ + j]; } } while (0)
    if (sb < 16 * 64) ML2_LOAD(sb, ur, fb);
    for (int it = sb; it < 16 * 64; it += nsb) {
        const int bh = it >> 6, e0 = (it & 63) * 256 + 4 * lane; const size_t ub = (size_t)bh * 128 + 16 * w;
        const bool more = it + nsb < 16 * 64;
        if (more) ML2_LOAD(it + nsb, un_, fn_);
        f32x4 S = (f32x4){0.f, 0.f, 0.f, 0.f}; float F = 1.f;
        float fr_[16];
#pragma unroll
        for (int j = 0; j < 16; ++j) fr_[j] = __expf(fb[j]);
#pragma unroll
        for (int j = 0; j < 16; ++j) { const f32x4 x = (f32x4){__uint_as_float(ur[j].x << 16), __uint_as_float(ur[j].x & 0xffff0000u), __uint_as_float(ur[j].y << 16), __uint_as_float(ur[j].y & 0xffff0000u)};
            S = S * fr_[j] + x; F *= fr_[j]; }
        __syncthreads();
        *(f32x4*)(segS + w * 256 + 4 * lane) = S; if (lane == 0) segF[w] = F;
        __syncthreads();
        f32x4 C = (f32x4){0.f, 0.f, 0.f, 0.f};
        for (int sgm = 0; sgm < w; ++sgm) C = C * segF[sgm] + *(const f32x4*)(segS + sgm * 256 + 4 * lane);
#pragma unroll
        for (int j = 0; j < 16; ++j) { const f32x4 x = (f32x4){__uint_as_float(ur[j].x << 16), __uint_as_float(ur[j].x & 0xffff0000u), __uint_as_float(ur[j].y << 16), __uint_as_float(ur[j].y & 0xffff0000u)};
            pg8::u32x2 o; o.x = pg8::cvt_pk_bf16(C[0], C[1]); o.y = pg8::cvt_pk_bf16(C[2], C[3]); *(pg8::u32x2*)(Cst + (ub + j) * 16384 + e0) = o;
            C = C * fr_[j] + x; }
        if (more) {
#pragma unroll
            for (int j = 0; j < 16; ++j) { ur[j] = un_[j]; fb[j] = fn_[j]; } }
    }
#undef ML2_LOAD
    const int gt = (nsb - 1 - sb) * 512 + tid, ngt = nsb * 512;
    for (int g = gt; g < 16 * 128; g += ngt) { const int bh = g >> 7, k = g & 127; float C = 0.f;
#pragma unroll 1
        for (int c0 = 0; c0 < 128; c0 += 32) { float uv[32], fv[32];
#pragma unroll
            for (int j = 0; j < 32; ++j) { const size_t u = (size_t)bh * 128 + c0 + j; uv[j] = un[u * 128 + k]; fv[j] = BL[u]; }
#pragma unroll
            for (int j = 0; j < 32; ++j) { const size_t u = (size_t)bh * 128 + c0 + j; nst[u * 128 + k] = C; C = __expf(fv[j]) * C + uv[j]; } } }
}

constexpr int L3_V = 0, L3_G = 16384  , L3_WSF = 16384 + 1024, L3_H = 16384 + 1024 + 2048  , L3_Q = L3_H + 64 * 132 * 4  ,
              L3_K = L3_Q + 64 * XLD * 2, L3_C = L3_K + 64 * XLD * 2  , L3_END = L3_C + 128 * XLD * 2;
struct P3 { const bf16_t* proj; const bf16_t* xc; const bf16_t* mq; const bf16_t* mk; const bf16_t* mv; const bf16_t* Cst; const float* nst; const float* gB; const float* gG;
            const float* mh_gain; const float* skip; bf16_t* yb; };
__device__ __forceinline__ void ml3_unit(const P3& p, int b, int h, int c, LAS unsigned char* lds) {
    int t_ = threadIdx.x; asm volatile("" : "+v"(t_)); const int tid = t_, lane = tid & 63, wid = __builtin_amdgcn_readfirstlane(tid >> 6), r32 = lane & 31, hi = lane >> 5;
    const size_t m0 = (size_t)b * T + 64 * c; const int bh = b * 4 + h, unit = bh * 128 + c;
    LAS float* gl = (LAS float*)(lds + L3_G);
    __syncthreads();
#pragma unroll
    for (int i2 = 0; i2 < 2; ++i2) { const int cid = tid + 512 * i2, s = cid >> 4, e8 = cid & 15; const size_t go = (m0 + s) * 512 + h * 128 + e8 * 8;
        const u32x4 vv = *(const u32x4*)(p.mv + go), qq = *(const u32x4*)(p.mq + go), kk = *(const u32x4*)(p.mk + go);
        const u32x4 c0 = *(const u32x4*)(p.Cst + (size_t)unit * 16384 + (size_t)cid * 8), c1 = *(const u32x4*)(p.Cst + (size_t)unit * 16384 + (size_t)(cid + 1024) * 8);
        *(LAS u32x4*)(lds + L3_V + vblk(s, e8 * 8)) = vv; *(LAS u32x4*)(lds + L3_Q + (s * XLD + e8 * 8) * 2) = qq; *(LAS u32x4*)(lds + L3_K + (s * XLD + e8 * 8) * 2) = kk;
        *(LAS u32x4*)(lds + L3_C + (s * XLD + e8 * 8) * 2) = c0; *(LAS u32x4*)(lds + L3_C + ((s + 64) * XLD + e8 * 8) * 2) = c1; }
    if (tid < 64) { gl[tid] = p.gB[(size_t)bh * T + 64 * c + tid]; gl[64 + tid] = p.gG[(size_t)bh * T + 64 * c + tid]; }
    else if (tid < 192) gl[128 + tid - 64] = p.nst[(size_t)unit * 128 + tid - 64];
    __syncthreads();
    const int tt = wid & 1, d0 = wid >> 1, t = 32 * tt + r32;
    bf16x8 qf[8];
#pragma unroll
    for (int ks = 0; ks < 8; ++ks) qf[ks] = *(const LAS bf16x8*)(lds + L3_Q + (t * XLD + 16 * ks + 8 * hi) * 2);
    const float bt = gl[t], ebt = __expf(bt);
    f32x16 o = zero16(); float den = 0.f;
    const int lo_ = ((lane >> 4) & 1) * 32 + (lane & 3) * 8 + (4 * hi + ((lane & 15) >> 2)) * 64;
    for (int st = 0; st <= tt; ++st) {
        f32x16 ps = zero16();
#pragma unroll
        for (int ks = 0; ks < 8; ++ks) ps = __builtin_amdgcn_mfma_f32_32x32x16_bf16(*(const LAS bf16x8*)(lds + L3_K + ((32 * st + r32) * XLD + 16 * ks + 8 * hi) * 2), qf[ks], ps, 0, 0, 0);
#pragma unroll
        for (int g4 = 0; g4 < 4; ++g4) { const f32x4 gs = *(const LAS f32x4*)(gl + 64 + 32 * st + 8 * g4 + 4 * hi);
#pragma unroll
            for (int j = 0; j < 4; ++j) { const int s = 32 * st + 8 * g4 + 4 * hi + j; const float v = (s <= t) ? ps[4 * g4 + j] * __expf(bt + gs[j]) : 0.f; ps[4 * g4 + j] = v; den += v; } }
        const u32x4 pw0 = (u32x4){pk(ps[0], ps[1]), pk(ps[2], ps[3]), pk(ps[4], ps[5]), pk(ps[6], ps[7])}, pw1 = (u32x4){pk(ps[8], ps[9]), pk(ps[10], ps[11]), pk(ps[12], ps[13]), pk(ps[14], ps[15])};
#pragma unroll
        for (int k2 = 0; k2 < 2; ++k2) { const int kg = 2 * st + k2;
            const s16x4 vl = vtr(lds + L3_V + lo_ + d0 * 4096 + kg * 1024), vh = vtr(lds + L3_V + lo_ + d0 * 4096 + kg * 1024 + 512);
            o = __builtin_amdgcn_mfma_f32_32x32x16_bf16(__builtin_bit_cast(bf16x8, k2 ? pw1 : pw0), (bf16x8){vl[0], vl[1], vl[2], vl[3], vh[0], vh[1], vh[2], vh[3]}, o, 0, 0, 0); }
    }
    { float qn = 0.f; const LAS unsigned char* cp = lds + L3_C + ((32 * d0 + r32) * XLD + 8 * hi) * 2;
#pragma unroll
      for (int ks = 0; ks < 8; ++ks) { f32x4 a0, a1; pg8::unpack8(__builtin_bit_cast(u32x4, qf[ks]), a0, a1);
          const f32x4 n0 = *(const LAS f32x4*)(gl + 128 + 16 * ks + 8 * hi), n1 = *(const LAS f32x4*)(gl + 128 + 16 * ks + 8 * hi + 4);
          qn += (a0[0] * n0[0] + a0[1] * n0[1]) + (a0[2] * n0[2] + a0[3] * n0[3]) + (a1[0] * n1[0] + a1[1] * n1[1]) + (a1[2] * n1[2] + a1[3] * n1[3]);
          const u32x4 qs = pg8::pack8(a0 * ebt, a1 * ebt);
          o = __builtin_amdgcn_mfma_f32_32x32x16_bf16(__builtin_bit_cast(bf16x8, qs), *(const LAS bf16x8*)(cp + 32 * ks), o, 0, 0, 0); }
      den = swap_sum(den + ebt * qn); }
    { LAS float* wsf = (LAS float*)(lds + L3_WSF + wid * 256);
      if (hi == 0) wsf[r32] = 1.f / fmaxf(fabsf(den), 1.f);
      LAS float* H = (LAS float*)(lds + L3_H);
#pragma unroll
      for (int g4 = 0; g4 < 4; ++g4) { const f32x4 w = *(const LAS f32x4*)(wsf + 8 * g4 + 4 * hi);
#pragma unroll
          for (int j = 0; j < 4; ++j) { const int tq = 32 * tt + 8 * g4 + 4 * hi + j; H[tq * 132 + 32 * d0 + r32] = o[4 * g4 + j] * w[j]; } } }
    __syncthreads();
    { const LAS float* H = (const LAS float*)(lds + L3_H);
      const int tq = tid >> 3, cs = (tid & 7) * 16; const size_t m = m0 + tq; const int cb = h * 128 + cs;
      const u32x4 op0 = *(const u32x4*)(p.proj + m * LDP + C_OPRE + cb), op1 = *(const u32x4*)(p.proj + m * LDP + C_OPRE + cb + 8);
      const u32x4 xc0 = *(const u32x4*)(p.xc + m * 512 + cb), xc1 = *(const u32x4*)(p.xc + m * 512 + cb + 8);
      f32x4 og[4], xv[4], hv[4]; pg8::unpack8(op0, og[0], og[1]); pg8::unpack8(op1, og[2], og[3]); pg8::unpack8(xc0, xv[0], xv[1]); pg8::unpack8(xc1, xv[2], xv[3]);
      float s1 = 0.f, s2 = 0.f;
#pragma unroll
      for (int q4 = 0; q4 < 4; ++q4) { hv[q4] = *(const LAS f32x4*)(H + tq * 132 + cs + 4 * q4);
#pragma unroll
          for (int j = 0; j < 4; ++j) { const float v = hv[q4][j] * __builtin_amdgcn_rcpf(1.f + __expf(-og[q4][j])); hv[q4][j] = v; s1 += v; s2 += v * v; } }
      s1 += __shfl_xor(s1, 1); s2 += __shfl_xor(s2, 1); s1 += __shfl_xor(s1, 2); s2 += __shfl_xor(s2, 2); s1 += __shfl_xor(s1, 4); s2 += __shfl_xor(s2, 4);
      const float mu = s1 * (1.f / 128.f), rs = rsqrtf(fmaxf(s2 * (1.f / 128.f) - mu * mu, 0.f) + EPS);
      f32x4 yo[4];
#pragma unroll
      for (int q4 = 0; q4 < 4; ++q4) { const f32x4 gn = *(const f32x4*)(p.mh_gain + cb + 4 * q4), sk = *(const f32x4*)(p.skip + cb + 4 * q4);
#pragma unroll
          for (int j = 0; j < 4; ++j) yo[q4][j] = (hv[q4][j] - mu) * rs * gn[j] + sk[j] * xv[q4][j]; }
      *(u32x4*)(p.yb + m * 512 + cb) = pg8::pack8(yo[0], yo[1]); *(u32x4*)(p.yb + m * 512 + cb + 8) = pg8::pack8(yo[2], yo[3]); }
}
}

namespace xat {
using nsa::bf16x8; using nsa::s16x4; using nsa::f32x16; using nsa::u32x4; using nsa::vtr; using nsa::pk; using nsa::swap_sum; using nsa::swap_max;
constexpr int L_K = 0, L_V = 65536, L_WSF = 98304, L_END = L_WSF + 2048;
constexpr float C2X = 0.0625f * 1.4426950408889634f, THR = 6.f;
__device__ __forceinline__ void unit(int b, int h, int qb, const bf16_t* qx, const bf16_t* kx, const bf16_t* vx, int kvp, bf16_t* ox, LAS unsigned char* lds) {
    int t_ = threadIdx.x; asm volatile("" : "+v"(t_)); const int tid = t_, lane = tid & 63, wid = __builtin_amdgcn_readfirstlane(tid >> 6), r32 = lane & 31, hi = lane >> 5;
    LAS float* wsf = (LAS float*)(lds + L_WSF + wid * 256);
    const size_t mrow = (size_t)b * T + 256 * qb + 32 * wid + r32;
    bf16x8 qr[16];
#pragma unroll
    for (int d0 = 0; d0 < 16; ++d0) qr[d0] = *(const bf16x8*)(qx + mrow * D + h * 256 + d0 * 16 + hi * 8);
    const bf16_t* kb = kx + (size_t)b * NMEM * kvp + h * 256; const bf16_t* vb = vx + (size_t)b * NMEM * kvp + h * 256;
    const LAS unsigned char* kp0 = lds + L_K + hi * 1024 + r32 * 16;
    const LAS unsigned char* vp0 = lds + L_V + ((lane >> 4) & 1) * 32 + (lane & 3) * 8 + (4 * hi + ((lane & 15) >> 2)) * 64;
    for (int dh2 = 0; dh2 < 2; ++dh2) {
        f32x16 o[4];
#pragma unroll
        for (int d0 = 0; d0 < 4; ++d0) o[d0] = mls::zero16();
        float mref = -1e30f, l = 0.f;
#define XA_LOAD(jt, slot) do { _Pragma("unroll") for (int i2 = 0; i2 < 4; ++i2) { const int pid = tid + 512 * i2; \
                __builtin_amdgcn_global_load_lds((const unsigned*)(kb + (size_t)(64 * (jt) + (pid & 63)) * kvp + (pid >> 6) * 8), (LAS unsigned*)(lds + L_K + (slot) * 32768 + (wid * 64 + 512 * i2) * 16), 16, 0, 0); } \
            _Pragma("unroll") for (int i2 = 0; i2 < 2; ++i2) { const int pid = tid + 512 * i2, blk = pid >> 6, ln = pid & 63; \
                __builtin_amdgcn_global_load_lds((const unsigned*)(vb + (size_t)(64 * (jt) + 16 * (blk & 3) + (ln >> 2)) * kvp + 128 * dh2 + (blk >> 2) * 32 + (ln & 3) * 8), (LAS unsigned*)(lds + L_V + (slot) * 16384 + (wid * 64 + 512 * i2) * 16), 16, 0, 0); } } while (0)
        __syncthreads();
        XA_LOAD(0, 0); asm volatile("s_waitcnt vmcnt(0)" ::: "memory"); __syncthreads();
        for (int jt = 0; jt < 4; ++jt) { const int slot = jt & 1;
            if (jt + 1 < 4) XA_LOAD(jt + 1, slot ^ 1);
            f32x16 p0 = mls::zero16(), p1 = p0;
            { const LAS unsigned char* kp = kp0 + slot * 32768;
              bf16x8 ka0 = *(const LAS bf16x8*)(kp), ka1 = *(const LAS bf16x8*)(kp + 512), kb0, kb1;
#pragma unroll
              for (int d0 = 0; d0 < 16; d0 += 2) {
                  kb0 = *(const LAS bf16x8*)(kp + (d0 + 1) * 2048); kb1 = *(const LAS bf16x8*)(kp + (d0 + 1) * 2048 + 512);
                  __builtin_amdgcn_sched_barrier(0);
                  p0 = __builtin_amdgcn_mfma_f32_32x32x16_bf16(ka0, qr[d0], p0, 0, 0, 0); p1 = __builtin_amdgcn_mfma_f32_32x32x16_bf16(ka1, qr[d0], p1, 0, 0, 0);
                  __builtin_amdgcn_sched_barrier(0);
                  if (d0 + 2 < 16) { ka0 = *(const LAS bf16x8*)(kp + (d0 + 2) * 2048); ka1 = *(const LAS bf16x8*)(kp + (d0 + 2) * 2048 + 512); }
                  __builtin_amdgcn_sched_barrier(0);
                  p0 = __builtin_amdgcn_mfma_f32_32x32x16_bf16(kb0, qr[d0 + 1], p0, 0, 0, 0); p1 = __builtin_amdgcn_mfma_f32_32x32x16_bf16(kb1, qr[d0 + 1], p1, 0, 0, 0);
                  __builtin_amdgcn_sched_barrier(0); } }
            float rm = fmaxf(p0[0], p1[0]);
#pragma unroll
            for (int r = 1; r < 16; ++r) rm = fmaxf(rm, fmaxf(p0[r], p1[r]));
            rm = swap_max(rm) * C2X;
            const bool need = rm > mref + THR;
            if (__any(need)) {
                const float mnew = need ? rm : mref, f = __builtin_amdgcn_exp2f(mref - mnew);
                l *= f; mref = mnew;
#pragma unroll
                for (int r = 0; r < 16; ++r) { o[0][r] *= f; o[1][r] *= f; o[2][r] *= f; o[3][r] *= f; }
            }
            float sum = 0.f;
#pragma unroll
            for (int r = 0; r < 16; ++r) { p0[r] = __builtin_amdgcn_exp2f(__builtin_fmaf(p0[r], C2X, -mref)); p1[r] = __builtin_amdgcn_exp2f(__builtin_fmaf(p1[r], C2X, -mref)); sum += p0[r] + p1[r]; }
            l += sum;
            u32x4 pw[4];
            pw[0] = (u32x4){pk(p0[0], p0[1]), pk(p0[2], p0[3]), pk(p0[4], p0[5]), pk(p0[6], p0[7])}; pw[1] = (u32x4){pk(p0[8], p0[9]), pk(p0[10], p0[11]), pk(p0[12], p0[13]), pk(p0[14], p0[15])};
            pw[2] = (u32x4){pk(p1[0], p1[1]), pk(p1[2], p1[3]), pk(p1[4], p1[5]), pk(p1[6], p1[7])}; pw[3] = (u32x4){pk(p1[8], p1[9]), pk(p1[10], p1[11]), pk(p1[12], p1[13]), pk(p1[14], p1[15])};
            { const LAS unsigned char* vp = vp0 + slot * 16384;
#define XA_VLD(i, L0, H0, L1, H1) do { L0 = vtr(vp + ((i) >> 1) * 4096 + ((i) & 1) * 2048); H0 = vtr(vp + ((i) >> 1) * 4096 + ((i) & 1) * 2048 + 512); L1 = vtr(vp + ((i) >> 1) * 4096 + ((i) & 1) * 2048 + 1024); H1 = vtr(vp + ((i) >> 1) * 4096 + ((i) & 1) * 2048 + 1536); } while (0)
#define XA_VMM(i, L0, H0, L1, H1) do { o[(i) >> 1] = __builtin_amdgcn_mfma_f32_32x32x16_bf16((bf16x8){L0[0], L0[1], L0[2], L0[3], H0[0], H0[1], H0[2], H0[3]}, __builtin_bit_cast(bf16x8, pw[((i) & 1) * 2]), o[(i) >> 1], 0, 0, 0); \
                  o[(i) >> 1] = __builtin_amdgcn_mfma_f32_32x32x16_bf16((bf16x8){L1[0], L1[1], L1[2], L1[3], H1[0], H1[1], H1[2], H1[3]}, __builtin_bit_cast(bf16x8, pw[((i) & 1) * 2 + 1]), o[(i) >> 1], 0, 0, 0); } while (0)
              s16x4 al0, ah0, al1, ah1, bl0, bh0, bl1, bh1;
              XA_VLD(0, al0, ah0, al1, ah1);
#pragma unroll
              for (int i = 0; i < 8; i += 2) {
                  XA_VLD(i + 1, bl0, bh0, bl1, bh1);
                  __builtin_amdgcn_sched_barrier(0);
                  XA_VMM(i, al0, ah0, al1, ah1);
                  __builtin_amdgcn_sched_barrier(0);
                  if (i + 2 < 8) XA_VLD(i + 2, al0, ah0, al1, ah1);
                  __builtin_amdgcn_sched_barrier(0);
                  XA_VMM(i + 1, bl0, bh0, bl1, bh1);
                  __builtin_amdgcn_sched_barrier(0); }
#undef XA_VLD
#undef XA_VMM
            }
            asm volatile("s_waitcnt vmcnt(0)" ::: "memory"); __syncthreads();
        }
#undef XA_LOAD
        const float inv = 1.f / swap_sum(l);
        LAS unsigned char* ot = lds + wid * 8704;
#pragma unroll
        for (int d0 = 0; d0 < 4; ++d0)
#pragma unroll
            for (int g4 = 0; g4 < 4; ++g4) { pg8::u32x2 w; w.x = pk(o[d0][4 * g4] * inv, o[d0][4 * g4 + 1] * inv); w.y = pk(o[d0][4 * g4 + 2] * inv, o[d0][4 * g4 + 3] * inv);
                *(LAS pg8::u32x2*)(ot + r32 * 272 + (32 * d0 + 8 * g4 + 4 * hi) * 2) = w; }
#pragma unroll
        for (int i2 = 0; i2 < 8; ++i2) { const int row = 4 * i2 + (lane >> 4), c16 = lane & 15;
            *(u32x4*)(ox + ((size_t)b * T + 256 * qb + 32 * wid + row) * D + h * 256 + 128 * dh2 + c16 * 8) = *(const LAS u32x4*)(ot + row * 272 + c16 * 16); }
    }
}
}

__device__ __forceinline__ int conv_srccol(int kind, int r) {
    if (kind == 1) return r < IN_COLS ? my2orig(r) : -1;
    if (kind == 2) { const int pn = r >> 8, rr = r & 255; return (rr >> 7) * 1024 + pn * 128 + (rr & 127); }
    if (kind == 3) return r < NEXP ? r : -1;
    if (kind == 4) return r < 128 ? r : -1;
    return r;
}
template <bool F8>
__device__ __forceinline__ void conv_item(const float* W, int ldw, const float* gk, int kind, bf16_t* WT, int K, int k0, int r0, LAS float* scr, int lane) {
    const int c4 = (lane & 15) * 4; const int sc = conv_srccol(kind, r0 + c4);
    f32x4 vv[16];
#pragma unroll
    for (int i = 0; i < 16; ++i) { const int kk = 4 * i + (lane >> 4); vv[i] = (f32x4){0.f, 0.f, 0.f, 0.f}; if (sc >= 0) vv[i] = *(const f32x4*)(W + (size_t)(k0 + kk) * ldw + sc); }
    float gv[16];
#pragma unroll
    for (int i = 0; i < 16; ++i) gv[i] = gk ? gk[k0 + 4 * i + (lane >> 4)] : 1.f;
#pragma unroll
    for (int i = 0; i < 16; ++i) { const int kk = 4 * i + (lane >> 4); const f32x4 v = vv[i] * gv[i];
        LAS float* d = scr + kk * 65 + c4; d[0] = v[0]; d[1] = v[1]; d[2] = v[2]; d[3] = v[3]; }
    asm volatile("s_waitcnt lgkmcnt(0)" ::: "memory");
    const int ch = lane & 7;
#pragma unroll 2
    for (int i = 0; i < 8; ++i) { const int n = (lane >> 3) + 8 * i; const LAS float* s = scr + (8 * ch) * 65 + n;
        if constexpr (F8) {
            pg8::u32x2 o; o.x = pg8::pack4_fp8((f32x4){s[0 * 65], s[1 * 65], s[2 * 65], s[3 * 65]} * 32.f); o.y = pg8::pack4_fp8((f32x4){s[4 * 65], s[5 * 65], s[6 * 65], s[7 * 65]} * 32.f);
            *(pg8::u32x2*)((unsigned char*)WT + (size_t)(r0 + n) * K + k0 + 8 * ch) = o;
        } else {
        pg8::u32x4 o; o.x = pg8::cvt_pk_bf16(s[0 * 65], s[1 * 65]); o.y = pg8::cvt_pk_bf16(s[2 * 65], s[3 * 65]); o.z = pg8::cvt_pk_bf16(s[4 * 65], s[5 * 65]); o.w = pg8::cvt_pk_bf16(s[6 * 65], s[7 * 65]);
        bf16_t* dst = WT + (size_t)(r0 + n) * K + k0 + 8 * ch;
        if (kind == 5) dst = WT + (size_t)((((r0 + n) >> 5) * 8 + ((k0 + 8 * ch) >> 4)) * 64 + (((k0 + 8 * ch) >> 3) & 1) * 32 + ((r0 + n) & 31)) * 8;
        *(pg8::u32x4*)dst = o; } }
    asm volatile("s_waitcnt lgkmcnt(0)" ::: "memory");
}
template <bool F8 = false>
__device__ __forceinline__ bool conv_matrix(int& it, const float* W, int ldw, const float* gk, int kind, bf16_t* WT, int K, int rows, LAS float* scr, int lane) {
    const int nkb = K / 64, nrb = rows / 64, nit = nkb * nrb;
    if (it >= nit) { it -= nit; return false; }
    const int kbp = it / (2 * nrb), r2 = it % (2 * nrb), rb = r2 >> 1, kb = 2 * kbp + (r2 & 1);
    conv_item<F8>(W, ldw, gk, kind, WT, K, kb * 64, rb * 64, scr, lane);
    return true;
}

enum Stage { ST_PREP = 0, ST_PROJ, ST_A, ST_B, ST_C, ST_MRG, ST_OMIX, ST_QX, ST_XATT, ST_OX, ST_ROUTER, ST_RSCAT, ST_MOE1, ST_MOE2, ST_FINAL, ST_COUNT };
constexpr size_t W_1_T = 22 * MiB;

constexpr size_t W_IN_T = 0, W_UA_T = 9 * MiB, W_UB_T = 10 * MiB, W_OM_T = 11 * MiB, W_QX_T = 13 * MiB, W_OX_T = 15 * MiB, W_R_T = 17 * MiB, W_GU_T = 32 * MiB, W_D_T = 160 * MiB;
constexpr size_t SM_SSQ1 = 22 * MiB, SM_SSQ2 = 24 * MiB;
constexpr size_t W_KX_T = 18 * MiB, W_VX_T = 20 * MiB, W_MEMN = 26 * MiB, W_KVX = 28 * MiB;
constexpr size_t W_M_T = 24 * MiB;
constexpr size_t SM_ROWRS = 32 * MiB, SM_ROWW = 33 * MiB, SM_RPAIR = 34 * MiB, SM_TEND = 35 * MiB;
constexpr size_t SM_UN = 26 * MiB, SM_NST = 27 * MiB, SM_GB = 28 * MiB, SM_GG = 28 * MiB + 512 * 1024, SM_BL = 29 * MiB;

template <int stage> __device__ __forceinline__ void run_stage(const Args& a, float* sm) {
    int tid_ = threadIdx.x; asm volatile("" : "+v"(tid_));
    int bid_ = blockIdx.x; asm volatile("" : "+s"(bid_));
    const int bid = bid_, nb = gridDim.x, tid = tid_;
    LAS unsigned char* ldsb = (LAS unsigned char*)sm;
    unsigned long long ws_ = (unsigned long long)a.ws; asm volatile("" : "+s"(ws_)); unsigned char* ws = glb_ptr<unsigned char>(ws_);
    const LAS unsigned long long* ptab = (const LAS unsigned long long*)((LAS unsigned char*)sm + LDS_PTAB);
#define INP(k) glb_ptr<const float>(((unsigned long long)(unsigned)__builtin_amdgcn_readfirstlane((int)(ptab[k] >> 32)) << 32) | (unsigned long long)(unsigned)__builtin_amdgcn_readfirstlane((int)(unsigned)ptab[k]))
    const float* x = INP(0); const float* mem = INP(1); const float* g_mix = INP(2); const float* w_in = INP(3);
    const float* pe_k = INP(4); const float* pe_v = INP(5); const float* w1k = INP(6); const float* w2k = INP(7); const float* w1v = INP(8); const float* w2v = INP(9);
    const float* w_conv = INP(10); const float* b_conv = INP(11); const float* w_q_m = INP(12); const float* w_k_m = INP(13); const float* w_v_m = INP(14);
    const float* b_i = INP(15); const float* b_f = INP(16); const float* mh_gain = INP(17); const float* skip_m = INP(18);
    const float* w_up_a = INP(19); const float* w_up_b = INP(20); const float* w_o_mix = INP(21); const float* g_x = INP(22); const float* g_mem = INP(23);
    const float* w_q_x = INP(24); const float* w_k_x = INP(25); const float* w_v_x = INP(26); const float* w_o_x = INP(27);
    const float* g_ffn = INP(28); const float* w_router = INP(29); const float* b_router = INP(30); const float* w_gu = INP(31); const float* b_gu = INP(32);
    const float* w_down = INP(33); const float* b_down = INP(34); const float* g_final = INP(35);
    unsigned char* sml = ws + WS_SMALL;
    float* rstdm = (float*)(sml + SM_RSTDM);
    float* bias1 = (float*)(sml + SM_BIAS1); int* cnt = (int*)(sml + 30 * MiB);     int* ntl = (int*)(sml + SM_NT); int* texp = (int*)(sml + SM_TEXP);
    bf16_t* kc = (bf16_t*)(sml + SM_KC); bf16_t* vc = (bf16_t*)(sml + SM_VC); float* h1 = (float*)(sml + SM_H1);
    float* kx = (float*)(sml + SM_KX); float* vx = (float*)(sml + SM_VX); float* logit = (float*)(sml + SM_LOGIT);
    int* te = (int*)(sml + SM_TE); float* tw = (float*)(sml + SM_TW); int* tp = (int*)(sml + SM_TP); int* rslot = (int*)(sml + SM_RSLOT);
    float* ssq1 = (float*)(sml + SM_SSQ1); float* ssq2 = (float*)(sml + SM_SSQ2);
    float* gates = (float*)(ws + WS_GATES); bf16_t* proj = (bf16_t*)(ws + WS_PROJ); float* x1 = (float*)(ws + WS_X1);
    bf16_t* ya = (bf16_t*)(ws + WS_YA); bf16_t* yb = (bf16_t*)(ws + WS_YB);
    bf16_t* xb0 = (bf16_t*)(ws + WS_T1);
    bf16_t* xc = (bf16_t*)(ws + WS_T1); bf16_t* mq = (bf16_t*)(ws + WS_T1 + 32 * MiB); bf16_t* mk = (bf16_t*)(ws + WS_T1 + 64 * MiB); bf16_t* mv = (bf16_t*)(ws + WS_T1 + 96 * MiB);
    float* hbuf = (float*)(ws + WS_T1 + 128 * MiB);
    bf16_t* mg = (bf16_t*)(ws + WS_T1);
    bf16_t* xb1 = (bf16_t*)(ws + WS_T1 + 64 * MiB);
    bf16_t* xb2 = (bf16_t*)(ws + WS_X1);
    bf16_t* qx = (bf16_t*)(ws + WS_PROJ);
    bf16_t* ox = (bf16_t*)(ws + WS_PROJ + 64 * MiB);
    unsigned char* act8 = ws + WS_PROJ;
    unsigned char* xq8 = ws + WS_X1 + 64 * MiB;
    bf16_t* ys = (bf16_t*)(ws + WS_YA);
    bf16_t* wt = (bf16_t*)(ws + WS_W);
    bf16_t* memn = wt + W_MEMN / 2; bf16_t* kvx = wt + W_KVX / 2;
    bf16_t* kvc6 = (bf16_t*)(ws + 964 * MiB);
    const int G = nb;

    switch (stage) {
    case ST_PREP: {
        const int lane = tid & 63, wv = tid >> 6;
        LAS float* scr = (LAS float*)(ldsb + wv * 16640);
        const int gw = bid * 8 + wv, NGW = nb * 8;
        constexpr int I_IN = 16 * 72, I_U = 8 * 16, I_SQ = 16 * 16, I_R = 16 * 4, I_GU = 16 * 32, I_D = 16 * 16;
        constexpr int NITEMS = I_IN + 2 * I_U + 5 * I_SQ + I_R + 48 + 256;
        for (int item = gw; item < NITEMS; item += NGW) {
            int it = item;
            if (conv_matrix(it, w_in, IN_COLS, g_mix, 1, wt + W_IN_T / 2, D, LDP, scr, lane)) continue;
            if (conv_matrix(it, w_up_a, D, nullptr, 0, wt + W_UA_T / 2, 512, D, scr, lane)) continue;
            if (conv_matrix(it, w_up_b, D, nullptr, 0, wt + W_UB_T / 2, 512, D, scr, lane)) continue;
            if (conv_matrix(it, w_o_mix, D, nullptr, 0, wt + W_OM_T / 2, D, D, scr, lane)) continue;
            if (conv_matrix(it, w_q_x, D, g_x, 0, wt + W_QX_T / 2, D, D, scr, lane)) continue;
            if (conv_matrix(it, w_o_x, D, nullptr, 0, wt + W_OX_T / 2, D, D, scr, lane)) continue;
            if (conv_matrix(it, w_k_x, D, g_mem, 0, wt + W_KX_T / 2, D, D, scr, lane)) continue;
            if (conv_matrix(it, w_v_x, D, g_mem, 0, wt + W_VX_T / 2, D, D, scr, lane)) continue;
            if (conv_matrix(it, w_router, NEXP, g_ffn, 3, wt + W_R_T / 2, D, 256, scr, lane)) continue;
            if (it < 48) { const int mi = it >> 2; it &= 3; const float* wsrc = (mi < 4 ? w_q_m : mi < 8 ? w_k_m : w_v_m) + (size_t)(mi & 3) * 16384;
                conv_matrix(it, wsrc, 128, nullptr, 5, wt + W_M_T / 2 + (size_t)mi * 16384, 128, 128, scr, lane); continue; }
            it -= 48;
            if (conv_matrix(it, w1k, 128, nullptr, 4, wt + W_1_T / 2, 2048, 256, scr, lane)) continue;
            if (conv_matrix(it, w1v, 128, nullptr, 4, wt + W_1_T / 2 + 256 * 2048, 2048, 256, scr, lane)) continue;
        }
        for (int m = gw; m < M; m += NGW) {
            const f32x4* xr = (const f32x4*)(x + (size_t)m * D) + lane; f32x4 v[4]; float s = 0.f;
#pragma unroll
            for (int j = 0; j < 4; ++j) { v[j] = xr[64 * j]; s += v[j].x * v[j].x + v[j].y * v[j].y + v[j].z * v[j].z + v[j].w * v[j].w; }
            const float rs = rsqrtf(wave_sum(s) * (1.f / D) + EPS);
            pg8::u32x2* o = (pg8::u32x2*)(xb0 + (size_t)m * D) + lane;
#pragma unroll
            for (int j = 0; j < 4; ++j) { pg8::u32x2 w; w.x = pg8::cvt_pk_bf16(v[j].x * rs, v[j].y * rs); w.y = pg8::cvt_pk_bf16(v[j].z * rs, v[j].w * rs); o[64 * j] = w; }
        }
        for (int m = gw; m < NB * NMEM; m += NGW) {
            const f32x4* xr = (const f32x4*)(mem + (size_t)m * D) + lane; f32x4 v[4]; float s = 0.f;
#pragma unroll
            for (int j = 0; j < 4; ++j) { v[j] = xr[64 * j]; s += v[j].x * v[j].x + v[j].y * v[j].y + v[j].z * v[j].z + v[j].w * v[j].w; }
            const float rs = rsqrtf(wave_sum(s) * (1.f / D) + EPS);
            pg8::u32x2* o = (pg8::u32x2*)(memn + (size_t)m * D) + lane;
#pragma unroll
            for (int j = 0; j < 4; ++j) { pg8::u32x2 w; w.x = pg8::cvt_pk_bf16(v[j].x * rs, v[j].y * rs); w.y = pg8::cvt_pk_bf16(v[j].z * rs, v[j].w * rs); o[64 * j] = w; }
        }
        for (int i = bid; i < 256; i += nb) {
            const float* pe = i < 128 ? pe_k : pe_v; const float* w1 = i < 128 ? w1k : w1v; const int j = i & 127; float sacc = 0.f;
#pragma unroll
            for (int q4 = 0; q4 < 4; ++q4) { const int kk = tid + 512 * q4; sacc += pe[kk] * w1[(size_t)kk * 128 + j]; }
            sacc = wave_sum(sacc);
            __syncthreads();
            if (lane == 0) sm[wv] = sacc;
            __syncthreads();
            if (tid == 0) bias1[i] = ((sm[0] + sm[1]) + (sm[2] + sm[3])) + ((sm[4] + sm[5]) + (sm[6] + sm[7]));
        }
        if (bid == 0 && tid < 32) cnt[tid * 64] = 0;
    } break;
    case ST_PROJ: {
        pg8::DenseSched S{(const char*)xb0, (const char*)(wt + W_IN_T / 2), nullptr, nullptr, 2048u, 2048u, 128, 16, M / 256, LDP / 256, G, bid, 1};
        pg8::EpiProj E{proj, gates, kvc6};
        pg8::gemm_phase(ldsb, S, E);
    } break;
    case ST_A: {
        { pg8::CmpSched S{kvc6, (const char*)(wt + W_1_T / 2), 2048u, 4096u, (size_t)128, 32, G, bid};
          pg8::EpiCmp E{h1, bias1};
          pg8::gemm_phase(ldsb, S, E); }
        mls::P1 P{proj, gates, w_conv, b_conv, b_i, b_f, wt + W_M_T / 2, xc, mq, mk, mv, (bf16_t*)(ws + WS_X1), (float*)(sml + SM_UN), (float*)(sml + SM_GB), (float*)(sml + SM_GG), (float*)(sml + SM_BL)};
        for (int k = tid; k < 2560; k += 512) ((LAS float*)(ldsb + mls::L_WC))[k] = k < 2048 ? w_conv[k] : b_conv[k - 2048];
        if (nb == 256) {
            const int u0 = bid < 32 ? 2016 + bid : (bid - 32) * 9, nu = bid < 32 ? 1 : 9;
#pragma unroll 1
            for (int k = 0; k < nu; ++k) { const int u = u0 + k; mls::ml1_unit(P, u >> 9, (u >> 7) & 3, u & 127, ldsb); }
        } else {
#pragma unroll 1
            for (int u = bid; u < 2048; u += nb) mls::ml1_unit(P, u >> 9, (u >> 7) & 3, u & 127, ldsb);
        }
    } break;
    case ST_B: {
        { pg8::DenseSched S{(const char*)memn, (const char*)(wt + W_KX_T / 2), nullptr, nullptr, 2048u, 2048u, 128, 16, NB * NMEM / 256, 2 * D / 256, G, bid, 1};
          pg8::EpiScaleBf16 E{kvx, 2 * D, nullptr};
          pg8::gemm_phase(ldsb, S, E); }
        const int ncg = nb >= 128 ? 64 : 0;
        if (ncg == 0 || bid < ncg) {
            const int cb = ncg ? bid : bid, cn = ncg ? ncg : nb;
            for (int kv = 0; kv < 2; ++kv) {
                const float* w2 = kv ? w2v : w2k; bf16_t* o = kv ? vc : kc;
                nv_gemm(4096, 64, 128,
                    [&](int row, int kk) { return h1[((size_t)kv * 4096 + row) * 128 + kk]; },
                    [&](int kk, int n, int) { return w2[(size_t)kk * 64 + n]; },
                    [&](int row, int n, const float* acc) { const bool pad = (row & 511) == 511;
#pragma unroll
                        for (int j = 0; j < 4; ++j) o[(size_t)row * 64 + n + j] = pad ? (bf16_t)0 : f2bf(acc[j]); },
                    sm, kv ? cb : (cb + cn / 2) % cn, cn);
            }
        }
        if (ncg == 0 || bid >= ncg)
            mls::ml2((const bf16_t*)(ws + WS_X1), (const float*)(sml + SM_UN), (const float*)(sml + SM_BL), (bf16_t*)(ws + WS_T1 + 128 * MiB), (float*)(sml + SM_NST), sm, ncg ? bid - ncg : bid, ncg ? nb - ncg : nb);
    } break;
    case ST_C: {
#define MOE_CONVERT() do { constexpr int I_GU = 16 * 32, I_D = 16 * 16, NMOE = NEXP * (I_GU + I_D); \
            int tid2 = threadIdx.x, bid2 = blockIdx.x; asm volatile("" : "+v"(tid2), "+s"(bid2)); \
            const int lane = tid2 & 63, wv = __builtin_amdgcn_readfirstlane(tid2 >> 6), gw = bid2 * 8 + wv, NGW = gridDim.x * 8; \
            LAS float* scr = (LAS float*)((LAS unsigned char*)sm + wv * 16640); \
            __syncthreads(); \
            _Pragma("unroll 1") for (int it0 = gw; it0 < NMOE; it0 += NGW) { int it = it0; unsigned char* wdst = ws + WS_W; \
                if (it < NEXP * I_GU) { const int e = it / I_GU; it -= e * I_GU; conv_matrix<true>(it, INP(31) + (size_t)e * D * 2048, 2048, INP(28), 2, (bf16_t*)(wdst + W_GU_T + (size_t)e * 2048 * D), D, 2048, scr, lane); } \
                else { it -= NEXP * I_GU; const int e = it / I_D; it -= e * I_D; conv_matrix<true>(it, INP(33) + (size_t)e * D * D, D, nullptr, 0, (bf16_t*)(wdst + W_D_T + (size_t)e * D * D), D, D, scr, lane); } } \
            __syncthreads(); } while (0)
        if (bid & 1) MOE_CONVERT();
        nsa::phase(proj, kvc6, gates, kc, vc, ya, ldsb, bid, nb);
        { mls::P3 P{proj, xc, mq, mk, mv, (const bf16_t*)(ws + WS_T1 + 128 * MiB), (const float*)(sml + SM_NST), (const float*)(sml + SM_GB), (const float*)(sml + SM_GG), mh_gain, skip_m, yb};
#pragma unroll 1
          for (int u = bid; u < 2048; u += nb) mls::ml3_unit(P, u >> 9, (u >> 7) & 3, u & 127, ldsb); }
        if (!(bid & 1)) MOE_CONVERT();
#undef MOE_CONVERT
    } break;
    case ST_MRG: {
        pg8::DenseSched S{(const char*)ya, (const char*)(wt + W_UA_T / 2), (const char*)yb, (const char*)(wt + W_UB_T / 2), 1024u, 1024u, 128, 8, M / 256, D / 256, G, bid, 2};
        pg8::EpiMerged E{proj, mg};
        pg8::gemm_phase(ldsb, S, E);
    } break;
    case ST_OMIX: {
        pg8::DenseSched S{(const char*)mg, (const char*)(wt + W_OM_T / 2), nullptr, nullptr, 2048u, 2048u, 128, 16, M / 256, D / 256, G, bid, 1};
        pg8::EpiResid<false> E{x, xb1, ssq1, nullptr};
        pg8::gemm_phase(ldsb, S, E);
    } break;
    case ST_QX: {
        pg8::DenseSched S{(const char*)xb1, (const char*)(wt + W_QX_T / 2), nullptr, nullptr, 2048u, 2048u, 128, 16, M / 256, D / 256, G, bid, 1};
        pg8::EpiScaleBf16 E{qx, D, ssq1};
        pg8::gemm_phase(ldsb, S, E);
    } break;
    case ST_XATT: {
#pragma unroll 1
        for (int u = bid; u < 512; u += nb) xat::unit(u >> 7, (u >> 5) & 3, u & 31, qx, kvx, kvx + D, 2 * D, ox, ldsb);
    } break;
    case ST_OX: {
        pg8::DenseSched S{(const char*)ox, (const char*)(wt + W_OX_T / 2), nullptr, nullptr, 2048u, 2048u, 128, 16, M / 256, D / 256, G, bid, 1};
        pg8::EpiResid<true> E{xb1, xb2, ssq2, xq8};
        pg8::gemm_phase(ldsb, S, E);
    } break;
    case ST_ROUTER: {
        typedef short bf16x8_t __attribute__((ext_vector_type(8)));
        const int lane = tid & 63, wv = tid >> 6;
        constexpr int WLD = 2064;
        LAS unsigned char* wl = ldsb;
        LAS float* lgs = (LAS float*)(ldsb + 66560) + wv * (16 * 33);
        int* hist = (int*)(sm + (66560 + 8 * 16 * 33 * 4) / 4); int* gbase = hist + 32;
        for (int i = bid * 512 + tid; i < MOE_ROWS_MAX; i += nb * 512) { rslot[i] = -1; ((float*)(sml + SM_ROWRS))[i] = 0.f; ((float*)(sml + SM_ROWW))[i] = 0.f; if (i < MOE_ROWS_MAX / 2) ((unsigned*)(sml + SM_RPAIR))[i] = 0u; }
        for (int i = tid; i < 32 * 128; i += 512) { const int r = i >> 7, c16 = i & 127; *(LAS pg8::u32x4*)(wl + r * WLD + c16 * 16) = *(const pg8::u32x4*)(wt + W_R_T / 2 + (size_t)r * D + c16 * 8); }
        for (int ch = bid; ch < M / 128; ch += nb) {
            __syncthreads();
            if (tid < 32) hist[tid] = 0;
            const size_t row0 = (size_t)ch * 128 + wv * 16;
            f32x4 a0 = (f32x4){0.f, 0.f, 0.f, 0.f}, a1 = a0;
            const bf16_t* ap = xb2 + (row0 + (lane & 15)) * D + (lane >> 4) * 8;
            const LAS unsigned char* bp = wl + (lane & 15) * WLD + (lane >> 4) * 16;
#pragma unroll 8
            for (int ks = 0; ks < 32; ++ks) {
                const bf16x8_t af = *(const bf16x8_t*)(ap + ks * 32);
                const bf16x8_t b0 = *(const LAS bf16x8_t*)(bp + ks * 64), b1 = *(const LAS bf16x8_t*)(bp + 16 * WLD + ks * 64);
                a0 = __builtin_amdgcn_mfma_f32_16x16x32_bf16(af, b0, a0, 0, 0, 0); a1 = __builtin_amdgcn_mfma_f32_16x16x32_bf16(af, b1, a1, 0, 0, 0);
            }
#pragma unroll
            for (int j = 0; j < 4; ++j) { lgs[((lane >> 4) * 4 + j) * 33 + (lane & 15)] = a0[j]; lgs[((lane >> 4) * 4 + j) * 33 + 16 + (lane & 15)] = a1[j]; }
            __syncthreads();
            int ei[4]; float ex[4]; int lp[4]; float ssum = 0.f; const size_t m = row0 + lane;
            if (lane < 16) {
                const float rs = pg8::rstd_from_ssq(ssq2, m);
                float lv[NEXP];
#pragma unroll
                for (int e = 0; e < NEXP; ++e) lv[e] = lgs[lane * 33 + e] * rs + b_router[e];
                float ev[4];
#pragma unroll
                for (int k = 0; k < 4; ++k) { float best = -INFINITY; int bi_ = 0;
#pragma unroll
                    for (int e = 0; e < NEXP; ++e) { if (lv[e] > best) { best = lv[e]; bi_ = e; } }
                    ei[k] = bi_; ev[k] = best;
#pragma unroll
                    for (int e = 0; e < NEXP; ++e) if (e == bi_) lv[e] = -INFINITY; }
#pragma unroll
                for (int k = 0; k < 4; ++k) { ex[k] = __expf(ev[k] - ev[0]); ssum += ex[k]; lp[k] = atomicAdd(&hist[ei[k]], 1); }
            }
            __syncthreads();
            if (tid < 32) gbase[tid] = atomicAdd(&cnt[tid * 64], hist[tid]);
            __syncthreads();
            if (lane < 16) {
#pragma unroll
                for (int k = 0; k < 4; ++k) { te[m * 4 + k] = ei[k]; tw[m * 4 + k] = ex[k] / ssum; tp[m * 4 + k] = gbase[ei[k]] + lp[k]; }
            }
        }
    } break;
    case ST_RSCAT: {
        int* eb = (int*)sm;
        if (tid < 32) { int acc = 0; for (int e = 0; e < tid; ++e) acc += (cnt[e * 64] + MOE_PAD - 1) / MOE_PAD * MOE_PAD; eb[tid] = acc; }
        __syncthreads();
        if (bid == 0 && tid < 32) { const int te_ = (eb[tid] + (cnt[tid * 64] + MOE_PAD - 1) / MOE_PAD * MOE_PAD) / MOE_PAD; ((int*)(sml + SM_TEND))[tid] = te_; if (tid == 31) ntl[0] = te_; }
        for (int i = bid * 512 + tid; i < NASG; i += nb * 512) { const int row = eb[te[i]] + tp[i]; rslot[row] = i;
            ((float*)(sml + SM_ROWRS))[row] = pg8::rstd_from_ssq(ssq2, i >> 2); ((float*)(sml + SM_ROWW))[row] = tw[i];
            ((unsigned short*)(sml + SM_RPAIR))[(((row >> 8) * 2 + ((row >> 7) & 1)) * 64 + (row & 63)) * 2 + ((row >> 6) & 1)] = (unsigned short)(i >> 2); }
    } break;
    case ST_MOE1: {
        pg8::MoeSched1 S; S.A = (const char*)xq8; S.Bt = (const char*)wt + W_GU_T; S.lda2 = 1024u; S.ldb2 = 1024u; S.kstepA = 128; S.ntk = 8; S.nM = ntl[0]; S.nN = 8; S.G = G; S.c = bid;
        S.bexp = (size_t)2048 * D; S.tend = (const LAS int*)(ldsb + 131072); S.rowpair = (const unsigned*)(sml + SM_RPAIR);
        if (tid < 32) ((LAS int*)(ldsb + 131072))[tid] = ((const int*)(sml + SM_TEND))[tid];
        __syncthreads();
        pg8::EpiMoe1 E{act8, (const float*)(sml + SM_ROWRS), b_gu};
        pg8::gemm_phase(ldsb, S, E);
    } break;
    case ST_MOE2: {
        pg8::MoeSched2 S; S.A = (const char*)act8; S.Bt = (const char*)wt + W_D_T; S.lda2 = 1024u; S.ldb2 = 1024u; S.kstepA = 128; S.ntk = 8; S.nM = ntl[0]; S.nN = 4; S.G = G; S.c = bid;
        S.bexp = (size_t)D * D; S.tend = (const LAS int*)(ldsb + 131072); S.rowpair = nullptr;
        if (tid < 32) ((LAS int*)(ldsb + 131072))[tid] = ((const int*)(sml + SM_TEND))[tid];
        __syncthreads();
        pg8::EpiMoe2 E{ys, rslot, (const float*)(sml + SM_ROWW), b_down};
        pg8::gemm_phase(ldsb, S, E);
    } break;
    case ST_FINAL: {
        const int lane = tid & 63, wv = tid >> 6;
        for (int m = bid * 8 + wv; m < M; m += nb * 8) {
            const pg8::u32x2* xr = (const pg8::u32x2*)(xb2 + (size_t)m * D) + lane; f32x4 v[4]; float s = 0.f;
#pragma unroll
            for (int j = 0; j < 4; ++j) { const pg8::u32x2 w = xr[64 * j]; v[j] = (f32x4){__uint_as_float(w.x << 16), __uint_as_float(w.x & 0xffff0000u), __uint_as_float(w.y << 16), __uint_as_float(w.y & 0xffff0000u)}; }
#pragma unroll
            for (int k = 0; k < 4; ++k) { const pg8::u32x2* yr = (const pg8::u32x2*)(ys + ((size_t)m * 4 + k) * D) + lane;
#pragma unroll
                for (int j = 0; j < 4; ++j) { const pg8::u32x2 w = yr[64 * j]; v[j].x += __uint_as_float(w.x << 16); v[j].y += __uint_as_float(w.x & 0xffff0000u); v[j].z += __uint_as_float(w.y << 16); v[j].w += __uint_as_float(w.y & 0xffff0000u); } }
#pragma unroll
            for (int j = 0; j < 4; ++j) s += v[j].x * v[j].x + v[j].y * v[j].y + v[j].z * v[j].z + v[j].w * v[j].w;
            const float rs = rsqrtf(wave_sum(s) * (1.f / D) + EPS);
            f32x4* o = (f32x4*)(as_global(a.out) + (size_t)m * D) + lane; const f32x4* gf = (const f32x4*)g_final + lane;
#pragma unroll
            for (int j = 0; j < 4; ++j) o[64 * j] = v[j] * rs * gf[64 * j];
        }
    } break;
    default: break;
    }
#undef INP
}

#define XB_TMO      128
#define XB_XCNT(j)  (256  + 64 * (j))
#define XB_XSUB(j)  (1280 + 64 * (j))
#define XB_XGEN(j)  (2304 + 64 * (j))
#define XB_TOP      3328
#define XB_TOPGEN   3392
#define XCD_BAR_WORDS 3456
#define XB_SPIN_CAP (1u << 20)
#define LAS __attribute__((address_space(3)))
__device__ __forceinline__ unsigned xb_ld(unsigned* p)              { return __hip_atomic_load(p, __ATOMIC_RELAXED, __HIP_MEMORY_SCOPE_AGENT); }
__device__ __forceinline__ unsigned xb_add(unsigned* p, unsigned v) { return __hip_atomic_fetch_add(p, v, __ATOMIC_RELAXED, __HIP_MEMORY_SCOPE_AGENT); }
__device__ __forceinline__ unsigned xb_xcc_id() { return (unsigned)__builtin_amdgcn_s_getreg((3 << 11) | 20) & 0xFu; }
#define XB_SPIN(cond, bar) do { unsigned _sp = 0; while (cond) { __builtin_amdgcn_s_sleep(1); \
    if ((++_sp & 255u) == 0u) { if (xb_ld(&(bar)[XB_TMO])) break; if (_sp > XB_SPIN_CAP) { atomicAdd(&(bar)[XB_TMO], 1u); break; } } } } while (0)
struct XcdBarrier { unsigned* bar; unsigned x; volatile LAS unsigned* st; };
__device__ __forceinline__ XcdBarrier xcd_barrier_post(unsigned* bar, volatile LAS unsigned* st) {
    XcdBarrier b; b.bar = bar; b.x = xb_xcc_id(); b.st = st;
    if (threadIdx.x == 0) (void)xb_add(&bar[XB_XCNT(b.x)], 1u);
    return b;
}
__device__ __forceinline__ void xcd_barrier_complete(unsigned* bar, unsigned x, unsigned& nloc, unsigned& nx) {
    const unsigned G = gridDim.x * gridDim.y * gridDim.z;
    unsigned sum, cnt, mine, sp = 0u;
    for (;;) {
        sum = 0u; cnt = 0u; mine = 0u;
#pragma unroll
        for (unsigned j = 0; j < 16; ++j) { const unsigned c = xb_ld(&bar[XB_XCNT(j)]); sum += c; cnt += (c > 0u) ? 1u : 0u; mine = (j == x) ? c : mine; }
        if (sum == G) break;
        __builtin_amdgcn_s_sleep(1);
        if ((++sp & 255u) == 0u) { if (xb_ld(&bar[XB_TMO])) break; if (sp > XB_SPIN_CAP) { atomicAdd(&bar[XB_TMO], 1u); break; } }
    }
    nloc = mine > 0u ? mine : 1u; nx = cnt > 0u ? cnt : 1u;
}
__device__ __forceinline__ void xcd_barrier(const XcdBarrier& b) {
    asm volatile("s_waitcnt vmcnt(0)" ::: "memory");
    __syncthreads();
    if (threadIdx.x == 0) {
        unsigned* bar = b.bar;
        __builtin_amdgcn_s_waitcnt(0);
        unsigned nloc = b.st[0], nx = b.st[1];
        if (nloc == 0u) { xcd_barrier_complete(bar, b.x, nloc, nx); b.st[0] = nloc; b.st[1] = nx; }
        const unsigned old = xb_add(&bar[XB_XSUB(b.x)], 1u);
        const unsigned gen = old / nloc;
        if (old + 1u == (gen + 1u) * nloc) {
            __builtin_amdgcn_fence(__ATOMIC_RELEASE, "agent");
            asm volatile("s_waitcnt vmcnt(0)" ::: "memory");
            const unsigned og = xb_add(&bar[XB_TOP], 1u);
            const unsigned tg = og / nx;
            if (og + 1u == (tg + 1u) * nx) xb_add(&bar[XB_TOPGEN], 1u);
            else XB_SPIN(xb_ld(&bar[XB_TOPGEN]) == tg, bar);
            __builtin_amdgcn_fence(__ATOMIC_ACQUIRE, "agent");
            xb_add(&bar[XB_XGEN(b.x)], 1u);
            asm volatile("s_waitcnt vmcnt(0)" ::: "memory");
        } else {
            XB_SPIN(xb_ld(&bar[XB_XGEN(b.x)]) == gen, bar);
            __builtin_amdgcn_fence(__ATOMIC_ACQUIRE, "agent");
            asm volatile("s_waitcnt vmcnt(0)" ::: "memory");
        }
    }
    __syncthreads();
}

constexpr int LDS_BYTES = 147456;
constexpr int CW_BAR = 4096;

template <int S> __device__ __forceinline__ void run_stages(const Args& a, float* sm, const XcdBarrier& bar) {
    if constexpr (S < ST_COUNT) {
        run_stage<S>(a, sm);
#ifdef DUP_MASK
        if constexpr ((DUP_MASK >> S) & 1) { __syncthreads(); run_stage<S>(a, sm); }
#endif
        if (S + 1 < ST_COUNT) xcd_barrier(bar);
        run_stages<S + 1>(a, sm, bar);
    }
}
__global__ void __launch_bounds__(512, 2) mega(Args a) {
    extern __shared__ __attribute__((aligned(16))) unsigned char lds[];
    float* sm = (float*)lds;
    volatile LAS unsigned* misc = (volatile LAS unsigned*)((LAS unsigned char*)lds + LDS_MISC);
    if (threadIdx.x < 32) misc[threadIdx.x] = 0u;
    if (threadIdx.x < 36) ((LAS unsigned long long*)((LAS unsigned char*)lds + LDS_PTAB))[threadIdx.x] = (unsigned long long)a.in[threadIdx.x];
    __syncthreads();
    XcdBarrier bar = xcd_barrier_post((unsigned*)(as_global(a.ws) + WS_CTL) + CW_BAR, misc + 8);
    run_stages<0>(a, sm, bar);
}

extern "C" void kernel_launch(void* const* d_in, const int* in_sizes, int n_in, void* d_out, int out_size, void* d_ws, size_t ws_size, hipStream_t stream) {
    static int grid = 0;
    if (grid == 0) {
        if (n_in != 36 || out_size != M * D || ws_size < WS_END) { fprintf(stderr, "kernel_launch: unexpected n_in %d / out %d / ws %zu\n", n_in, out_size, ws_size); grid = -1; return; }
        int dev = 0, cus = 0;
        if (hipGetDevice(&dev) != hipSuccess || hipDeviceGetAttribute(&cus, hipDeviceAttributeMultiprocessorCount, dev) != hipSuccess) { grid = -1; return; }
        if (hipFuncSetAttribute((const void*)mega, hipFuncAttributeMaxDynamicSharedMemorySize, LDS_BYTES) != hipSuccess) { fprintf(stderr, "kernel_launch: hipFuncSetAttribute failed\n"); grid = -1; return; }
        int per_cu = 0;
        if (hipOccupancyMaxActiveBlocksPerMultiprocessor(&per_cu, (const void*)mega, 512, LDS_BYTES) != hipSuccess || per_cu < 1) { fprintf(stderr, "kernel_launch: occupancy query says %d\n", per_cu); }
        (void)hipGetLastError();
        grid = cus;
    }
    if (grid < 0) return;
    (void)hipMemsetAsync((char*)d_ws + WS_CTL, 0, 1 * MiB, stream);
    Args a{};
    for (int i = 0; i < 36; ++i) a.in[i] = (const float*)d_in[i];
    a.out = (float*)d_out; a.ws = (unsigned char*)d_ws;
    a.stage = 0; a.pad = ST_COUNT;
    hipLaunchKernelGGL(mega, dim3(grid), dim3(512), LDS_BYTES, stream, a);
}
```
